# Optimizing an MI355X kernel written in HIP

```python
import jax, jax.numpy as jnp
from jax import lax
import numpy as np

D_MODEL = 1024
BATCH = 8
SEQ = 2048
DEPTH = 2

HEAD_DIM = 64
N_SB = 6
N_DSA = 6
N_IDX = 8
IDX_DIM = 64
TOPK_MAX = 256
N_HG = 4
HG_DK = 128
HG_DV = 64
D_FF = 4 * D_MODEL
ROPE_THETA = 500000.0
ROT_DIM = HEAD_DIM // 4
Q_BLOCK = 128
HG_CHUNK = 64
EPS = 1e-6
F_MIN = 1e-12
NEG = -1e30
W_SB = N_SB * HEAD_DIM
W_DSA = N_DSA * HEAD_DIM
W_HF = N_HG * HG_DK
W_HV = N_HG * HG_DV
IDX_SCALE = (IDX_DIM * N_IDX) ** -0.5
SPLITS = (W_SB, W_SB, W_SB,
          W_DSA, HEAD_DIM, HEAD_DIM,
          N_IDX * IDX_DIM, IDX_DIM, N_IDX,
          W_HF, W_HF, W_HV, W_HV,
          D_MODEL, D_MODEL, D_MODEL)
D_IN = sum(SPLITS)

kernel_name = 'hybrid_sb_dsa_hgrn2_block'


def _split_points():
    return [int(v) for v in np.cumsum(np.array(SPLITS))[:-1]]


def rms_norm(x, gain):
    xf = x.astype(jnp.float32)
    y = xf * lax.rsqrt(jnp.mean(xf * xf, axis=-1, keepdims=True) + EPS)
    return (y * gain.astype(jnp.float32)).astype(x.dtype)


def partial_rope(x, pos):
    half = ROT_DIM // 2
    inv = ROPE_THETA ** (-(jnp.arange(half, dtype=jnp.float32) * 2.0) / ROT_DIM)
    ang = pos.astype(jnp.float32)[:, None] * inv[None, :]
    cos = jnp.cos(ang)[None, :, None, :]
    sin = jnp.sin(ang)[None, :, None, :]
    xr = x[..., :ROT_DIM].astype(jnp.float32)
    x1, x2 = xr[..., :half], xr[..., half:]
    rot = jnp.concatenate([x1 * cos - x2 * sin, x2 * cos + x1 * sin], axis=-1).astype(x.dtype)
    return jnp.concatenate([rot, x[..., ROT_DIM:]], axis=-1)


def stick_breaking_attention(q, k, v):
    B, T, H, D = q.shape
    scale = D ** -0.5
    outs = []
    for blk in range(T // Q_BLOCK):
        q0, q1 = blk * Q_BLOCK, (blk + 1) * Q_BLOCK
        z = jnp.einsum('bqhd,bkhd->bhqk', q[:, q0:q1], k[:, :q1]).astype(jnp.float32) * scale
        t_pos = q0 + jnp.arange(Q_BLOCK)[:, None]
        s_pos = jnp.arange(q1)[None, :]
        past = s_pos < t_pos
        log_1m = jnp.where(past, jax.nn.log_sigmoid(-z), 0.0)
        later = lax.cumsum(log_1m, axis=3, reverse=True) - log_1m
        log_a = jnp.where(past, jax.nn.log_sigmoid(z) + later, NEG)
        a = jnp.exp(log_a)
        outs.append(jnp.einsum('bhqk,bkhd->bqhd', a.astype(v.dtype), v[:, :q1]))
    return jnp.concatenate(outs, axis=1)


def dsa_attention(q, k, v, q_idx, k_idx, w_idx):
    B, T, H, D = q.shape
    k_top = min(TOPK_MAX, T // 4)
    gather = jax.vmap(lambda arr, idx: arr[idx])
    outs = []
    for blk in range(T // Q_BLOCK):
        q0, q1 = blk * Q_BLOCK, (blk + 1) * Q_BLOCK
        kl = min(T, max(q1, k_top))
        rel = jax.nn.relu(jnp.einsum('bqjd,bkd->bqjk', q_idx[:, q0:q1], k_idx[:, :kl]).astype(jnp.float32))
        score = jnp.einsum('bqj,bqjk->bqk', w_idx[:, q0:q1].astype(jnp.float32) * IDX_SCALE, rel)
        t_pos = q0 + jnp.arange(Q_BLOCK)[:, None]
        s_pos = jnp.arange(kl)[None, :]
        score = jnp.where(s_pos <= t_pos, score, NEG)
        top_score, top_idx = lax.top_k(score, k_top)
        k_sel = gather(k, top_idx)
        v_sel = gather(v, top_idx)
        logits = jnp.einsum('bqhd,bqkd->bhqk', q[:, q0:q1], k_sel).astype(jnp.float32) * (D ** -0.5)
        valid = (top_score > 0.5 * NEG)[:, None]
        logits = jnp.where(valid, logits, NEG)
        p = jax.nn.softmax(logits, axis=-1)
        outs.append(jnp.einsum('bhqk,bqkd->bqhd', p.astype(v.dtype), v_sel))
    return jnp.concatenate(outs, axis=1)


def hgrn2(q, f_pre, inp, lb):
    B, T, H, DK = q.shape
    DV = inp.shape[-1]
    C = HG_CHUNK
    N = T // C
    q = jax.nn.silu(q.astype(jnp.float32))
    lb = lb.astype(jnp.float32)
    f = lb + (1.0 - lb) * jax.nn.sigmoid(f_pre.astype(jnp.float32))
    log_f = jnp.log(jnp.maximum(f, F_MIN))
    k = 1.0 - f

    def to_chunks(a):
        return a.reshape(B, N, C, H, a.shape[-1]).transpose(1, 0, 3, 2, 4)

    qc, kc, vc, gc = (to_chunks(a) for a in (q, k, inp.astype(jnp.float32), log_f))
    causal = jnp.tril(jnp.ones((C, C), dtype=bool))[:, :, None]

    def step(S, xs):
        qt, kt, vt, gt = xs
        b = jnp.cumsum(gt, axis=2)
        diff = b[:, :, :, None, :] - b[:, :, None, :, :]
        decay = jnp.exp(jnp.where(causal, diff, NEG))
        att = jnp.einsum('bhtk,bhsk,bhtsk->bhts', qt, kt, decay)
        o = jnp.einsum('bhts,bhsv->bhtv', att, vt) + jnp.einsum('bhtk,bhkv->bhtv', qt * jnp.exp(b), S)
        b_last = b[:, :, -1:, :]
        S = S * jnp.exp(b_last[:, :, 0, :, None]) + jnp.einsum('bhsk,bhsv->bhkv', kt * jnp.exp(b_last - b), vt)
        return S, o

    S0 = jnp.zeros((B, H, DK, DV), jnp.float32)
    _, o = lax.scan(step, S0, (qc, kc, vc, gc))
    return o.transpose(1, 0, 3, 2, 4).reshape(B, T, H, DV).astype(inp.dtype)


def hybrid_mixer(h, w_in_l, qn, kn, lb, onorm, w_sb_l, w_dsa_l, w_hg_l, w_out_l):
    B, T, _ = h.shape
    pos = jnp.arange(T)
    (sq, sk, sv, dq, dk, dv, iq, ik, iw, hq, hf, hi, hg,
     g_sb, g_dsa, g_hg) = jnp.split(h @ w_in_l, _split_points(), axis=-1)
    heads = lambda a, n: a.reshape(B, T, n, -1)
    y_sb = stick_breaking_attention(heads(sq, N_SB), heads(sk, N_SB), heads(sv, N_SB)).reshape(B, T, W_SB) @ w_sb_l
    q = partial_rope(rms_norm(heads(dq, N_DSA), qn), pos)
    k = partial_rope(rms_norm(dk[:, :, None, :], kn), pos)[:, :, 0]
    q_i = partial_rope(heads(iq, N_IDX), pos)
    k_i = partial_rope(ik[:, :, None, :], pos)[:, :, 0]
    y_dsa = dsa_attention(q, k, dv, q_i, k_i, iw).reshape(B, T, W_DSA) @ w_dsa_l
    o = hgrn2(heads(hq, N_HG), heads(hf, N_HG), heads(hi, N_HG), lb.reshape(N_HG, HG_DK))
    o = rms_norm(o, onorm) * jax.nn.silu(heads(hg, N_HG))
    y_hg = o.reshape(B, T, W_HV) @ w_hg_l
    mixed = jax.nn.sigmoid(g_sb) * y_sb + jax.nn.sigmoid(g_dsa) * y_dsa + jax.nn.sigmoid(g_hg) * y_hg
    return mixed @ w_out_l


def setup_inputs(seed: int = 0) -> dict:
    key = jax.random.key(seed)
    ks = jax.random.split(key, 16)
    f32 = jnp.float32
    res = (2 * DEPTH) ** -0.5

    def nrm(k, shape, fan_in, g=1.0):
        return jax.random.normal(k, shape, f32) * (g * fan_in ** -0.5)

    def gain(k, shape):
        return 1.0 + 0.02 * jax.random.normal(k, shape, f32)

    return {
        'x': jax.random.normal(ks[0], (BATCH, SEQ, D_MODEL), f32),
        'norm_mix': gain(ks[1], (DEPTH, D_MODEL)),
        'w_in': nrm(ks[2], (DEPTH, D_MODEL, D_IN), D_MODEL),
        'qn_dsa': gain(ks[3], (DEPTH, HEAD_DIM)),
        'kn_dsa': gain(ks[4], (DEPTH, HEAD_DIM)),
        'hgrn_lb': 0.5 * jax.random.normal(ks[5], (DEPTH, W_HF), f32),
        'hgrn_onorm': gain(ks[6], (DEPTH, HG_DV)),
        'w_br_sb': nrm(ks[7], (DEPTH, W_SB, D_MODEL), W_SB),
        'w_br_dsa': nrm(ks[8], (DEPTH, W_DSA, D_MODEL), W_DSA),
        'w_br_hgrn': nrm(ks[9], (DEPTH, W_HV, D_MODEL), W_HV),
        'w_out': nrm(ks[10], (DEPTH, D_MODEL, D_MODEL), D_MODEL, res),
        'norm_mlp': gain(ks[11], (DEPTH, D_MODEL)),
        'w_up': nrm(ks[12], (DEPTH, D_MODEL, D_FF), D_MODEL),
        'w_down': nrm(ks[13], (DEPTH, D_FF, D_MODEL), D_FF, res),
    }


def reference(x, norm_mix, w_in, qn_dsa, kn_dsa, hgrn_lb, hgrn_onorm, w_br_sb, w_br_dsa,
              w_br_hgrn, w_out, norm_mlp, w_up, w_down):
    p_lb = jax.nn.softmax(hgrn_lb.astype(jnp.float32), axis=0)
    lbs = jnp.cumsum(p_lb, axis=0) - p_lb[0:1]
    for l in range(DEPTH):
        h = rms_norm(x, norm_mix[l])
        x = x + hybrid_mixer(h, w_in[l], qn_dsa[l], kn_dsa[l], lbs[l], hgrn_onorm[l],
                             w_br_sb[l], w_br_dsa[l], w_br_hgrn[l], w_out[l])
        h2 = rms_norm(x, norm_mlp[l])
        x = x + jnp.square(jax.nn.relu(h2 @ w_up[l])) @ w_down[l]
    return x
```

```cpp
#include <hip/hip_runtime.h>
#include <hip/hip_cooperative_groups.h>
#include <cstdio>
#include <cstdint>
namespace cg = cooperative_groups;

#ifndef ONE_LAUNCH
#define ONE_LAUNCH 1
#endif

#define LAS __attribute__((address_space(3)))
typedef unsigned short bf16_t;
typedef short bf16x8 __attribute__((ext_vector_type(8)));
typedef short bf16x4 __attribute__((ext_vector_type(4)));
typedef float f32x4 __attribute__((ext_vector_type(4)));
typedef float f32x16 __attribute__((ext_vector_type(16)));
typedef unsigned u32x4 __attribute__((ext_vector_type(4)));
typedef unsigned u32x2 __attribute__((ext_vector_type(2)));

constexpr int D = 1024, NB = 8, T = 2048, DEPTH = 2, M = NB * T, FF = 4096;
constexpr int D_IN = 6856;
constexpr int NGEMM = 3840;
constexpr int G_SV = 0, G_DV = 384, G_SK = 448, NKV = 832, NPROJ = NGEMM - NKV;
constexpr int C_SQ = 0, C_DQ = 384, C_DK = 768, C_IQ = 832, C_IK = 1344, C_HQ = 1408, C_HF = 1920, C_HI = 2432, C_HG = 2688, C_IW = 2944;
constexpr float EPS = 1e-6f;
constexpr float LOG2E = 1.4426950408889634f;

constexpr size_t MiB = 1u << 20;
constexpr size_t WS_WT = 1 * MiB;
constexpr size_t WT_IN = 0, WT_G = WT_IN + (size_t)NGEMM * D * 2, WT_BR = WT_G + (size_t)3072 * D * 2  ,
                 WT_OUT = WT_BR + (size_t)3072 * 384 * 2, WT_UP = WT_OUT + (size_t)D * D * 2, WT_DOWN = WT_UP + (size_t)FF * D * 2,
                 WT_END = WT_DOWN + (size_t)D * FF * 2;
static_assert(WT_END <= 34 * MiB, "weights");
constexpr size_t WS_H = 35 * MiB;
constexpr size_t WS_BR = 67 * MiB;
constexpr size_t WS_BIG = 99 * MiB;
constexpr size_t BIG_GT = 0  , BIG_MIX = 96 * MiB;
constexpr size_t WS_KF_SB = WS_BIG + 96 * MiB, WS_VF_SB = WS_KF_SB + 12 * MiB, WS_KF_DSA = WS_VF_SB + 12 * MiB, WS_VF_DSA = WS_KF_DSA + 2 * MiB, WS_KF_IDX = WS_VF_DSA + 2 * MiB;
static_assert((size_t)M * NPROJ * 2 <= 96 * MiB && WS_KF_IDX + 2 * MiB <= WS_BIG + 128 * MiB, "big");
constexpr size_t WS_MASK = 227 * MiB;
constexpr size_t WS_HST = 231 * MiB;
constexpr size_t HST_STRIDE = 128 * 64 + 128;
constexpr size_t WS_VF_HG = 240 * MiB;
constexpr size_t WS_END = 248 * MiB;
static_assert(WS_HST + 256 * HST_STRIDE * 4 <= WS_END, "ws");

constexpr int LDS_BYTES = 147456;

__device__ __forceinline__ unsigned cvt_pk_bf16(float lo, float hi) { unsigned r; asm volatile("v_cvt_pk_bf16_f32 %0, %1, %2" : "=v"(r) : "v"(lo), "v"(hi)); return r; }
__device__ __forceinline__ float bf2f(unsigned short b) { return __builtin_bit_cast(float, (unsigned)b << 16); }
__device__ __forceinline__ float bflo(unsigned u) { return __builtin_bit_cast(float, u << 16); }
__device__ __forceinline__ float bfhi(unsigned u) { return __builtin_bit_cast(float, u & 0xffff0000u); }
__device__ __forceinline__ float fexp2(float x) { return __builtin_amdgcn_exp2f(x); }
__device__ __forceinline__ float fexp(float x) { return __builtin_amdgcn_exp2f(x * LOG2E); }
__device__ __forceinline__ float flog2(float x) { return __builtin_amdgcn_logf(x); }
__device__ __forceinline__ float frcp(float x) { return __builtin_amdgcn_rcpf(x); }
__device__ __forceinline__ float sigmoidf_(float x) { return frcp(1.f + fexp(-x)); }
__device__ __forceinline__ float wave_sum(float v) {
#pragma unroll
    for (int o = 1; o < 64; o <<= 1) v += __shfl_xor(v, o);
    return v;
}

namespace pg8 {
constexpr int BM = 256, BK = 64, HALF = 128, HTB = HALF * BK * 2, NXCD = 8, WGM = 8;
__host__ __device__ __forceinline__ int lds_byte(int r, int c) { const int st = (r >> 4) * 2 + (c >> 5), rr = r & 15, cc = c & 31, ob = rr * 64 + cc * 2; return st * 1024 + (ob ^ (((ob >> 9) & 1) << 5)); }
__host__ __device__ __forceinline__ void stage_rc(int b, int& R, int& C) { const int st = b / 1024, sb = b % 1024, swz = sb ^ (((sb >> 9) & 1) << 5); R = (st >> 1) * 16 + swz / 64; C = (st & 1) * 32 + (swz % 64) / 2; }
__host__ __device__ __forceinline__ int perm32(int rho) { const int n = rho >> 4, i = rho & 15; return 8 * (i >> 2) + 4 * n + (i & 3); }
struct Unit { int pm, pn; };
struct Gemm { const bf16_t* A; const bf16_t* Bt; int M, N, K, lda, a_grp_off, align; };
struct StaticOrder {
    int nM, nN, nwg, G, c, reps;
    __device__ void init(int M_, int N_, int G_, int c_, int reps_ = 1) { reps = reps_; nM = M_ / BM; nN = N_ / (BM * reps_); nwg = nM * nN; G = G_; c = c_; }
    __device__ bool next(int i, Unit& u) const {
        const int ib = i / reps, br = i - ib * reps;
        const long L = (long)ib * G + c; if (L >= nwg) return false;
        int wgid = (int)L; { const int q = nwg / NXCD, r = nwg % NXCD, xcd = wgid % NXCD, off = wgid / NXCD; wgid = (xcd < r ? xcd * (q + 1) : r * (q + 1) + (xcd - r) * q) + off; }
        const int nig = WGM * nN, gid = wgid / nig, fm = gid * WGM, gsz = (nM - fm) < WGM ? (nM - fm) : WGM;
        u.pm = fm + ((wgid % nig) % gsz); u.pn = br * nN + (wgid % nig) / gsz; return true;
    }
};
template <class Epi>
__device__ __forceinline__ void gemm_phase(LAS unsigned char* lds, const Gemm g, const StaticOrder& S, const Epi& E) {
    int tid_ = threadIdx.x; asm volatile("" : "+v"(tid_));
    const int tid = tid_, wid = __builtin_amdgcn_readfirstlane(tid >> 6), lane = tid & 63, wr = wid >> 2, wc = wid & 3, fr = lane & 15, fq = lane >> 4;
    const int K = g.K, nt = K / BK, lda = g.lda;
    unsigned voffA[2], voffB[2];
#pragma unroll
    for (int i = 0; i < 2; ++i) { int R, C; stage_rc(tid * 16 + i * 8192, R, C); const int Rb = (R & ~31) + perm32(R & 31);
        voffA[i] = (unsigned)(R * lda + C) * 2u; voffB[i] = (unsigned)(Rb * K + C) * 2u; }
    const size_t kstep = (size_t)(BK * 2);
    const size_t hstepA = (size_t)HALF * lda * 2, tstepA = 2 * hstepA;
    const size_t hstepB = (size_t)HALF * K * 2, tstepB = 2 * hstepB;
    const unsigned ldsw = (unsigned)wid * 1024u;
    const int aoff = lds_byte(wr * 64 + fr, fq * 8), boff = lds_byte(wc * 32 + fr, fq * 8);
#define PG8_SA(b, h) (((b) * 2 + (h)) * HTB)
#define PG8_SB(b, h) ((4 + (b) * 2 + (h)) * HTB)
#define PG8_STAGE(bufoff, gbase, voff) do { _Pragma("unroll") for (int _i = 0; _i < 2; ++_i) \
        __builtin_amdgcn_global_load_lds((const unsigned*)((const char*)(gbase) + (voff)[_i]), (LAS unsigned*)(lds + (bufoff) + ldsw + _i * 8192), 16, 0, 0); } while (0)
#define PG8_LDA(dst, b, h) do { _Pragma("unroll") for (int m = 0; m < 4; ++m) _Pragma("unroll") for (int k = 0; k < 2; ++k) dst[m][k] = *(const LAS bf16x8*)(lds + PG8_SA(b, h) + aoff + m * 2048 + k * 1024); } while (0)
#define PG8_LDB(dst, b, h) do { _Pragma("unroll") for (int n = 0; n < 2; ++n) _Pragma("unroll") for (int k = 0; k < 2; ++k) dst[n][k] = *(const LAS bf16x8*)(lds + PG8_SB(b, h) + boff + n * 2048 + k * 1024); } while (0)
#define PG8_MMA(ai, bj, At, Bt) do { __builtin_amdgcn_s_setprio(1); _Pragma("unroll") for (int m = 0; m < 4; ++m) _Pragma("unroll") for (int n = 0; n < 2; ++n) _Pragma("unroll") for (int k = 0; k < 2; ++k) \
        acc[ai][bj][m][n] = __builtin_amdgcn_mfma_f32_16x16x32_bf16(Bt[n][k], At[m][k], acc[ai][bj][m][n], 0, 0, 0); __builtin_amdgcn_s_setprio(0); } while (0)
#define PG8_WAIT_V(n) asm volatile("s_waitcnt vmcnt(" #n ")" ::: "memory")
#define PG8_WAIT_L(n) asm volatile("s_waitcnt lgkmcnt(" #n ")" ::: "memory")
#define PG8_BAR __builtin_amdgcn_s_barrier()
#define PG8_SCHED __builtin_amdgcn_sched_barrier(0)
    Unit cur, nxt; int ui = 0;
    if (!S.next(0, cur)) return;
    f32x4 acc[2][2][4][2];
#pragma unroll
    for (int a = 0; a < 2; ++a)
#pragma unroll
        for (int b = 0; b < 2; ++b)
#pragma unroll
            for (int m = 0; m < 4; ++m)
#pragma unroll
                for (int n = 0; n < 2; ++n) acc[a][b][m][n] = (f32x4){0.f, 0.f, 0.f, 0.f};
    bf16x8 At[4][2], B0[2][2], B1[2][2];
    const size_t agrp = (size_t)g.a_grp_off * 2;
    const char* cA = (const char*)g.A + (size_t)cur.pm * tstepA + (size_t)(cur.pn >> 2) * agrp; const char* cB = (const char*)g.Bt + (size_t)cur.pn * tstepB;
    PG8_STAGE(PG8_SB(0, 0), cB, voffB); PG8_STAGE(PG8_SB(0, 1), cB + hstepB, voffB); PG8_STAGE(PG8_SA(0, 0), cA, voffA); PG8_STAGE(PG8_SA(0, 1), cA + hstepA, voffA);
    if (wr == 1) PG8_BAR;
    PG8_WAIT_V(2); PG8_BAR;
    PG8_STAGE(PG8_SB(1, 0), cB + kstep, voffB); PG8_STAGE(PG8_SA(1, 0), cA + kstep, voffA); PG8_STAGE(PG8_SB(1, 1), cB + hstepB + kstep, voffB);
    PG8_WAIT_V(6); PG8_BAR;
    for (;;) {
        const bool has_next = S.next(ui + 1, nxt);
        const char* nA = has_next ? (const char*)g.A + (size_t)nxt.pm * tstepA + (size_t)(nxt.pn >> 2) * agrp : cA; const char* nB = has_next ? (const char*)g.Bt + (size_t)nxt.pn * tstepB : cB;
        for (int t = 0; t < nt; t += 2) {
            const bool last = (t == nt - 2);
            const char* a1 = cA + (size_t)(t + 1) * kstep;
            const char* a2 = last ? nA : cA + (size_t)(t + 2) * kstep; const char* b2 = last ? nB : cB + (size_t)(t + 2) * kstep;
            const char* a3 = a2 + kstep; const char* b3 = b2 + kstep;
            PG8_LDB(B0, 0, 0); PG8_LDB(B1, 0, 1); PG8_SCHED; PG8_LDA(At, 0, 0); PG8_STAGE(PG8_SA(1, 1), a1 + hstepA, voffA);
            PG8_WAIT_V(8); PG8_WAIT_L(0); PG8_BAR; PG8_MMA(0, 0, At, B0); PG8_MMA(0, 1, At, B1); PG8_BAR; PG8_SCHED;
            PG8_LDA(At, 0, 1); PG8_STAGE(PG8_SB(0, 0), b2, voffB); PG8_STAGE(PG8_SB(0, 1), b2 + hstepB, voffB); PG8_STAGE(PG8_SA(0, 0), a2, voffA);
            PG8_WAIT_V(8); PG8_WAIT_L(0); PG8_BAR; PG8_MMA(1, 0, At, B0); PG8_MMA(1, 1, At, B1); PG8_BAR; PG8_SCHED;
            PG8_LDB(B0, 1, 0); PG8_LDB(B1, 1, 1); PG8_SCHED; PG8_LDA(At, 1, 0); PG8_STAGE(PG8_SA(0, 1), a2 + hstepA, voffA);
            PG8_WAIT_V(8); PG8_WAIT_L(0); PG8_BAR; PG8_MMA(0, 0, At, B0); PG8_MMA(0, 1, At, B1); PG8_BAR; PG8_SCHED;
            PG8_LDA(At, 1, 1); PG8_STAGE(PG8_SB(1, 0), b3, voffB); PG8_STAGE(PG8_SB(1, 1), b3 + hstepB, voffB); PG8_STAGE(PG8_SA(1, 0), a3, voffA);
            PG8_WAIT_V(8); PG8_WAIT_L(0); PG8_BAR; PG8_MMA(1, 0, At, B0); PG8_MMA(1, 1, At, B1); PG8_BAR; PG8_SCHED;
        }
        if (g.align) { if (wr == 0) PG8_BAR; }
        E(acc, cur, wr, wc, fr, fq);
        if (!has_next) break;
#pragma unroll
        for (int a = 0; a < 2; ++a)
#pragma unroll
            for (int b = 0; b < 2; ++b)
#pragma unroll
                for (int m = 0; m < 4; ++m)
#pragma unroll
                    for (int n = 0; n < 2; ++n) acc[a][b][m][n] = (f32x4){0.f, 0.f, 0.f, 0.f};
        cur = nxt; cA = nA; cB = nB; ++ui;
        if (g.align) { if (wr == 1) PG8_BAR; }
    }
    PG8_WAIT_V(0);
    if (!g.align) { if (wr == 0) PG8_BAR; }
    PG8_BAR;
#undef PG8_SA
#undef PG8_SB
#undef PG8_STAGE
#undef PG8_LDA
#undef PG8_LDB
#undef PG8_MMA
#undef PG8_WAIT_V
#undef PG8_WAIT_L
#undef PG8_BAR
#undef PG8_SCHED
}

#define EPI_LOOP_BEGIN \
    _Pragma("unroll") for (int ai = 0; ai < 2; ++ai) _Pragma("unroll") for (int m = 0; m < 4; ++m) { const int row = u.pm * BM + ai * HALF + wr * 64 + m * 16 + fr; \
    _Pragma("unroll") for (int bj = 0; bj < 2; ++bj) { const int col = u.pn * BM + bj * HALF + wc * 32 + 8 * fq; const f32x4 v0 = acc[ai][bj][m][0], v1 = acc[ai][bj][m][1];
#define EPI_LOOP_END } }

enum { EM_PROJ = 0, EM_GATE = 1, EM_MIXB = 2, EM_RES = 5, EM_UP = 6 };
struct EpiAll {
    int mode; bf16_t* O16; int ldo; unsigned char* KVB  ; const bf16_t* G16; const float* Xi; float* Xo;
    __device__ __forceinline__ void operator()(const f32x4 (&acc)[2][2][4][2], const Unit& u, int wr, int wc, int fr, int fq) const {
        asm volatile("" : "+v"(fr), "+v"(fq));
        EPI_LOOP_BEGIN
            if (mode == EM_PROJ) {
                u32x4 w; w.x = cvt_pk_bf16(v0[0], v0[1]); w.y = cvt_pk_bf16(v0[2], v0[3]); w.z = cvt_pk_bf16(v1[0], v1[1]); w.w = cvt_pk_bf16(v1[2], v1[3]);
                const int bb = row >> 11, tt = row & (T - 1), kt = tt >> 5, r = tt & 31;
                if (col < G_SK) {
                    const int isd = col >= G_DV, cc = isd ? col - G_DV : col, hh = cc >> 6, d0 = cc & 63, db = d0 >> 5;
                    const int s2 = r >> 4, k16 = r & 15, jj = 4 * (k16 >> 3) + (k16 & 3), h = (k16 >> 2) & 1;
                    const size_t blk = isd ? (size_t)(((bb * 64 + kt) * 2 + db) * 2 + s2) : (size_t)((((bb * 6 + hh) * 64 + kt) * 2 + db) * 2 + s2);
                    bf16_t* vp = (bf16_t*)(KVB + (isd ? WS_VF_DSA : WS_VF_SB)) + blk * 512 + ((d0 & 31) + 32 * h) * 8 + jj;
                    vp[0] = (bf16_t)(w.x & 0xffff); vp[8] = (bf16_t)(w.x >> 16); vp[16] = (bf16_t)(w.y & 0xffff); vp[24] = (bf16_t)(w.y >> 16);
                    vp[32] = (bf16_t)(w.z & 0xffff); vp[40] = (bf16_t)(w.z >> 16); vp[48] = (bf16_t)(w.w & 0xffff); vp[56] = (bf16_t)(w.w >> 16);
                } else if (col < NKV) {
                    const int cc = col - G_SK, hh = cc >> 6, d0 = cc & 63, s = d0 >> 4, h = (d0 >> 3) & 1;
                    *(u32x4*)((bf16_t*)(KVB + WS_KF_SB) + (size_t)((((bb * 6 + hh) * 64 + kt) * 4 + s)) * 512 + (r + 32 * h) * 8) = w;
                } else if (col >= NKV + C_HI && col < NKV + C_HI + 256) {
                    const int cc = col - (NKV + C_HI), hh = cc >> 6, v0 = cc & 63, s = tt & 63;
                    bf16_t* vp = (bf16_t*)(KVB + WS_VF_HG) + ((size_t)(((((bb * 4 + hh) * 32 + (tt >> 6)) * 4 + (v0 >> 4)) * 2 + (s >> 5))) * 64 + (v0 & 15) + 16 * ((s >> 3) & 3)) * 8 + (s & 7);
                    vp[0] = (bf16_t)(w.x & 0xffff); vp[8] = (bf16_t)(w.x >> 16); vp[16] = (bf16_t)(w.y & 0xffff); vp[24] = (bf16_t)(w.y >> 16);
                    vp[32] = (bf16_t)(w.z & 0xffff); vp[40] = (bf16_t)(w.z >> 16); vp[48] = (bf16_t)(w.w & 0xffff); vp[56] = (bf16_t)(w.w >> 16);
                } else {
                    *(u32x4*)(O16 + (size_t)row * ldo + col - NKV) = w;
                }
            } else if (mode == EM_GATE) {
                u32x4 w; w.x = cvt_pk_bf16(sigmoidf_(v0[0]), sigmoidf_(v0[1])); w.y = cvt_pk_bf16(sigmoidf_(v0[2]), sigmoidf_(v0[3]));
                w.z = cvt_pk_bf16(sigmoidf_(v1[0]), sigmoidf_(v1[1])); w.w = cvt_pk_bf16(sigmoidf_(v1[2]), sigmoidf_(v1[3]));
                *(u32x4*)(O16 + (size_t)row * ldo + col) = w;
            } else if (mode == EM_MIXB) {
                const u32x4 gw = *(const u32x4*)(G16 + (size_t)row * 3072 + col);
                f32x4 r0 = {bflo(gw.x) * v0[0], bfhi(gw.x) * v0[1], bflo(gw.y) * v0[2], bfhi(gw.y) * v0[3]};
                f32x4 r1 = {bflo(gw.z) * v1[0], bfhi(gw.z) * v1[1], bflo(gw.w) * v1[2], bfhi(gw.w) * v1[3]};
                bf16_t* mp = O16 + (size_t)row * D + (col & 1023);
                if (col >= 1024) { const u32x4 pw = *(const u32x4*)mp;
                    r0 += (f32x4){bflo(pw.x), bfhi(pw.x), bflo(pw.y), bfhi(pw.y)}; r1 += (f32x4){bflo(pw.z), bfhi(pw.z), bflo(pw.w), bfhi(pw.w)}; }
                u32x4 w; w.x = cvt_pk_bf16(r0[0], r0[1]); w.y = cvt_pk_bf16(r0[2], r0[3]); w.z = cvt_pk_bf16(r1[0], r1[1]); w.w = cvt_pk_bf16(r1[2], r1[3]);
                *(u32x4*)mp = w;
            } else if (mode == EM_RES) {
                const float* xp = Xi + (size_t)row * D + col; float* op = Xo + (size_t)row * D + col;
                const f32x4 x0 = *(const f32x4*)xp, x1 = *(const f32x4*)(xp + 4);
                *(f32x4*)op = x0 + v0; *(f32x4*)(op + 4) = x1 + v1;
            } else {
                f32x4 a = __builtin_elementwise_max(v0, (f32x4){0.f, 0.f, 0.f, 0.f}), b = __builtin_elementwise_max(v1, (f32x4){0.f, 0.f, 0.f, 0.f}); a = a * a; b = b * b;
                u32x4 w; w.x = cvt_pk_bf16(a[0], a[1]); w.y = cvt_pk_bf16(a[2], a[3]); w.z = cvt_pk_bf16(b[0], b[1]); w.w = cvt_pk_bf16(b[2], b[3]);
                *(u32x4*)(O16 + (size_t)row * ldo + col) = w;
            }
        EPI_LOOP_END
    }
};
}

#define CAS __attribute__((address_space(4)))
struct Ctx {
    LAS unsigned char* lds; int wave, G, bid;
    const CAS unsigned char* ka; float* out; unsigned char* ws;
    __device__ __forceinline__ const float* in(int i) const { return *(const float* const CAS*)(ka + 8 * i); }
};
#define LDS_WAIT() asm volatile("s_waitcnt lgkmcnt(0)" ::: "memory")

struct TrDesc { const float* src; bf16_t* dst; int ldw, ldt; };
__device__ __forceinline__ void tr_load(const TrDesc& d, float (&tv)[32], int lane) {
    const float* wp = d.src + (size_t)(lane >> 5) * d.ldw + (lane & 31);
#pragma unroll
    for (int i = 0; i < 32; ++i) tv[i] = __builtin_nontemporal_load(wp + (size_t)(2 * i) * d.ldw);
}
__device__ __forceinline__ void tr_store(const TrDesc& d, const float (&tv)[32], LAS float* scr, int lane) {
#pragma unroll
    for (int i = 0; i < 32; ++i) scr[(2 * i + (lane >> 5)) * 33 + (lane & 31)] = tv[i];
    LDS_WAIT(); asm volatile("" ::: "memory");
    const int c = lane & 7;
#pragma unroll
    for (int j = 0; j < 4; ++j) { const int n = (lane >> 3) + 8 * j; const LAS float* sp = scr + (8 * c) * 33 + n;
        u32x4 o; o.x = cvt_pk_bf16(sp[0 * 33], sp[1 * 33]); o.y = cvt_pk_bf16(sp[2 * 33], sp[3 * 33]); o.z = cvt_pk_bf16(sp[4 * 33], sp[5 * 33]); o.w = cvt_pk_bf16(sp[6 * 33], sp[7 * 33]);
        *(u32x4*)(d.dst + (size_t)n * d.ldt + 8 * c) = o; }
    LDS_WAIT(); asm volatile("" ::: "memory");
}
__device__ __forceinline__ void rms_row_to_bf16(const float* xrow, const float* gain, bf16_t* orow, int lane) {
    asm volatile("" : "+v"(lane));
    const f32x4* xr = (const f32x4*)xrow + lane; const f32x4* gr = (const f32x4*)gain + lane;
    f32x4 v[4]; float s = 0.f;
#pragma unroll
    for (int j = 0; j < 4; ++j) { v[j] = xr[64 * j]; s += (v[j].x * v[j].x + v[j].y * v[j].y) + (v[j].z * v[j].z + v[j].w * v[j].w); }
    const float rstd = 1.f / sqrtf(wave_sum(s) * (1.f / D) + EPS);
    u32x2* o8 = (u32x2*)orow + lane;
#pragma unroll
    for (int j = 0; j < 4; ++j) { const f32x4 g = gr[64 * j]; u32x2 w; w.x = cvt_pk_bf16(v[j].x * rstd * g.x, v[j].y * rstd * g.y); w.y = cvt_pk_bf16(v[j].z * rstd * g.z, v[j].w * rstd * g.w); o8[64 * j] = w; }
}
__device__ __forceinline__ void norm_rows(const Ctx& F, const float* X, const float* gain, bf16_t* O) {
    const int gw = F.bid * 8 + F.wave, NGW = F.G * 8;
    int lane = (int)threadIdx.x & 63; asm volatile("" : "+v"(lane));
    const f32x4* gr = (const f32x4*)gain + lane;
    for (int m = gw; m < M; m += 2 * NGW) {
        const int m2 = m + NGW; const bool two = m2 < M;
        const f32x4* xa = (const f32x4*)(X + (size_t)m * D) + lane; const f32x4* xb = (const f32x4*)(X + (size_t)(two ? m2 : m) * D) + lane;
        f32x4 va[4], vb[4]; float sa = 0.f, sb = 0.f;
#pragma unroll
        for (int j = 0; j < 4; ++j) { va[j] = xa[64 * j]; vb[j] = xb[64 * j]; }
#pragma unroll
        for (int j = 0; j < 4; ++j) { sa += (va[j].x * va[j].x + va[j].y * va[j].y) + (va[j].z * va[j].z + va[j].w * va[j].w); sb += (vb[j].x * vb[j].x + vb[j].y * vb[j].y) + (vb[j].z * vb[j].z + vb[j].w * vb[j].w); }
#pragma unroll
        for (int o = 1; o < 64; o <<= 1) { sa += __shfl_xor(sa, o); sb += __shfl_xor(sb, o); }
        const float ra = 1.f / sqrtf(sa * (1.f / D) + EPS), rb = 1.f / sqrtf(sb * (1.f / D) + EPS);
        u32x2* oa = (u32x2*)(O + (size_t)m * D) + lane; u32x2* ob = (u32x2*)(O + (size_t)m2 * D) + lane;
#pragma unroll
        for (int j = 0; j < 4; ++j) { const f32x4 g = gr[64 * j];
            u32x2 w; w.x = cvt_pk_bf16(va[j].x * ra * g.x, va[j].y * ra * g.y); w.y = cvt_pk_bf16(va[j].z * ra * g.z, va[j].w * ra * g.w); oa[64 * j] = w;
            if (two) { u32x2 w2; w2.x = cvt_pk_bf16(vb[j].x * rb * g.x, vb[j].y * rb * g.y); w2.y = cvt_pk_bf16(vb[j].z * rb * g.z, vb[j].w * rb * g.w); ob[64 * j] = w2; } }
    }
}
__device__ __forceinline__ void p0_weights(const Ctx& F, int l) {
    LAS float* scr = (LAS float*)(F.lds + F.wave * 16384);
    int tid0 = threadIdx.x; asm volatile("" : "+v"(tid0));
    const int gw = F.bid * 8 + F.wave, NGW = F.G * 8;
    unsigned char* wt = F.ws + WS_WT;
    bf16_t* Wt_in = (bf16_t*)(wt + WT_IN); bf16_t* Wt_g = (bf16_t*)(wt + WT_G); bf16_t* Wt_br = (bf16_t*)(wt + WT_BR);
    bf16_t* Wt_out = (bf16_t*)(wt + WT_OUT); bf16_t* Wt_up = (bf16_t*)(wt + WT_UP); bf16_t* Wt_down = (bf16_t*)(wt + WT_DOWN);
    const float* w_in = F.in(2) + (size_t)l * D * D_IN;
    const float* w_sb = F.in(7) + (size_t)l * 384 * D; const float* w_dsa = F.in(8) + (size_t)l * 384 * D; const float* w_hg = F.in(9) + (size_t)l * 256 * D;
    const float* w_out = F.in(10) + (size_t)l * D * D; const float* w_up = F.in(12) + (size_t)l * D * FF; const float* w_down = F.in(13) + (size_t)l * FF * D;
    constexpr int NI_IN = 16 * (3776 / 32 + 3072 / 32);
    constexpr int NI_TOT = NI_IN + 2 * (6 * 32) + 4 * 32 + 16 * 32 + 16 * 128 + 64 * 32;
#define SEGP(W_, ldw_, c0_, nc_, K_, P_, WT_, r0_) { constexpr int nbk = (nc_) / 32, ni = ((K_) / 64) * nbk; if (r < ni) { const int kb = r / nbk, nb = r - kb * nbk; \
        d.src = (W_) + (size_t)(64 * kb) * (ldw_) + (c0_) + 32 * nb; d.dst = (WT_) + (size_t)((r0_) + 32 * nb) * (P_) + 64 * kb; d.ldw = (ldw_); d.ldt = (P_); break; } r -= ni; }
#define SEG(W_, ldw_, c0_, nc_, K_, WT_, r0_) SEGP(W_, ldw_, c0_, nc_, K_, K_, WT_, r0_)
#define DECODE(it_, d) do { int r = (it_); \
        SEG(w_in, D_IN, 768, 384, 1024, Wt_in, G_SV) SEG(w_in, D_IN, 1600, 64, 1024, Wt_in, G_DV) SEG(w_in, D_IN, 0, 384, 1024, Wt_in, NKV + C_SQ) SEG(w_in, D_IN, 384, 384, 1024, Wt_in, G_SK) \
        SEG(w_in, D_IN, 1152, 384, 1024, Wt_in, NKV + C_DQ) SEG(w_in, D_IN, 1536, 64, 1024, Wt_in, NKV + C_DK) SEG(w_in, D_IN, 1664, 512, 1024, Wt_in, NKV + C_IQ) SEG(w_in, D_IN, 2176, 64, 1024, Wt_in, NKV + C_IK) \
        SEG(w_in, D_IN, 2248, 512, 1024, Wt_in, NKV + C_HQ) SEG(w_in, D_IN, 2760, 512, 1024, Wt_in, NKV + C_HF) SEG(w_in, D_IN, 3272, 256, 1024, Wt_in, NKV + C_HI) SEG(w_in, D_IN, 3528, 256, 1024, Wt_in, NKV + C_HG) \
        SEG(w_in, D_IN, 3784, 3072, 1024, Wt_g, 0) SEG(w_sb, D, 0, 1024, 384, Wt_br, 0) SEG(w_dsa, D, 0, 1024, 384, Wt_br, 1024) SEGP(w_hg, D, 0, 1024, 256, 384, Wt_br, 2048) \
        SEG(w_out, D, 0, 1024, 1024, Wt_out, 0) SEG(w_up, FF, 0, 4096, 1024, Wt_up, 0) SEG(w_down, D, 0, 1024, 4096, Wt_down, 0) } while (0)
    {
        int lane = (int)threadIdx.x & 63; asm volatile("" : "+v"(lane));
        TrDesc dc, dn; float tva[32], tvb[32];
        int it = gw;
        if (it < NI_TOT) { TrDesc d; DECODE(it, d); dc = d; tr_load(dc, tva, lane); }
        while (it < NI_TOT) {
            const int itn = it + NGW; const bool more = itn < NI_TOT;
            if (more) { TrDesc d; DECODE(itn, d); dn = d; tr_load(dn, tvb, lane); }
            tr_store(dc, tva, scr, lane);
            if (more) { dc = dn;
#pragma unroll
                for (int i = 0; i < 32; ++i) tva[i] = tvb[i]; }
            it = itn;
        }
    }
#undef DECODE
#undef SEG
#undef SEGP
    static_assert(NI_IN == 16 * ((384 + 64 + 384 + 384 + 384 + 64 + 512 + 64 + 512 + 512 + 256 + 256 + 3072) / 32), "segments");
    for (int idx = F.bid * 512 + tid0; idx < 1024 * 16; idx += F.G * 512) *(u32x4*)(Wt_br + (size_t)(2048 + (idx >> 4)) * 384 + 256 + (idx & 15) * 8) = (u32x4){0u, 0u, 0u, 0u};
    for (int idx = F.bid * 512 + tid0; idx < 64 * 1024; idx += F.G * 512) { const int rr = idx >> 10, k = idx & 1023;
        Wt_in[(size_t)(NKV + C_IW + rr) * 1024 + k] = rr < 8 ? (bf16_t)(cvt_pk_bf16(w_in[(size_t)k * D_IN + 2240 + rr], 0.f) & 0xffff) : (bf16_t)0; }
}

__device__ __forceinline__ void prep_tokens(const Ctx& F, int l) {
    bf16_t* P = (bf16_t*)(F.ws + WS_BIG);
    int lane_ = ((int)threadIdx.x & 63); asm volatile("" : "+v"(lane_));
    const int gw = F.bid * 8 + F.wave, NGW = F.G * 8, lane = lane_, head = lane >> 2, part = lane & 3;
    const float* gq = F.in(3) + l * 64 + part * 16; const float* gk = F.in(4) + l * 64 + part * 16;
    float g[16];
#pragma unroll
    for (int i = 0; i < 16; ++i) g[i] = head < 6 ? gq[i] : (head == 6 ? gk[i] : 1.f);
    const float inv[8] = {1.0f, 0.19392274474868576f, 0.03760603093086393f, 0.007292664737217109f, 0.001414213562373095f, 0.0002742481756762073f, 5.318295896944988e-05f, 1.031338537721246e-05f};
    for (int m0 = gw; m0 < M; m0 += 2 * NGW) {
        const bool two = m0 + NGW < M;
        bf16_t* pp[2] = {P + (size_t)m0 * NPROJ + C_DQ + lane * 16, P + (size_t)(two ? m0 + NGW : m0) * NPROJ + C_DQ + lane * 16};
        u32x4 ra[2], rb[2];
#pragma unroll
        for (int u = 0; u < 2; ++u) { ra[u] = *(const u32x4*)pp[u]; rb[u] = *(const u32x4*)(pp[u] + 8); }
#pragma unroll
        for (int u = 0; u < 2; ++u) {
            if (u == 1 && !two) break;
            const int m = m0 + u * NGW;
            const u32x4 a = ra[u], b = rb[u];
            float v[16] = {bflo(a.x), bfhi(a.x), bflo(a.y), bfhi(a.y), bflo(a.z), bfhi(a.z), bflo(a.w), bfhi(a.w), bflo(b.x), bfhi(b.x), bflo(b.y), bfhi(b.y), bflo(b.z), bfhi(b.z), bflo(b.w), bfhi(b.w)};
            float ss = 0.f;
#pragma unroll
            for (int i = 0; i < 16; ++i) ss += v[i] * v[i];
            ss += __shfl_xor(ss, 1); ss += __shfl_xor(ss, 2);
            const float rstd = head < 7 ? 1.f / sqrtf(ss * (1.f / 64.f) + EPS) : 1.f;
#pragma unroll
            for (int i = 0; i < 16; ++i) v[i] = v[i] * rstd * g[i];
            if (part == 0) {
                const float pos = (float)(m & (T - 1));
#pragma unroll
                for (int i = 0; i < 8; ++i) { const float ang = pos * inv[i], c = __cosf(ang), sn = __sinf(ang), x1 = v[i], x2 = v[i + 8]; v[i] = x1 * c - x2 * sn; v[i + 8] = x2 * c + x1 * sn; }
            }
            u32x4 oa, ob;
            oa.x = cvt_pk_bf16(v[0], v[1]); oa.y = cvt_pk_bf16(v[2], v[3]); oa.z = cvt_pk_bf16(v[4], v[5]); oa.w = cvt_pk_bf16(v[6], v[7]);
            ob.x = cvt_pk_bf16(v[8], v[9]); ob.y = cvt_pk_bf16(v[10], v[11]); ob.z = cvt_pk_bf16(v[12], v[13]); ob.w = cvt_pk_bf16(v[14], v[15]);
            if (head == 6 || head == 15) {
                const int bb = m >> 11, tt = m & (T - 1);
                bf16_t* kf = (bf16_t*)(F.ws + (head == 6 ? WS_KF_DSA : WS_KF_IDX)) + (size_t)(((bb * 64 + (tt >> 5)) * 4 + part)) * 512 + (tt & 31) * 8;
                *(u32x4*)kf = oa; *(u32x4*)(kf + 256) = ob;
            } else { *(u32x4*)pp[u] = oa; *(u32x4*)(pp[u] + 8) = ob; }
        }
    }
}

__device__ __forceinline__ f32x16 mfma32(bf16x8 a, bf16x8 b, f32x16 c) { return __builtin_amdgcn_mfma_f32_32x32x16_bf16(a, b, c, 0, 0, 0); }
__device__ __forceinline__ bf16x8 ld_frag(const bf16_t* p) { return *(const bf16x8*)p; }
__device__ __forceinline__ bf16x8 ld_vfrag(const bf16_t* p) {
    const u32x2 a = *(const u32x2*)p, b = *(const u32x2*)(p + 8); u32x4 w = {a.x, a.y, b.x, b.y}; return __builtin_bit_cast(bf16x8, w);
}
__device__ __forceinline__ bf16x8 pack_p(const f32x16& p, int s) {
    u32x4 w; w.x = cvt_pk_bf16(p[8 * s + 0], p[8 * s + 1]); w.y = cvt_pk_bf16(p[8 * s + 2], p[8 * s + 3]); w.z = cvt_pk_bf16(p[8 * s + 4], p[8 * s + 5]); w.w = cvt_pk_bf16(p[8 * s + 6], p[8 * s + 7]);
    return __builtin_bit_cast(bf16x8, w);
}
__device__ __forceinline__ void store_ot(bf16_t* orow  , const f32x16& o0, const f32x16& o1, int h, float sc) {
#pragma unroll
    for (int g = 0; g < 4; ++g) {
        u32x2 w0, w1; w0.x = cvt_pk_bf16(o0[4 * g] * sc, o0[4 * g + 1] * sc); w0.y = cvt_pk_bf16(o0[4 * g + 2] * sc, o0[4 * g + 3] * sc);
        w1.x = cvt_pk_bf16(o1[4 * g] * sc, o1[4 * g + 1] * sc); w1.y = cvt_pk_bf16(o1[4 * g + 2] * sc, o1[4 * g + 3] * sc);
        *(u32x2*)(orow + 8 * g + 4 * h) = w0; *(u32x2*)(orow + 32 + 8 * g + 4 * h) = w1;
    }
}

#define LOAD_KV(KF, VA, kp_, vp_) do { _Pragma("unroll") for (int s_ = 0; s_ < 4; ++s_) KF[s_] = ld_frag((kp_) + 512 * s_); \
    _Pragma("unroll") for (int db_ = 0; db_ < 2; ++db_) _Pragma("unroll") for (int s_ = 0; s_ < 2; ++s_) VA[db_][s_] = ld_frag((vp_) + 512 * (2 * db_ + s_)); } while (0)

__device__ __forceinline__ void sb_item(const Ctx& F, int b, int hh, int qt) {
    const bf16_t* P = (const bf16_t*)(F.ws + WS_BIG); bf16_t* BR = (bf16_t*)(F.ws + WS_BR);
    int lane_ = ((int)threadIdx.x & 63); asm volatile("" : "+v"(lane_));
    const int lane = lane_, c = lane & 31, h = lane >> 5, tb = b * T, q0 = 32 * qt, tq = q0 + c;
    bf16x8 qf[4];
#pragma unroll
    for (int s = 0; s < 4; ++s) qf[s] = ld_frag(P + (size_t)(tb + q0 + c) * NPROJ + C_SQ + hh * 64 + 16 * s + 8 * h);
    f32x16 o0, o1;
#pragma unroll
    for (int i = 0; i < 16; ++i) { o0[i] = 0.f; o1[i] = 0.f; }
    float carry = 0.f;
    const bf16_t* kp0 = (const bf16_t*)(F.ws + WS_KF_SB) + (size_t)((b * 6 + hh) * 64) * 2048 + lane * 8;
    const bf16_t* vt0 = (const bf16_t*)(F.ws + WS_VF_SB) + (size_t)((b * 6 + hh) * 64) * 2048 + lane * 8;
    bf16x8 kfn[4], van[2][2];
    LOAD_KV(kfn, van, kp0 + (size_t)qt * 2048, vt0 + (size_t)qt * 2048);
    for (int kt = qt; kt >= 0; --kt) {
        const int key0 = 32 * kt;
        bf16x8 kf[4], va[2][2];
#pragma unroll
        for (int s = 0; s < 4; ++s) kf[s] = kfn[s];
#pragma unroll
        for (int db = 0; db < 2; ++db) { va[db][0] = van[db][0]; va[db][1] = van[db][1]; }
        if (kt > 0) LOAD_KV(kfn, van, kp0 + (size_t)(kt - 1) * 2048, vt0 + (size_t)(kt - 1) * 2048);
        f32x16 st;
#pragma unroll
        for (int i = 0; i < 16; ++i) st[i] = 0.f;
#pragma unroll
        for (int s = 0; s < 4; ++s) st = mfma32(kf[s], qf[s], st);
        float z[16], lm[16];
#pragma unroll
        for (int r = 0; r < 16; ++r) {
            const int key = key0 + (r & 3) + 8 * (r >> 2) + 4 * h;
            z[r] = st[r] * 0.125f;
            const float az = fabsf(z[r]);
            const float sp = fmaxf(z[r], 0.f) + flog2(1.f + fexp(-az)) * 0.6931471805599453f;
            lm[r] = key < tq ? -sp : 0.f;
        }
        float gs[4], pg[4], hi[4];
#pragma unroll
        for (int g = 0; g < 4; ++g) { gs[g] = (lm[4 * g] + lm[4 * g + 1]) + (lm[4 * g + 2] + lm[4 * g + 3]); pg[g] = __shfl_xor(gs[g], 32); }
        hi[3] = 0.f; hi[2] = gs[3] + pg[3]; hi[1] = hi[2] + gs[2] + pg[2]; hi[0] = hi[1] + gs[1] + pg[1];
        const float tot = hi[0] + gs[0] + pg[0];
        f32x16 pa;
#pragma unroll
        for (int g = 0; g < 4; ++g) {
            float run = carry + hi[g] + (h == 0 ? pg[g] : 0.f);
#pragma unroll
            for (int i = 3; i >= 0; --i) {
                const int r = 4 * g + i; const int key = key0 + (r & 3) + 8 * (r >> 2) + 4 * h;
                run += lm[r];
                pa[r] = key < tq ? fexp(z[r] + run) : 0.f;
            }
        }
        carry += tot;
        const bf16x8 pb0 = pack_p(pa, 0), pb1 = pack_p(pa, 1);
        o0 = mfma32(va[0][0], pb0, o0); o0 = mfma32(va[0][1], pb1, o0);
        o1 = mfma32(va[1][0], pb0, o1); o1 = mfma32(va[1][1], pb1, o1);
        if (__all(carry < -104.f)) break;
    }
    store_ot(BR + (size_t)(tb + tq) * D + hh * 64, o0, o1, h, 1.f);
}

__device__ __forceinline__ void dsa_item(const Ctx& F, int b, int hh, int qt) {
    const bf16_t* P = (const bf16_t*)(F.ws + WS_BIG); bf16_t* BR = (bf16_t*)(F.ws + WS_BR);
    const unsigned* MK = (const unsigned*)(F.ws + WS_MASK);
    int lane_ = ((int)threadIdx.x & 63); asm volatile("" : "+v"(lane_));
    const int lane = lane_, c = lane & 31, h = lane >> 5, tb = b * T, q0 = 32 * qt, tq = q0 + c;
    bf16x8 qf[4];
#pragma unroll
    for (int s = 0; s < 4; ++s) qf[s] = ld_frag(P + (size_t)(tb + q0 + c) * NPROJ + C_DQ + hh * 64 + 16 * s + 8 * h);
    f32x16 o0, o1;
#pragma unroll
    for (int i = 0; i < 16; ++i) { o0[i] = 0.f; o1[i] = 0.f; }
    float mrun = -1e30f, lrun = 0.f;
    const bf16_t* kp0 = (const bf16_t*)(F.ws + WS_KF_DSA) + (size_t)(b * 64) * 2048 + lane * 8;
    const bf16_t* vt0 = (const bf16_t*)(F.ws + WS_VF_DSA) + (size_t)(b * 64) * 2048 + lane * 8;
    const unsigned* mrow = MK + (size_t)(tb + tq) * 64;
    bf16x8 kfn[4], van[2][2]; unsigned mwn = mrow[0];
    LOAD_KV(kfn, van, kp0, vt0);
    constexpr float SC2 = 0.125f * LOG2E;
    for (int kt = 0; kt <= qt; ++kt) {
        bf16x8 kf[4], va[2][2]; const unsigned mw = mwn;
#pragma unroll
        for (int s = 0; s < 4; ++s) kf[s] = kfn[s];
#pragma unroll
        for (int db = 0; db < 2; ++db) { va[db][0] = van[db][0]; va[db][1] = van[db][1]; }
        if (kt < qt) { mwn = mrow[kt + 1]; LOAD_KV(kfn, van, kp0 + (size_t)(kt + 1) * 2048, vt0 + (size_t)(kt + 1) * 2048); }
        if (!__any(mw != 0u)) continue;
        f32x16 st;
#pragma unroll
        for (int i = 0; i < 16; ++i) st[i] = 0.f;
#pragma unroll
        for (int s = 0; s < 4; ++s) st = mfma32(kf[s], qf[s], st);
        float mx = fmaxf(fmaxf(fmaxf(st[0], st[1]), fmaxf(st[2], st[3])), fmaxf(fmaxf(st[4], st[5]), fmaxf(st[6], st[7])));
        mx = fmaxf(mx, fmaxf(fmaxf(fmaxf(st[8], st[9]), fmaxf(st[10], st[11])), fmaxf(fmaxf(st[12], st[13]), fmaxf(st[14], st[15]))));
        mx = fmaxf(mx, __shfl_xor(mx, 32));
        const float mnew = fmaxf(mrun, mx);
        if (__any(mnew > mrun)) {
            const float alpha = fexp2((mrun - mnew) * SC2);
            lrun *= alpha;
#pragma unroll
            for (int i = 0; i < 16; ++i) { o0[i] *= alpha; o1[i] *= alpha; }
            mrun = mnew;
        }
        const float nm = -mrun * SC2; const unsigned mh = mw >> (4 * h);
        float ps = 0.f; f32x16 pa;
#pragma unroll
        for (int r = 0; r < 16; ++r) {
            const unsigned keep = (unsigned)__builtin_amdgcn_sbfe((int)mh, (r & 3) + 8 * (r >> 2), 1);
            pa[r] = __builtin_bit_cast(float, __builtin_bit_cast(unsigned, fexp2(__builtin_fmaf(st[r], SC2, nm))) & keep); ps += pa[r];
        }
        ps += __shfl_xor(ps, 32);
        lrun += ps;
        const bf16x8 pb0 = pack_p(pa, 0), pb1 = pack_p(pa, 1);
        o0 = mfma32(va[0][0], pb0, o0); o0 = mfma32(va[0][1], pb1, o0);
        o1 = mfma32(va[1][0], pb0, o1); o1 = mfma32(va[1][1], pb1, o1);
    }
    store_ot(BR + (size_t)(tb + tq) * D + 384 + hh * 64, o0, o1, h, 1.f / lrun);
}

constexpr int SCP = 2052;
constexpr float IDX_SCALE = 0.044194173824159216f;
__device__ __forceinline__ unsigned mono_key(float f) { const unsigned u = __builtin_bit_cast(unsigned, f); return (u & 0x80000000u) ? ~u : (u | 0x80000000u); }
__device__ __forceinline__ int popc64(unsigned long long m) { return __builtin_popcountll(m); }
__device__ __forceinline__ int cnt_ge8(unsigned v0, unsigned v1, unsigned v2, unsigned v3, unsigned v4, unsigned v5, unsigned v6, unsigned v7, unsigned c) {
    unsigned long long m0, m1, m2, m3, m4, m5, m6, m7;
    asm("v_cmp_le_u32_e64 %0, %8, %9\n\tv_cmp_le_u32_e64 %1, %8, %10\n\tv_cmp_le_u32_e64 %2, %8, %11\n\tv_cmp_le_u32_e64 %3, %8, %12\n\t"
        "v_cmp_le_u32_e64 %4, %8, %13\n\tv_cmp_le_u32_e64 %5, %8, %14\n\tv_cmp_le_u32_e64 %6, %8, %15\n\tv_cmp_le_u32_e64 %7, %8, %16"
        : "=&s"(m0), "=&s"(m1), "=&s"(m2), "=&s"(m3), "=&s"(m4), "=&s"(m5), "=&s"(m6), "=&s"(m7)
        : "s"(c), "v"(v0), "v"(v1), "v"(v2), "v"(v3), "v"(v4), "v"(v5), "v"(v6), "v"(v7));
    return (__builtin_popcountll(m0) + __builtin_popcountll(m1)) + (__builtin_popcountll(m2) + __builtin_popcountll(m3)) + (__builtin_popcountll(m4) + __builtin_popcountll(m5)) + (__builtin_popcountll(m6) + __builtin_popcountll(m7));
}
__device__ __forceinline__ int wave_count6(int c) {
    int tot = 0;
#pragma unroll
    for (int b = 0; b < 6; ++b) tot += popc64(__ballot((c >> b) & 1)) << b;
    return tot;
}
__device__ __forceinline__ unsigned long long sel_mask(const unsigned (&uk)[32], unsigned U, int n, int lane, bool exact) {
    unsigned long long mine = 0ull;
    if (exact && n > 256) {
#pragma unroll
        for (int i = 0; i < 32; ++i) { const unsigned long long mk = __ballot(uk[i] >= U); if (lane == i) mine = mk; }
        return mine;
    }
    if (n <= 256) {
#pragma unroll
        for (int i = 0; i < 4; ++i) { const unsigned long long mk = __ballot(i * 64 + lane < n); if (lane == i) mine = mk; }
        return mine;
    }
    int cgt = 0, ce = 0;
#pragma unroll
    for (int i = 0; i < 32; ++i) { cgt += popc64(__ballot(uk[i] > U)); ce += popc64(__ballot(uk[i] == U)); }
    const int need = 256 - cgt;
    int X = 4096;
    if (ce > need) {
        int lo = 0, hi = 2047;
#pragma unroll 1
        while (lo < hi) {
            const int mid = (lo + hi) >> 1; int cl = 0;
#pragma unroll
            for (int i = 0; i < 32; ++i) cl += popc64(__ballot((uk[i] == U) & (i * 64 + lane <= mid)));
            if (cl >= need) hi = mid; else lo = mid + 1;
        }
        X = lo;
    }
#pragma unroll
    for (int i = 0; i < 32; ++i) {
        const unsigned long long mk = __ballot((uk[i] > U) | ((uk[i] == U) & (i * 64 + lane <= X)));
        if (lane == i) mine = mk;
    }
    return mine;
}
__device__ __forceinline__ void index_items(const Ctx& F, int do_sel = 1) {
    const bf16_t* P = (const bf16_t*)(F.ws + WS_BIG); unsigned long long* MK = (unsigned long long*)(F.ws + WS_MASK);
    LAS float* sc = (LAS float*)F.lds;
    int lane_ = ((int)threadIdx.x & 63); asm volatile("" : "+v"(lane_));
    const int lane = lane_, c = lane & 31, h = lane >> 5, wave = F.wave, qq = c & 15, hsel = c >> 4;
    bf16x8 qi[4][4], qn[4][4]; float wv[4], wn[4];
#define IDX_LOADQ(QI, WV, it_) do { const bf16_t* qrow = P + (size_t)(((it_) & 7) * T + 16 * (127 - ((it_) >> 3)) + qq) * NPROJ; \
        _Pragma("unroll") for (int g = 0; g < 4; ++g) { _Pragma("unroll") for (int s = 0; s < 4; ++s) QI[g][s] = ld_frag(qrow + C_IQ + (2 * g + hsel) * 64 + 16 * s + 8 * h); \
            WV[g] = bf2f(qrow[C_IW + 2 * g + hsel]) * IDX_SCALE; } } while (0)
    if (F.bid < NB * 128) IDX_LOADQ(qi, wv, F.bid);
    for (int it = F.bid; it < NB * 128; it += F.G) {
    const int b = it & 7, qb = 127 - (it >> 3), tb = b * T, q0 = 16 * qb;
    const int ntiles = (q0 + 16 + 31) >> 5;
    {
#define IDX_TILE(KF, key0_) do { float sa[16]; \
            _Pragma("unroll") for (int r = 0; r < 16; ++r) sa[r] = 0.f; \
            _Pragma("unroll") for (int g = 0; g < 4; ++g) { f32x16 st; \
                _Pragma("unroll") for (int i = 0; i < 16; ++i) st[i] = 0.f; \
                _Pragma("unroll") for (int s = 0; s < 4; ++s) st = mfma32(KF[s], qi[g][s], st); \
                _Pragma("unroll") for (int r = 0; r < 16; ++r) sa[r] += wv[g] * fmaxf(st[r], 0.f); } \
            _Pragma("unroll") for (int r = 0; r < 16; ++r) sa[r] += __shfl_xor(sa[r], 16); \
            if (hsel == 0) { _Pragma("unroll") for (int g4 = 0; g4 < 4; ++g4) *(LAS f32x4*)(sc + qq * SCP + (key0_) + 8 * g4 + 4 * h) = (f32x4){sa[4 * g4], sa[4 * g4 + 1], sa[4 * g4 + 2], sa[4 * g4 + 3]}; } } while (0)
        const bf16_t* kbase = (const bf16_t*)(F.ws + WS_KF_IDX) + (size_t)(b * 64) * 2048 + lane * 8;
        for (int kt = wave; kt < ntiles; kt += 16) {
            const int kt2 = kt + 8; const bool two = kt2 < ntiles;
            bf16x8 kfa[4], kfb[4];
#pragma unroll
            for (int s = 0; s < 4; ++s) kfa[s] = ld_frag(kbase + (size_t)kt * 2048 + 512 * s);
            if (two) {
#pragma unroll
                for (int s = 0; s < 4; ++s) kfb[s] = ld_frag(kbase + (size_t)kt2 * 2048 + 512 * s);
            }
            IDX_TILE(kfa, 32 * kt);
            if (two) IDX_TILE(kfb, 32 * kt2);
        }
#undef IDX_TILE
    }
    __syncthreads();
    if (it + F.G < NB * 128) IDX_LOADQ(qn, wn, it + F.G);
    if (do_sel) {
        const int qA = 2 * wave, nA = q0 + qA + 1, nB = nA + 1;
        unsigned ua[32], ub[32];
        {
            float sv[32];
#pragma unroll
            for (int i = 0; i < 32; ++i) sv[i] = sc[qA * SCP + i * 64 + lane];
#pragma unroll
            for (int i = 0; i < 32; ++i) ua[i] = (i * 64 + lane < nA) ? mono_key(sv[i]) : 0u;
#pragma unroll
            for (int i = 0; i < 32; ++i) sv[i] = sc[(qA + 1) * SCP + i * 64 + lane];
#pragma unroll
            for (int i = 0; i < 32; ++i) ub[i] = (i * 64 + lane < nB) ? mono_key(sv[i]) : 0u;
        }
        unsigned UA = 0u, UB = 0u; int cntA = 4096, cntB = 4096;
        if (nB > 256) {
            const int nb8 = (nB + 511) >> 9;
#pragma unroll 1
            for (int bit = 31; bit >= 0; --bit) {
                if (cntA == 256 && cntB == 256) break;
                const unsigned ca = UA | (1u << bit), cb = UB | (1u << bit); int na = 0, nbc = 0;
#pragma unroll
                for (int bk = 0; bk < 4; ++bk) if (bk < nb8) {
                    na += cnt_ge8(ua[8 * bk], ua[8 * bk + 1], ua[8 * bk + 2], ua[8 * bk + 3], ua[8 * bk + 4], ua[8 * bk + 5], ua[8 * bk + 6], ua[8 * bk + 7], ca);
                    nbc += cnt_ge8(ub[8 * bk], ub[8 * bk + 1], ub[8 * bk + 2], ub[8 * bk + 3], ub[8 * bk + 4], ub[8 * bk + 5], ub[8 * bk + 6], ub[8 * bk + 7], cb);
                }
                if (na >= 256) { UA = ca; cntA = na; }
                if (nbc >= 256) { UB = cb; cntB = nbc; }
            }
        }
        const unsigned long long mA = sel_mask(ua, UA, nA, lane, cntA == 256), mB = sel_mask(ub, UB, nB, lane, cntB == 256);
        if (lane < 32) { MK[(size_t)(tb + q0 + qA) * 32 + lane] = mA; MK[(size_t)(tb + q0 + qA + 1) * 32 + lane] = mB; }
    }
    __syncthreads();
    if (it + F.G < NB * 128) {
#pragma unroll
        for (int g = 0; g < 4; ++g) { wv[g] = wn[g];
#pragma unroll
            for (int s2 = 0; s2 < 4; ++s2) qi[g][s2] = qn[g][s2]; }
    }
    }
#undef IDX_LOADQ
}

constexpr int HP = 132, AP = 72, KP = 136, TP = 72, OP = 68;
constexpr int H_Q = 0, H_K = 64 * HP * 4, H_B = 2 * 64 * HP * 4;
constexpr int H_ATT = 3 * 64 * HP * 4;
constexpr int H_K2 = H_ATT + 64 * AP * 2;
constexpr int H_KT = H_K2 + 64 * KP * 2;
constexpr int H_DV = H_KT + 128 * TP * 2;
constexpr int H_END = H_DV + 512;
static_assert(H_END <= LDS_BYTES && 64 * KP * 2 <= 64 * HP * 4 && 64 * OP * 4 <= 64 * HP * 4 && 4 * 128 * 4 <= 64 * AP * 2, "hgrn lds");
__device__ __forceinline__ f32x4 mfma16(bf16x8 a, bf16x8 b, f32x4 c) { return __builtin_amdgcn_mfma_f32_16x16x32_bf16(a, b, c, 0, 0, 0); }
__device__ __forceinline__ bf16x8 pack8(const float* v) { u32x4 w; w.x = cvt_pk_bf16(v[0], v[1]); w.y = cvt_pk_bf16(v[2], v[3]); w.z = cvt_pk_bf16(v[4], v[5]); w.w = cvt_pk_bf16(v[6], v[7]); return __builtin_bit_cast(bf16x8, w); }
__device__ __forceinline__ bf16_t bf1(float a) { return (bf16_t)(cvt_pk_bf16(a, 0.f) & 0xffffu); }

template <int MODE>
__device__ __forceinline__ void hgrn_item(const Ctx& F, int l, int b, int hh, int sc) {
    const bf16_t* P = (const bf16_t*)(F.ws + WS_BIG); bf16_t* BR = (bf16_t*)(F.ws + WS_BR); float* HST = (float*)(F.ws + WS_HST);
    LAS unsigned char* L = F.lds;
    LAS float* qS = (LAS float*)(L + H_Q); LAS float* kS = (LAS float*)(L + H_K); LAS float* bS = (LAS float*)(L + H_B); LAS float* tot = (LAS float*)(L + H_ATT); LAS float* Dv = (LAS float*)(L + H_DV);
    LAS bf16_t* att = (LAS bf16_t*)(L + H_ATT); LAS bf16_t* k2 = (LAS bf16_t*)(L + H_K2); LAS bf16_t* kT = (LAS bf16_t*)(L + H_KT); LAS bf16_t* sT = (LAS bf16_t*)(L + H_B); LAS float* oS = (LAS float*)(L + H_Q);
    int tid_ = threadIdx.x; asm volatile("" : "+v"(tid_));
    const int tid = tid_, lane = tid & 63, w = F.wave, n16 = lane & 15, g4 = lane >> 4, tb = b * T + sc * 256;
    const int item = (b * 4 + hh) * 8 + sc;
    f32x4 S[4]; float Dt[4] = {1.f, 1.f, 1.f, 1.f};
#pragma unroll
    for (int i = 0; i < 4; ++i) S[i] = (f32x4){0.f, 0.f, 0.f, 0.f};
    if (MODE == 1 && sc > 0) {
        const float* hp0 = HST + (size_t)((b * 4 + hh) * 8) * HST_STRIDE;
        float dc[4], dn[4]; f32x4 cs[4], ns[4];
#pragma unroll
        for (int r = 0; r < 4; ++r) { const int kk = 16 * w + 4 * g4 + r; dc[r] = hp0[8192 + kk];
#pragma unroll
            for (int vt = 0; vt < 4; ++vt) cs[vt][r] = hp0[kk * 64 + 16 * vt + n16]; }
        for (int i = 0; i < sc; ++i) {
            if (i + 1 < sc) { const float* hp = hp0 + (size_t)(i + 1) * HST_STRIDE;
#pragma unroll
                for (int r = 0; r < 4; ++r) { const int kk = 16 * w + 4 * g4 + r; dn[r] = hp[8192 + kk];
#pragma unroll
                    for (int vt = 0; vt < 4; ++vt) ns[vt][r] = hp[kk * 64 + 16 * vt + n16]; } }
#pragma unroll
            for (int r = 0; r < 4; ++r)
#pragma unroll
                for (int vt = 0; vt < 4; ++vt) S[vt][r] = dc[r] * S[vt][r] + cs[vt][r];
            if (i + 1 < sc) {
#pragma unroll
                for (int r = 0; r < 4; ++r) dc[r] = dn[r];
#pragma unroll
                for (int vt = 0; vt < 4; ++vt) cs[vt] = ns[vt]; }
        }
    }
    const int lcg = (tid & 15) * 8;
    float lb[8];
#pragma unroll
    for (int e = 0; e < 8; ++e) {
        float v = 0.f;
        if (l == 1) { const float l0 = F.in(5)[hh * 128 + lcg + e], l1 = F.in(5)[512 + hh * 128 + lcg + e]; v = 1.f / (1.f + expf(l0 - l1)); }
        lb[e] = v;
    }
    const bf16_t* vf0 = (const bf16_t*)(F.ws + WS_VF_HG) + (size_t)(((b * 4 + hh) * 32 + sc * 4) * 8) * 512 + lane * 8;
    float onv[8];
#pragma unroll
    for (int e = 0; e < 8; ++e) onv[e] = (MODE == 1) ? F.in(6)[l * 64 + (tid & 7) * 8 + e] : 0.f;
    u32x4 fwn[2], qwn[2];
#pragma unroll
    for (int i = 0; i < 2; ++i) { const bf16_t* src = P + (size_t)(tb + ((tid + 512 * i) >> 4)) * NPROJ + hh * 128 + lcg; fwn[i] = *(const u32x4*)(src + C_HF); if (MODE == 1) qwn[i] = *(const u32x4*)(src + C_HQ); }
#pragma unroll 1
    for (int c = 0; c < 4; ++c) {
        const int tok0 = tb + c * 64;
        u32x4 gwp = {0u, 0u, 0u, 0u};
        if (MODE == 1) gwp = *(const u32x4*)(P + (size_t)(tok0 + (tid >> 3)) * NPROJ + C_HG + hh * 64 + (tid & 7) * 8);
        bf16x8 vf[4][2];
#pragma unroll
        for (int vt = 0; vt < 4; ++vt) { vf[vt][0] = ld_frag(vf0 + (size_t)(c * 8 + vt * 2) * 512); vf[vt][1] = ld_frag(vf0 + (size_t)(c * 8 + vt * 2 + 1) * 512); }
#pragma unroll
        for (int i = 0; i < 2; ++i) {
            const int p = tid + 512 * i, row = p >> 4;
            const u32x4 fw = fwn[i];
            const float fx[8] = {bflo(fw.x), bfhi(fw.x), bflo(fw.y), bfhi(fw.y), bflo(fw.z), bfhi(fw.z), bflo(fw.w), bfhi(fw.w)};
            float kv[8], bv[8];
#pragma unroll
            for (int e = 0; e < 8; ++e) { const float f = lb[e] + (1.f - lb[e]) * sigmoidf_(fx[e]); kv[e] = 1.f - f; bv[e] = flog2(fmaxf(f, 1e-12f)); }
            *(LAS f32x4*)(kS + row * HP + lcg) = (f32x4){kv[0], kv[1], kv[2], kv[3]}; *(LAS f32x4*)(kS + row * HP + lcg + 4) = (f32x4){kv[4], kv[5], kv[6], kv[7]};
            *(LAS f32x4*)(bS + row * HP + lcg) = (f32x4){bv[0], bv[1], bv[2], bv[3]}; *(LAS f32x4*)(bS + row * HP + lcg + 4) = (f32x4){bv[4], bv[5], bv[6], bv[7]};
            if (MODE == 1) {
                const u32x4 qw = qwn[i];
                const float qx[8] = {bflo(qw.x), bfhi(qw.x), bflo(qw.y), bfhi(qw.y), bflo(qw.z), bfhi(qw.z), bflo(qw.w), bfhi(qw.w)};
                float qv[8];
#pragma unroll
                for (int e = 0; e < 8; ++e) qv[e] = qx[e] * sigmoidf_(qx[e]);
                *(LAS f32x4*)(qS + row * HP + lcg) = (f32x4){qv[0], qv[1], qv[2], qv[3]}; *(LAS f32x4*)(qS + row * HP + lcg + 4) = (f32x4){qv[4], qv[5], qv[6], qv[7]};
            }
        }
        if (c < 3) {
#pragma unroll
            for (int i = 0; i < 2; ++i) { const bf16_t* src = P + (size_t)(tok0 + 64 + ((tid + 512 * i) >> 4)) * NPROJ + hh * 128 + lcg; fwn[i] = *(const u32x4*)(src + C_HF); if (MODE == 1) qwn[i] = *(const u32x4*)(src + C_HQ); }
        }
        __syncthreads();
        {
            const int part = tid >> 7, k2i = tid & 127;
            float pv[16]; float run = 0.f;
#pragma unroll
            for (int i = 0; i < 16; ++i) { run += bS[(part * 16 + i) * HP + k2i]; pv[i] = run; }
            tot[part * 128 + k2i] = run;
            __syncthreads();
            float pre = 0.f;
#pragma unroll
            for (int pp = 0; pp < 3; ++pp) if (pp < part) pre += tot[pp * 128 + k2i];
#pragma unroll
            for (int i = 0; i < 16; ++i) bS[(part * 16 + i) * HP + k2i] = pv[i] + pre;
        }
        __syncthreads();
        if (MODE == 1) {
            {
                const int t = tid >> 3, j = tid & 7, G = t >> 3, s = 8 * G + j;
                float a = 0.f;
                if (s <= t) {
#pragma unroll 4
                    for (int k4 = 0; k4 < 128; k4 += 4) {
                        const f32x4 q4 = *(const LAS f32x4*)(qS + t * HP + k4), bt = *(const LAS f32x4*)(bS + t * HP + k4), kx = *(const LAS f32x4*)(kS + s * HP + k4), bs = *(const LAS f32x4*)(bS + s * HP + k4);
                        a += q4.x * kx.x * fexp2(bt.x - bs.x) + q4.y * kx.y * fexp2(bt.y - bs.y) + q4.z * kx.z * fexp2(bt.z - bs.z) + q4.w * kx.w * fexp2(bt.w - bs.w);
                    }
                }
                att[t * AP + s] = bf1(a);
                for (int g2 = G + 1; g2 < 8; ++g2) att[t * AP + 8 * g2 + j] = (bf16_t)0;
            }
#pragma unroll
            for (int i = 0; i < 2; ++i) {
                const int p = tid + 512 * i, row = p >> 4, er = (row | 7);
                float kv[8];
#pragma unroll
                for (int e = 0; e < 8; ++e) kv[e] = kS[row * HP + lcg + e] * fexp2(bS[er * HP + lcg + e] - bS[row * HP + lcg + e]);
                *(LAS bf16x8*)(k2 + row * KP + lcg) = pack8(kv);
            }
            __syncthreads();
            for (int pr = w; pr < 16; pr += 8) {
                int I = 0, G = pr; while (G > 2 * I) { G -= 2 * I + 1; ++I; }
                const int t = 16 * I + n16, er = 8 * G + 7, sB = 8 * G + n16;
                f32x4 acc = {0.f, 0.f, 0.f, 0.f};
#pragma unroll
                for (int ks = 0; ks < 4; ++ks) {
                    const int k0 = 32 * ks + 8 * g4;
                    float qv[8];
#pragma unroll
                    for (int hs = 0; hs < 2; ++hs) {
                        const f32x4 q4 = *(const LAS f32x4*)(qS + t * HP + k0 + 4 * hs), bt = *(const LAS f32x4*)(bS + t * HP + k0 + 4 * hs), be = *(const LAS f32x4*)(bS + er * HP + k0 + 4 * hs);
                        qv[4 * hs] = q4.x * fexp2(fminf(bt.x - be.x, 0.f)); qv[4 * hs + 1] = q4.y * fexp2(fminf(bt.y - be.y, 0.f)); qv[4 * hs + 2] = q4.z * fexp2(fminf(bt.z - be.z, 0.f)); qv[4 * hs + 3] = q4.w * fexp2(fminf(bt.w - be.w, 0.f));
                    }
                    const bf16x8 bfr = *(const LAS bf16x8*)(k2 + (sB < 64 ? sB : 63) * KP + k0);
                    acc = mfma16(pack8(qv), bfr, acc);
                }
                if (n16 < 8) {
#pragma unroll
                    for (int r = 0; r < 4; ++r) { const int tt = 16 * I + 4 * g4 + r; if ((tt >> 3) > G) att[tt * AP + 8 * G + n16] = bf1(acc[r]); }
                }
            }
            __syncthreads();
        }
        if (tid < 128) Dv[tid] = fexp2(bS[63 * HP + tid]);
        if (MODE == 1) {
#pragma unroll
            for (int i = 0; i < 2; ++i) {
                const int p = tid + 512 * i, row = p >> 4;
                float qv[8];
#pragma unroll
                for (int e = 0; e < 8; ++e) qv[e] = qS[row * HP + lcg + e] * fexp2(bS[row * HP + lcg + e]);
                *(LAS bf16x8*)(k2 + row * KP + lcg) = pack8(qv);
            }
        }
#pragma unroll
        for (int i = 0; i < 2; ++i) {
            const int p = tid + 512 * i, kk = p & 127, sg = p >> 7;
            const float b63 = bS[63 * HP + kk];
            float kv[8];
#pragma unroll
            for (int e = 0; e < 8; ++e) kv[e] = kS[(8 * sg + e) * HP + kk] * fexp2(b63 - bS[(8 * sg + e) * HP + kk]);
            *(LAS bf16x8*)(kT + kk * TP + 8 * sg) = pack8(kv);
        }
        __syncthreads();
        if (MODE == 1) {
#pragma unroll
            for (int vt = 0; vt < 4; ++vt) { u32x2 pk; pk.x = cvt_pk_bf16(S[vt][0], S[vt][1]); pk.y = cvt_pk_bf16(S[vt][2], S[vt][3]); *(LAS u32x2*)(sT + (16 * vt + n16) * KP + 16 * w + 4 * g4) = pk; }
            __syncthreads();
            if (w < 4) {
                const int t = 16 * w + n16;
                f32x4 o[4];
#pragma unroll
                for (int vt = 0; vt < 4; ++vt) o[vt] = (f32x4){0.f, 0.f, 0.f, 0.f};
#pragma unroll
                for (int ks = 0; ks < 2; ++ks) { const bf16x8 a = *(const LAS bf16x8*)(att + t * AP + 32 * ks + 8 * g4);
#pragma unroll
                    for (int vt = 0; vt < 4; ++vt) o[vt] = mfma16(a, vf[vt][ks], o[vt]); }
#pragma unroll
                for (int ks = 0; ks < 4; ++ks) { const bf16x8 a = *(const LAS bf16x8*)(k2 + t * KP + 32 * ks + 8 * g4);
#pragma unroll
                    for (int vt = 0; vt < 4; ++vt) o[vt] = mfma16(a, *(const LAS bf16x8*)(sT + (16 * vt + n16) * KP + 32 * ks + 8 * g4), o[vt]); }
#pragma unroll
                for (int vt = 0; vt < 4; ++vt)
#pragma unroll
                    for (int r = 0; r < 4; ++r) oS[(16 * w + 4 * g4 + r) * OP + 16 * vt + n16] = o[vt][r];
            }
            __syncthreads();
            {
                const int t = tid >> 3, v0 = (tid & 7) * 8;
                const f32x4 oa = *(const LAS f32x4*)(oS + t * OP + v0), ob = *(const LAS f32x4*)(oS + t * OP + v0 + 4);
                float ss = (oa.x * oa.x + oa.y * oa.y) + (oa.z * oa.z + oa.w * oa.w) + (ob.x * ob.x + ob.y * ob.y) + (ob.z * ob.z + ob.w * ob.w);
                ss += __shfl_xor(ss, 1); ss += __shfl_xor(ss, 2); ss += __shfl_xor(ss, 4);
                const float rstd = 1.f / sqrtf(ss * (1.f / 64.f) + EPS);
                const u32x4 gw = gwp;
                const float gx[8] = {bflo(gw.x), bfhi(gw.x), bflo(gw.y), bfhi(gw.y), bflo(gw.z), bfhi(gw.z), bflo(gw.w), bfhi(gw.w)};
                const float ov[8] = {oa.x, oa.y, oa.z, oa.w, ob.x, ob.y, ob.z, ob.w};
                float y[8];
#pragma unroll
                for (int e = 0; e < 8; ++e) y[e] = ov[e] * rstd * onv[e] * (gx[e] * sigmoidf_(gx[e]));
                u32x4 wv; wv.x = cvt_pk_bf16(y[0], y[1]); wv.y = cvt_pk_bf16(y[2], y[3]); wv.z = cvt_pk_bf16(y[4], y[5]); wv.w = cvt_pk_bf16(y[6], y[7]);
                *(u32x4*)(BR + (size_t)(tok0 + t) * D + 768 + hh * 64 + v0) = wv;
            }
        }
        {
            bf16x8 ka[2];
#pragma unroll
            for (int ks = 0; ks < 2; ++ks) ka[ks] = *(const LAS bf16x8*)(kT + (16 * w + n16) * TP + 32 * ks + 8 * g4);
#pragma unroll
            for (int r = 0; r < 4; ++r) { const float d = Dv[16 * w + 4 * g4 + r]; Dt[r] *= d;
#pragma unroll
                for (int vt = 0; vt < 4; ++vt) S[vt][r] *= d; }
#pragma unroll
            for (int vt = 0; vt < 4; ++vt) { S[vt] = mfma16(ka[0], vf[vt][0], S[vt]); S[vt] = mfma16(ka[1], vf[vt][1], S[vt]); }
        }
        __syncthreads();
    }
    if (MODE == 0) {
        float* hp = HST + (size_t)item * HST_STRIDE;
#pragma unroll
        for (int r = 0; r < 4; ++r) { const int kk = 16 * w + 4 * g4 + r;
#pragma unroll
            for (int vt = 0; vt < 4; ++vt) hp[kk * 64 + 16 * vt + n16] = S[vt][r];
            if (n16 == 0) hp[8192 + kk] = Dt[r]; }
    }
}

#ifndef PHASE_MASK
#define PHASE_MASK 0xfff
#endif
#define PM(i) ((PHASE_MASK >> (i)) & 1)
#if defined(REPEAT_K) && defined(REP_SKIP_SEL)
#define IDX_DO_SEL (rep == 0)
#else
#define IDX_DO_SEL 1
#endif
constexpr int PH_PER_LAYER = 10, N_PHASES = DEPTH * PH_PER_LAYER;
struct Args { const float* in[14]; float* out; unsigned char* ws; int ph_lo, ph_hi; };
static_assert(offsetof(Args, out) == 112 && offsetof(Args, ws) == 120, "Args layout");

__global__ void __launch_bounds__(512, 2) hybrid_fwd(Args args) {
    extern __shared__ __attribute__((aligned(16))) unsigned char lds_raw[];
    cg::grid_group grid = cg::this_grid();
    Ctx F;
    F.lds = (LAS unsigned char*)lds_raw;
    F.wave = __builtin_amdgcn_readfirstlane((int)threadIdx.x >> 6); F.G = gridDim.x; F.bid = blockIdx.x;
    const int gw = F.bid * 8 + F.wave, NGW = F.G * 8;
    for (int i = threadIdx.x; i < LDS_BYTES / 16; i += 512) ((LAS u32x4*)F.lds)[i] = (u32x4){0u, 0u, 0u, 0u};
    __syncthreads();

    for (int ph = args.ph_lo; ph < args.ph_hi; ++ph) {
        const int l = ph / PH_PER_LAYER, k = ph - l * PH_PER_LAYER;
        {
            const CAS unsigned char* ka = (const CAS unsigned char*)__builtin_amdgcn_kernarg_segment_ptr(); asm volatile("" : "+s"(ka));
            F.ka = ka; F.out = *(float* const CAS*)(ka + 112); F.ws = *(unsigned char* const CAS*)(ka + 120);
        }
        unsigned char* ws = F.ws; unsigned char* wt = ws + WS_WT; unsigned char* big = ws + WS_BIG;
        bf16_t* Hb = (bf16_t*)(ws + WS_H); bf16_t* BR = (bf16_t*)(ws + WS_BR);
        const float* xin = (l == 0) ? F.in(0) : F.out;
#ifdef REPEAT_K
        for (int rep = 0; rep < ((k == REPEAT_K) ? REPEAT_N : 1); ++rep) {
        if (rep) grid.sync();
#endif
        if (k == 0 && PM(0)) {
            p0_weights(F, l);
            norm_rows(F, xin, F.in(1) + l * D, Hb);
        } else if (k == 2 && PM(2)) {
#ifdef REPEAT_K
            if (rep == 0)
#endif
            prep_tokens(F, l);
            for (int it = F.bid; it < 256; it += F.G) hgrn_item<0>(F, l, it >> 5, (it >> 3) & 3, it & 7);
        } else if (k == 3 && PM(3)) {
#if defined(REPEAT_K) && defined(REP_ONLY_HGRN)
            if (rep == 0)
#endif
            if (PM(10)) index_items(F, IDX_DO_SEL);
#if defined(REPEAT_K) && defined(REP_ONLY_INDEX)
            if (rep == 0)
#endif
            if (PM(11)) for (int it = F.bid; it < 256; it += F.G) hgrn_item<1>(F, l, it >> 5, (it >> 3) & 3, it & 7);
        } else if (k == 4 && PM(4)) {
            if (F.wave < 6) {
                for (int it = F.bid * 6 + F.wave; it < NB * 6 * 32; it += F.G * 6) { const int bh = it % 48, pi = it / 48; dsa_item(F, bh / 6, bh % 6, 63 - pi); dsa_item(F, bh / 6, bh % 6, pi); }
            } else {
                if ((F.G & 7) == 0 && F.G * 12 == NB * 6 * 64) {
                    for (int j = F.wave - 6; j < 12; j += 2) { const int g = (F.bid >> 3) * 12 + j; sb_item(F, F.bid & 7, g % 6, g / 6); }
                } else {
                    for (int it = F.bid * 2 + (F.wave - 6); it < NB * 6 * 64; it += F.G * 2) { const int bh = it % 48, qt = it / 48; sb_item(F, bh / 6, bh % 6, qt); }
                }
            }
        } else if (k == 7 && PM(7)) {
            norm_rows(F, F.out, F.in(11) + l * D, Hb);
        } else if ((k == 1 || k == 5 || k == 6 || k >= 8) && PM(1)) {
            bf16_t* Gt = (bf16_t*)(big + BIG_GT); bf16_t* Mx = (bf16_t*)(big + BIG_MIX);
            const int nsub = (k == 5) ? 2 : 1;
#pragma unroll 1
            for (int sub = 0; sub < nsub; ++sub) {
                pg8::Gemm g; pg8::EpiAll E; E.KVB = ws; E.G16 = Gt; E.Xi = xin; E.Xo = F.out; E.O16 = (bf16_t*)big; E.ldo = D;
                g.M = M; g.N = D; g.K = D; g.lda = D; g.A = Hb; g.a_grp_off = 0; g.align = 1; int reps = 1;
                if (k == 1) { g.Bt = (const bf16_t*)(wt + WT_IN); g.N = NGEMM; E.mode = pg8::EM_PROJ; E.ldo = NPROJ; }
                else if (k == 5) {
                    g.N = 3072; reps = 3;
                    if (sub == 0) { g.Bt = (const bf16_t*)(wt + WT_G); E.mode = pg8::EM_GATE; E.O16 = Gt; E.ldo = 3072; }
                    else { g.A = BR; g.a_grp_off = 384; g.K = 384; g.Bt = (const bf16_t*)(wt + WT_BR); E.mode = pg8::EM_MIXB; E.O16 = Mx; }
                }
                else if (k == 6) { g.A = Mx; g.Bt = (const bf16_t*)(wt + WT_OUT); E.mode = pg8::EM_RES; }
                else if (k == 8) { g.Bt = (const bf16_t*)(wt + WT_UP); g.N = FF; E.mode = pg8::EM_UP; E.ldo = FF; }
                else { g.A = (const bf16_t*)big; g.K = FF; g.lda = FF; g.Bt = (const bf16_t*)(wt + WT_DOWN); E.mode = pg8::EM_RES; E.Xi = F.out; }
                pg8::StaticOrder S; S.init(M, g.N, F.G, F.bid, reps);
                pg8::gemm_phase(F.lds, g, S, E);
            }
        }
#ifdef REPEAT_K
        }
#endif
        if (ph + 1 < args.ph_hi) grid.sync();
    }
}

extern "C" void kernel_launch(void* const* d_in, const int* in_sizes, int n_in, void* d_out, int out_size, void* d_ws, size_t ws_size, hipStream_t stream) {
    static int grid = 0;
    if (grid == 0) {
        if (n_in != 14 || out_size != M * D || ws_size < WS_END) { fprintf(stderr, "kernel_launch: unexpected shapes (n_in %d out %d ws %zu)\n", n_in, out_size, ws_size); grid = -1; return; }
        int dev = 0, cus = 0, per_cu = 0;
        hipGetDevice(&dev); hipDeviceGetAttribute(&cus, hipDeviceAttributeMultiprocessorCount, dev);
        hipFuncSetAttribute((const void*)hybrid_fwd, hipFuncAttributeMaxDynamicSharedMemorySize, LDS_BYTES);
        hipOccupancyMaxActiveBlocksPerMultiprocessor(&per_cu, (const void*)hybrid_fwd, 512, LDS_BYTES);
        (void)hipGetLastError();
        if (per_cu < 1) { fprintf(stderr, "kernel_launch: occupancy query says %d blocks/CU\n", per_cu); per_cu = 1; }
        grid = cus * 1;
        fprintf(stderr, "kernel_launch: grid %d (cus %d, per_cu %d)\n", grid, cus, per_cu);
    }
    if (grid < 0) return;
#ifdef DIAG_MEMSET
    hipMemsetAsync((char*)d_ws + WS_KF_SB, 0, 30 * MiB, stream);
#endif
    Args a{};
    for (int i = 0; i < 14; ++i) a.in[i] = (const float*)d_in[i];
    a.out = (float*)d_out; a.ws = (unsigned char*)d_ws;
#if ONE_LAUNCH
    a.ph_lo = 0; a.ph_hi = N_PHASES;
    void* kargs[] = {&a};
    hipError_t e = hipLaunchCooperativeKernel((const void*)hybrid_fwd, dim3(grid), dim3(512), kargs, LDS_BYTES, stream);
    if (e != hipSuccess) fprintf(stderr, "cooperative launch failed: %s (grid %d)\n", hipGetErrorString(e), grid);
#else
    for (int ph = 0; ph < N_PHASES; ++ph) { a.ph_lo = ph; a.ph_hi = ph + 1; hipLaunchKernelGGL(hybrid_fwd, dim3(grid), dim3(512), LDS_BYTES, stream, a); }
#endif
}
```

```cpp
#include <hip/hip_runtime.h>
#include <hip/hip_cooperative_groups.h>
#include <cstdio>
#include <cstdint>
namespace cg = cooperative_groups;

#ifndef ONE_LAUNCH
#define ONE_LAUNCH 1
#endif

#define LAS __attribute__((address_space(3)))
typedef unsigned short bf16_t;
typedef short bf16x8 __attribute__((ext_vector_type(8)));
typedef short bf16x4 __attribute__((ext_vector_type(4)));
typedef float f32x4 __attribute__((ext_vector_type(4)));
typedef float f32x16 __attribute__((ext_vector_type(16)));
typedef unsigned u32x4 __attribute__((ext_vector_type(4)));
typedef unsigned u32x2 __attribute__((ext_vector_type(2)));

constexpr int D = 1024, NB = 8, T = 2048, DEPTH = 2, M = NB * T, FF = 4096;
constexpr int D_IN = 6856;
constexpr int NGEMM = 3840;
constexpr int G_SV = 0, G_DV = 384, G_SK = 448, NKV = 832, NPROJ = NGEMM - NKV;
constexpr int C_SQ = 0, C_DQ = 384, C_DK = 768, C_IQ = 832, C_IK = 1344, C_HQ = 1408, C_HF = 1920, C_HI = 2432, C_HG = 2688, C_IW = 2944;
constexpr float EPS = 1e-6f;
constexpr float LOG2E = 1.4426950408889634f;

constexpr size_t MiB = 1u << 20;
constexpr size_t WS_WT = 1 * MiB;
constexpr size_t WT_IN = 0, WT_G = WT_IN + (size_t)NGEMM * D * 2, WT_BR = WT_G + (size_t)3072 * D * 2  ,
                 WT_OUT = WT_BR + (size_t)3072 * 384 * 2, WT_UP = WT_OUT + (size_t)D * D * 2, WT_DOWN = WT_UP + (size_t)FF * D * 2,
                 WT_END = WT_DOWN + (size_t)D * FF * 2;
static_assert(WT_END <= 34 * MiB, "weights");
constexpr size_t WS_H = 35 * MiB;
constexpr size_t WS_BR = 67 * MiB;
constexpr size_t WS_BIG = 99 * MiB;
constexpr size_t BIG_GT = 0  , BIG_MIX = 96 * MiB;
constexpr size_t WS_KF_SB = WS_BIG + 96 * MiB, WS_VF_SB = WS_KF_SB + 12 * MiB, WS_KF_DSA = WS_VF_SB + 12 * MiB, WS_VF_DSA = WS_KF_DSA + 2 * MiB, WS_KF_IDX = WS_VF_DSA + 2 * MiB;
static_assert((size_t)M * NPROJ * 2 <= 96 * MiB && WS_KF_IDX + 2 * MiB <= WS_BIG + 128 * MiB, "big");
constexpr size_t WS_MASK = 227 * MiB;
constexpr size_t WS_HST = 231 * MiB;
constexpr size_t HST_STRIDE = 128 * 64 + 128;
constexpr size_t WS_VF_HG = 240 * MiB;
constexpr size_t WS_END = 248 * MiB;
static_assert(WS_HST + 256 * HST_STRIDE * 4 <= WS_END, "ws");

constexpr int LDS_BYTES = 147456;

__device__ __forceinline__ unsigned cvt_pk_bf16(float lo, float hi) { unsigned r; asm volatile("v_cvt_pk_bf16_f32 %0, %1, %2" : "=v"(r) : "v"(lo), "v"(hi)); return r; }
__device__ __forceinline__ float bf2f(unsigned short b) { return __builtin_bit_cast(float, (unsigned)b << 16); }
__device__ __forceinline__ float bflo(unsigned u) { return __builtin_bit_cast(float, u << 16); }
__device__ __forceinline__ float bfhi(unsigned u) { return __builtin_bit_cast(float, u & 0xffff0000u); }
__device__ __forceinline__ float fexp2(float x) { return __builtin_amdgcn_exp2f(x); }
__device__ __forceinline__ float fexp(float x) { return __builtin_amdgcn_exp2f(x * LOG2E); }
__device__ __forceinline__ float flog2(float x) { return __builtin_amdgcn_logf(x); }
__device__ __forceinline__ float frcp(float x) { return __builtin_amdgcn_rcpf(x); }
__device__ __forceinline__ float sigmoidf_(float x) { return frcp(1.f + fexp(-x)); }
__device__ __forceinline__ float wave_sum(float v) {
#pragma unroll
    for (int o = 1; o < 64; o <<= 1) v += __shfl_xor(v, o);
    return v;
}

namespace pg8 {
constexpr int BM = 256, BK = 64, HALF = 128, HTB = HALF * BK * 2, NXCD = 8, WGM = 8;
__host__ __device__ __forceinline__ int lds_byte(int r, int c) { const int st = (r >> 4) * 2 + (c >> 5), rr = r & 15, cc = c & 31, ob = rr * 64 + cc * 2; return st * 1024 + (ob ^ (((ob >> 9) & 1) << 5)); }
__host__ __device__ __forceinline__ void stage_rc(int b, int& R, int& C) { const int st = b / 1024, sb = b % 1024, swz = sb ^ (((sb >> 9) & 1) << 5); R = (st >> 1) * 16 + swz / 64; C = (st & 1) * 32 + (swz % 64) / 2; }
__host__ __device__ __forceinline__ int perm32(int rho) { const int n = rho >> 4, i = rho & 15; return 8 * (i >> 2) + 4 * n + (i & 3); }
struct Unit { int pm, pn; };
struct Gemm { const bf16_t* A; const bf16_t* Bt; int M, N, K, lda, a_grp_off, align; };
struct StaticOrder {
    int nM, nN, nwg, G, c, reps;
    __device__ void init(int M_, int N_, int G_, int c_, int reps_ = 1) { reps = reps_; nM = M_ / BM; nN = N_ / (BM * reps_); nwg = nM * nN; G = G_; c = c_; }
    __device__ bool next(int i, Unit& u) const {
        const int ib = i / reps, br = i - ib * reps;
        const long L = (long)ib * G + c; if (L >= nwg) return false;
        int wgid = (int)L; { const int q = nwg / NXCD, r = nwg % NXCD, xcd = wgid % NXCD, off = wgid / NXCD; wgid = (xcd < r ? xcd * (q + 1) : r * (q + 1) + (xcd - r) * q) + off; }
        const int nig = WGM * nN, gid = wgid / nig, fm = gid * WGM, gsz = (nM - fm) < WGM ? (nM - fm) : WGM;
        u.pm = fm + ((wgid % nig) % gsz); u.pn = br * nN + (wgid % nig) / gsz; return true;
    }
};
template <class Epi>
__device__ __forceinline__ void gemm_phase(LAS unsigned char* lds, const Gemm g, const StaticOrder& S, const Epi& E) {
    int tid_ = threadIdx.x; asm volatile("" : "+v"(tid_));
    const int tid = tid_, wid = __builtin_amdgcn_readfirstlane(tid >> 6), lane = tid & 63, wr = wid >> 2, wc = wid & 3, fr = lane & 15, fq = lane >> 4;
    const int K = g.K, nt = K / BK, lda = g.lda;
    unsigned voffA[2], voffB[2];
#pragma unroll
    for (int i = 0; i < 2; ++i) { int R, C; stage_rc(tid * 16 + i * 8192, R, C); const int Rb = (R & ~31) + perm32(R & 31);
        voffA[i] = (unsigned)(R * lda + C) * 2u; voffB[i] = (unsigned)(Rb * K + C) * 2u; }
    const size_t kstep = (size_t)(BK * 2);
    const size_t hstepA = (size_t)HALF * lda * 2, tstepA = 2 * hstepA;
    const size_t hstepB = (size_t)HALF * K * 2, tstepB = 2 * hstepB;
    const unsigned ldsw = (unsigned)wid * 1024u;
    const int aoff = lds_byte(wr * 64 + fr, fq * 8), boff = lds_byte(wc * 32 + fr, fq * 8);
#define PG8_SA(b, h) (((b) * 2 + (h)) * HTB)
#define PG8_SB(b, h) ((4 + (b) * 2 + (h)) * HTB)
#define PG8_STAGE(bufoff, gbase, voff) do { _Pragma("unroll") for (int _i = 0; _i < 2; ++_i) \
        __builtin_amdgcn_global_load_lds((const unsigned*)((const char*)(gbase) + (voff)[_i]), (LAS unsigned*)(lds + (bufoff) + ldsw + _i * 8192), 16, 0, 0); } while (0)
#define PG8_LDA(dst, b, h) do { _Pragma("unroll") for (int m = 0; m < 4; ++m) _Pragma("unroll") for (int k = 0; k < 2; ++k) dst[m][k] = *(const LAS bf16x8*)(lds + PG8_SA(b, h) + aoff + m * 2048 + k * 1024); } while (0)
#define PG8_LDB(dst, b, h) do { _Pragma("unroll") for (int n = 0; n < 2; ++n) _Pragma("unroll") for (int k = 0; k < 2; ++k) dst[n][k] = *(const LAS bf16x8*)(lds + PG8_SB(b, h) + boff + n * 2048 + k * 1024); } while (0)
#define PG8_MMA(ai, bj, At, Bt) do { __builtin_amdgcn_s_setprio(1); _Pragma("unroll") for (int m = 0; m < 4; ++m) _Pragma("unroll") for (int n = 0; n < 2; ++n) _Pragma("unroll") for (int k = 0; k < 2; ++k) \
        acc[ai][bj][m][n] = __builtin_amdgcn_mfma_f32_16x16x32_bf16(Bt[n][k], At[m][k], acc[ai][bj][m][n], 0, 0, 0); __builtin_amdgcn_s_setprio(0); } while (0)
#define PG8_WAIT_V(n) asm volatile("s_waitcnt vmcnt(" #n ")" ::: "memory")
#define PG8_WAIT_L(n) asm volatile("s_waitcnt lgkmcnt(" #n ")" ::: "memory")
#define PG8_BAR __builtin_amdgcn_s_barrier()
#define PG8_SCHED __builtin_amdgcn_sched_barrier(0)
    Unit cur, nxt; int ui = 0;
    if (!S.next(0, cur)) return;
    f32x4 acc[2][2][4][2];
#pragma unroll
    for (int a = 0; a < 2; ++a)
#pragma unroll
        for (int b = 0; b < 2; ++b)
#pragma unroll
            for (int m = 0; m < 4; ++m)
#pragma unroll
                for (int n = 0; n < 2; ++n) acc[a][b][m][n] = (f32x4){0.f, 0.f, 0.f, 0.f};
    bf16x8 At[4][2], B0[2][2], B1[2][2];
    const size_t agrp = (size_t)g.a_grp_off * 2;
    const char* cA = (const char*)g.A + (size_t)cur.pm * tstepA + (size_t)(cur.pn >> 2) * agrp; const char* cB = (const char*)g.Bt + (size_t)cur.pn * tstepB;
    PG8_STAGE(PG8_SB(0, 0), cB, voffB); PG8_STAGE(PG8_SB(0, 1), cB + hstepB, voffB); PG8_STAGE(PG8_SA(0, 0), cA, voffA); PG8_STAGE(PG8_SA(0, 1), cA + hstepA, voffA);
    if (wr == 1) PG8_BAR;
    PG8_WAIT_V(2); PG8_BAR;
    PG8_STAGE(PG8_SB(1, 0), cB + kstep, voffB); PG8_STAGE(PG8_SA(1, 0), cA + kstep, voffA); PG8_STAGE(PG8_SB(1, 1), cB + hstepB + kstep, voffB);
    PG8_WAIT_V(6); PG8_BAR;
    for (;;) {
        const bool has_next = S.next(ui + 1, nxt);
        const char* nA = has_next ? (const char*)g.A + (size_t)nxt.pm * tstepA + (size_t)(nxt.pn >> 2) * agrp : cA; const char* nB = has_next ? (const char*)g.Bt + (size_t)nxt.pn * tstepB : cB;
        for (int t = 0; t < nt; t += 2) {
            const bool last = (t == nt - 2);
            const char* a1 = cA + (size_t)(t + 1) * kstep;
            const char* a2 = last ? nA : cA + (size_t)(t + 2) * kstep; const char* b2 = last ? nB : cB + (size_t)(t + 2) * kstep;
            const char* a3 = a2 + kstep; const char* b3 = b2 + kstep;
            PG8_LDB(B0, 0, 0); PG8_LDB(B1, 0, 1); PG8_SCHED; PG8_LDA(At, 0, 0); PG8_STAGE(PG8_SA(1, 1), a1 + hstepA, voffA);
            PG8_WAIT_V(8); PG8_WAIT_L(0); PG8_BAR; PG8_MMA(0, 0, At, B0); PG8_MMA(0, 1, At, B1); PG8_BAR; PG8_SCHED;
            PG8_LDA(At, 0, 1); PG8_STAGE(PG8_SB(0, 0), b2, voffB); PG8_STAGE(PG8_SB(0, 1), b2 + hstepB, voffB); PG8_STAGE(PG8_SA(0, 0), a2, voffA);
            PG8_WAIT_V(8); PG8_WAIT_L(0); PG8_BAR; PG8_MMA(1, 0, At, B0); PG8_MMA(1, 1, At, B1); PG8_BAR; PG8_SCHED;
            PG8_LDB(B0, 1, 0); PG8_LDB(B1, 1, 1); PG8_SCHED; PG8_LDA(At, 1, 0); PG8_STAGE(PG8_SA(0, 1), a2 + hstepA, voffA);
            PG8_WAIT_V(8); PG8_WAIT_L(0); PG8_BAR; PG8_MMA(0, 0, At, B0); PG8_MMA(0, 1, At, B1); PG8_BAR; PG8_SCHED;
            PG8_LDA(At, 1, 1); PG8_STAGE(PG8_SB(1, 0), b3, voffB); PG8_STAGE(PG8_SB(1, 1), b3 + hstepB, voffB); PG8_STAGE(PG8_SA(1, 0), a3, voffA);
            PG8_WAIT_V(8); PG8_WAIT_L(0); PG8_BAR; PG8_MMA(1, 0, At, B0); PG8_MMA(1, 1, At, B1); PG8_BAR; PG8_SCHED;
        }
        if (g.align) { if (wr == 0) PG8_BAR; }
        E(acc, cur, wr, wc, fr, fq);
        if (!has_next) break;
#pragma unroll
        for (int a = 0; a < 2; ++a)
#pragma unroll
            for (int b = 0; b < 2; ++b)
#pragma unroll
                for (int m = 0; m < 4; ++m)
#pragma unroll
                    for (int n = 0; n < 2; ++n) acc[a][b][m][n] = (f32x4){0.f, 0.f, 0.f, 0.f};
        cur = nxt; cA = nA; cB = nB; ++ui;
        if (g.align) { if (wr == 1) PG8_BAR; }
    }
    PG8_WAIT_V(0);
    if (!g.align) { if (wr == 0) PG8_BAR; }
    PG8_BAR;
#undef PG8_SA
#undef PG8_SB
#undef PG8_STAGE
#undef PG8_LDA
#undef PG8_LDB
#undef PG8_MMA
#undef PG8_WAIT_V
#undef PG8_WAIT_L
#undef PG8_BAR
#undef PG8_SCHED
}

#define EPI_LOOP_BEGIN \
    _Pragma("unroll") for (int ai = 0; ai < 2; ++ai) _Pragma("unroll") for (int m = 0; m < 4; ++m) { const int row = u.pm * BM + ai * HALF + wr * 64 + m * 16 + fr; \
    _Pragma("unroll") for (int bj = 0; bj < 2; ++bj) { const int col = u.pn * BM + bj * HALF + wc * 32 + 8 * fq; const f32x4 v0 = acc[ai][bj][m][0], v1 = acc[ai][bj][m][1];
#define EPI_LOOP_END } }

enum { EM_PROJ = 0, EM_GATE = 1, EM_MIXB = 2, EM_RES = 5, EM_UP = 6 };
struct EpiAll {
    int mode; bf16_t* O16; int ldo; unsigned char* KVB  ; const bf16_t* G16; const float* Xi; float* Xo;
    __device__ __forceinline__ void operator()(const f32x4 (&acc)[2][2][4][2], const Unit& u, int wr, int wc, int fr, int fq) const {
        asm volatile("" : "+v"(fr), "+v"(fq));
        EPI_LOOP_BEGIN
            if (mode == EM_PROJ) {
                u32x4 w; w.x = cvt_pk_bf16(v0[0], v0[1]); w.y = cvt_pk_bf16(v0[2], v0[3]); w.z = cvt_pk_bf16(v1[0], v1[1]); w.w = cvt_pk_bf16(v1[2], v1[3]);
                const int bb = row >> 11, tt = row & (T - 1), kt = tt >> 5, r = tt & 31;
                if (col < G_SK) {
                    const int isd = col >= G_DV, cc = isd ? col - G_DV : col, hh = cc >> 6, d0 = cc & 63, db = d0 >> 5;
                    const int s2 = r >> 4, k16 = r & 15, jj = 4 * (k16 >> 3) + (k16 & 3), h = (k16 >> 2) & 1;
                    const size_t blk = isd ? (size_t)(((bb * 64 + kt) * 2 + db) * 2 + s2) : (size_t)((((bb * 6 + hh) * 64 + kt) * 2 + db) * 2 + s2);
                    bf16_t* vp = (bf16_t*)(KVB + (isd ? WS_VF_DSA : WS_VF_SB)) + blk * 512 + ((d0 & 31) + 32 * h) * 8 + jj;
                    vp[0] = (bf16_t)(w.x & 0xffff); vp[8] = (bf16_t)(w.x >> 16); vp[16] = (bf16_t)(w.y & 0xffff); vp[24] = (bf16_t)(w.y >> 16);
                    vp[32] = (bf16_t)(w.z & 0xffff); vp[40] = (bf16_t)(w.z >> 16); vp[48] = (bf16_t)(w.w & 0xffff); vp[56] = (bf16_t)(w.w >> 16);
                } else if (col < NKV) {
                    const int cc = col - G_SK, hh = cc >> 6, d0 = cc & 63, s = d0 >> 4, h = (d0 >> 3) & 1;
                    *(u32x4*)((bf16_t*)(KVB + WS_KF_SB) + (size_t)((((bb * 6 + hh) * 64 + kt) * 4 + s)) * 512 + (r + 32 * h) * 8) = w;
                } else if (col >= NKV + C_HI && col < NKV + C_HI + 256) {
                    const int cc = col - (NKV + C_HI), hh = cc >> 6, v0 = cc & 63, s = tt & 63;
                    bf16_t* vp = (bf16_t*)(KVB + WS_VF_HG) + ((size_t)(((((bb * 4 + hh) * 32 + (tt >> 6)) * 4 + (v0 >> 4)) * 2 + (s >> 5))) * 64 + (v0 & 15) + 16 * ((s >> 3) & 3)) * 8 + (s & 7);
                    vp[0] = (bf16_t)(w.x & 0xffff); vp[8] = (bf16_t)(w.x >> 16); vp[16] = (bf16_t)(w.y & 0xffff); vp[24] = (bf16_t)(w.y >> 16);
                    vp[32] = (bf16_t)(w.z & 0xffff); vp[40] = (bf16_t)(w.z >> 16); vp[48] = (bf16_t)(w.w & 0xffff); vp[56] = (bf16_t)(w.w >> 16);
                } else {
                    *(u32x4*)(O16 + (size_t)row * ldo + col - NKV) = w;
                }
            } else if (mode == EM_GATE) {
                u32x4 w; w.x = cvt_pk_bf16(sigmoidf_(v0[0]), sigmoidf_(v0[1])); w.y = cvt_pk_bf16(sigmoidf_(v0[2]), sigmoidf_(v0[3]));
                w.z = cvt_pk_bf16(sigmoidf_(v1[0]), sigmoidf_(v1[1])); w.w = cvt_pk_bf16(sigmoidf_(v1[2]), sigmoidf_(v1[3]));
                *(u32x4*)(O16 + (size_t)row * ldo + col) = w;
            } else if (mode == EM_MIXB) {
                const u32x4 gw = *(const u32x4*)(G16 + (size_t)row * 3072 + col);
                f32x4 r0 = {bflo(gw.x) * v0[0], bfhi(gw.x) * v0[1], bflo(gw.y) * v0[2], bfhi(gw.y) * v0[3]};
                f32x4 r1 = {bflo(gw.z) * v1[0], bfhi(gw.z) * v1[1], bflo(gw.w) * v1[2], bfhi(gw.w) * v1[3]};
                bf16_t* mp = O16 + (size_t)row * D + (col & 1023);
                if (col >= 1024) { const u32x4 pw = *(const u32x4*)mp;
                    r0 += (f32x4){bflo(pw.x), bfhi(pw.x), bflo(pw.y), bfhi(pw.y)}; r1 += (f32x4){bflo(pw.z), bfhi(pw.z), bflo(pw.w), bfhi(pw.w)}; }
                u32x4 w; w.x = cvt_pk_bf16(r0[0], r0[1]); w.y = cvt_pk_bf16(r0[2], r0[3]); w.z = cvt_pk_bf16(r1[0], r1[1]); w.w = cvt_pk_bf16(r1[2], r1[3]);
                *(u32x4*)mp = w;
            } else if (mode == EM_RES) {
                const float* xp = Xi + (size_t)row * D + col; float* op = Xo + (size_t)row * D + col;
                const f32x4 x0 = *(const f32x4*)xp, x1 = *(const f32x4*)(xp + 4);
                *(f32x4*)op = x0 + v0; *(f32x4*)(op + 4) = x1 + v1;
            } else {
                f32x4 a = __builtin_elementwise_max(v0, (f32x4){0.f, 0.f, 0.f, 0.f}), b = __builtin_elementwise_max(v1, (f32x4){0.f, 0.f, 0.f, 0.f}); a = a * a; b = b * b;
                u32x4 w; w.x = cvt_pk_bf16(a[0], a[1]); w.y = cvt_pk_bf16(a[2], a[3]); w.z = cvt_pk_bf16(b[0], b[1]); w.w = cvt_pk_bf16(b[2], b[3]);
                *(u32x4*)(O16 + (size_t)row * ldo + col) = w;
            }
        EPI_LOOP_END
    }
};
}

#define CAS __attribute__((address_space(4)))
struct Ctx {
    LAS unsigned char* lds; int wave, G, bid;
    const CAS unsigned char* ka; float* out; unsigned char* ws;
    __device__ __forceinline__ const float* in(int i) const { return *(const float* const CAS*)(ka + 8 * i); }
};
#define LDS_WAIT() asm volatile("s_waitcnt lgkmcnt(0)" ::: "memory")

struct TrDesc { const float* src; bf16_t* dst; int ldw, ldt; };
__device__ __forceinline__ void tr_load(const TrDesc& d, float (&tv)[32], int lane) {
    const float* wp = d.src + (size_t)(lane >> 5) * d.ldw + (lane & 31);
#pragma unroll
    for (int i = 0; i < 32; ++i) tv[i] = __builtin_nontemporal_load(wp + (size_t)(2 * i) * d.ldw);
}
__device__ __forceinline__ void tr_store(const TrDesc& d, const float (&tv)[32], LAS float* scr, int lane) {
#pragma unroll
    for (int i = 0; i < 32; ++i) scr[(2 * i + (lane >> 5)) * 33 + (lane & 31)] = tv[i];
    LDS_WAIT(); asm volatile("" ::: "memory");
    const int c = lane & 7;
#pragma unroll
    for (int j = 0; j < 4; ++j) { const int n = (lane >> 3) + 8 * j; const LAS float* sp = scr + (8 * c) * 33 + n;
        u32x4 o; o.x = cvt_pk_bf16(sp[0 * 33], sp[1 * 33]); o.y = cvt_pk_bf16(sp[2 * 33], sp[3 * 33]); o.z = cvt_pk_bf16(sp[4 * 33], sp[5 * 33]); o.w = cvt_pk_bf16(sp[6 * 33], sp[7 * 33]);
        *(u32x4*)(d.dst + (size_t)n * d.ldt + 8 * c) = o; }
    LDS_WAIT(); asm volatile("" ::: "memory");
}
__device__ __forceinline__ void rms_row_to_bf16(const float* xrow, const float* gain, bf16_t* orow, int lane) {
    asm volatile("" : "+v"(lane));
    const f32x4* xr = (const f32x4*)xrow + lane; const f32x4* gr = (const f32x4*)gain + lane;
    f32x4 v[4]; float s = 0.f;
#pragma unroll
    for (int j = 0; j < 4; ++j) { v[j] = xr[64 * j]; s += (v[j].x * v[j].x + v[j].y * v[j].y) + (v[j].z * v[j].z + v[j].w * v[j].w); }
    const float rstd = 1.f / sqrtf(wave_sum(s) * (1.f / D) + EPS);
    u32x2* o8 = (u32x2*)orow + lane;
#pragma unroll
    for (int j = 0; j < 4; ++j) { const f32x4 g = gr[64 * j]; u32x2 w; w.x = cvt_pk_bf16(v[j].x * rstd * g.x, v[j].y * rstd * g.y); w.y = cvt_pk_bf16(v[j].z * rstd * g.z, v[j].w * rstd * g.w); o8[64 * j] = w; }
}
__device__ __forceinline__ void norm_rows(const Ctx& F, const float* X, const float* gain, bf16_t* O) {
    const int gw = F.bid * 8 + F.wave, NGW = F.G * 8;
    int lane = (int)threadIdx.x & 63; asm volatile("" : "+v"(lane));
    const f32x4* gr = (const f32x4*)gain + lane;
    for (int m = gw; m < M; m += 2 * NGW) {
        const int m2 = m + NGW; const bool two = m2 < M;
        const f32x4* xa = (const f32x4*)(X + (size_t)m * D) + lane; const f32x4* xb = (const f32x4*)(X + (size_t)(two ? m2 : m) * D) + lane;
        f32x4 va[4], vb[4]; float sa = 0.f, sb = 0.f;
#pragma unroll
        for (int j = 0; j < 4; ++j) { va[j] = xa[64 * j]; vb[j] = xb[64 * j]; }
#pragma unroll
        for (int j = 0; j < 4; ++j) { sa += (va[j].x * va[j].x + va[j].y * va[j].y) + (va[j].z * va[j].z + va[j].w * va[j].w); sb += (vb[j].x * vb[j].x + vb[j].y * vb[j].y) + (vb[j].z * vb[j].z + vb[j].w * vb[j].w); }
#pragma unroll
        for (int o = 1; o < 64; o <<= 1) { sa += __shfl_xor(sa, o); sb += __shfl_xor(sb, o); }
        const float ra = 1.f / sqrtf(sa * (1.f / D) + EPS), rb = 1.f / sqrtf(sb * (1.f / D) + EPS);
        u32x2* oa = (u32x2*)(O + (size_t)m * D) + lane; u32x2* ob = (u32x2*)(O + (size_t)m2 * D) + lane;
#pragma unroll
        for (int j = 0; j < 4; ++j) { const f32x4 g = gr[64 * j];
            u32x2 w; w.x = cvt_pk_bf16(va[j].x * ra * g.x, va[j].y * ra * g.y); w.y = cvt_pk_bf16(va[j].z * ra * g.z, va[j].w * ra * g.w); oa[64 * j] = w;
            if (two) { u32x2 w2; w2.x = cvt_pk_bf16(vb[j].x * rb * g.x, vb[j].y * rb * g.y); w2.y = cvt_pk_bf16(vb[j].z * rb * g.z, vb[j].w * rb * g.w); ob[64 * j] = w2; } }
    }
}
__device__ __forceinline__ void p0_weights(const Ctx& F, int l) {
    LAS float* scr = (LAS float*)(F.lds + F.wave * 16384);
    int tid0 = threadIdx.x; asm volatile("" : "+v"(tid0));
    const int gw = F.bid * 8 + F.wave, NGW = F.G * 8;
    unsigned char* wt = F.ws + WS_WT;
    bf16_t* Wt_in = (bf16_t*)(wt + WT_IN); bf16_t* Wt_g = (bf16_t*)(wt + WT_G); bf16_t* Wt_br = (bf16_t*)(wt + WT_BR);
    bf16_t* Wt_out = (bf16_t*)(wt + WT_OUT); bf16_t* Wt_up = (bf16_t*)(wt + WT_UP); bf16_t* Wt_down = (bf16_t*)(wt + WT_DOWN);
    const float* w_in = F.in(2) + (size_t)l * D * D_IN;
    const float* w_sb = F.in(7) + (size_t)l * 384 * D; const float* w_dsa = F.in(8) + (size_t)l * 384 * D; const float* w_hg = F.in(9) + (size_t)l * 256 * D;
    const float* w_out = F.in(10) + (size_t)l * D * D; const float* w_up = F.in(12) + (size_t)l * D * FF; const float* w_down = F.in(13) + (size_t)l * FF * D;
    constexpr int NI_IN = 16 * (3776 / 32 + 3072 / 32);
    constexpr int NI_TOT = NI_IN + 2 * (6 * 32) + 4 * 32 + 16 * 32 + 16 * 128 + 64 * 32;
#define SEGP(W_, ldw_, c0_, nc_, K_, P_, WT_, r0_) { constexpr int nbk = (nc_) / 32, ni = ((K_) / 64) * nbk; if (r < ni) { const int kb = r / nbk, nb = r - kb * nbk; \
        d.src = (W_) + (size_t)(64 * kb) * (ldw_) + (c0_) + 32 * nb; d.dst = (WT_) + (size_t)((r0_) + 32 * nb) * (P_) + 64 * kb; d.ldw = (ldw_); d.ldt = (P_); break; } r -= ni; }
#define SEG(W_, ldw_, c0_, nc_, K_, WT_, r0_) SEGP(W_, ldw_, c0_, nc_, K_, K_, WT_, r0_)
#define DECODE(it_, d) do { int r = (it_); \
        SEG(w_in, D_IN, 768, 384, 1024, Wt_in, G_SV) SEG(w_in, D_IN, 1600, 64, 1024, Wt_in, G_DV) SEG(w_in, D_IN, 0, 384, 1024, Wt_in, NKV + C_SQ) SEG(w_in, D_IN, 384, 384, 1024, Wt_in, G_SK) \
        SEG(w_in, D_IN, 1152, 384, 1024, Wt_in, NKV + C_DQ) SEG(w_in, D_IN, 1536, 64, 1024, Wt_in, NKV + C_DK) SEG(w_in, D_IN, 1664, 512, 1024, Wt_in, NKV + C_IQ) SEG(w_in, D_IN, 2176, 64, 1024, Wt_in, NKV + C_IK) \
        SEG(w_in, D_IN, 2248, 512, 1024, Wt_in, NKV + C_HQ) SEG(w_in, D_IN, 2760, 512, 1024, Wt_in, NKV + C_HF) SEG(w_in, D_IN, 3272, 256, 1024, Wt_in, NKV + C_HI) SEG(w_in, D_IN, 3528, 256, 1024, Wt_in, NKV + C_HG) \
        SEG(w_in, D_IN, 3784, 3072, 1024, Wt_g, 0) SEG(w_sb, D, 0, 1024, 384, Wt_br, 0) SEG(w_dsa, D, 0, 1024, 384, Wt_br, 1024) SEGP(w_hg, D, 0, 1024, 256, 384, Wt_br, 2048) \
        SEG(w_out, D, 0, 1024, 1024, Wt_out, 0) SEG(w_up, FF, 0, 4096, 1024, Wt_up, 0) SEG(w_down, D, 0, 1024, 4096, Wt_down, 0) } while (0)
    {
        int lane = (int)threadIdx.x & 63; asm volatile("" : "+v"(lane));
        TrDesc dc, dn; float tva[32], tvb[32];
        int it = gw;
        if (it < NI_TOT) { TrDesc d; DECODE(it, d); dc = d; tr_load(dc, tva, lane); }
        while (it < NI_TOT) {
            const int itn = it + NGW; const bool more = itn < NI_TOT;
            if (more) { TrDesc d; DECODE(itn, d); dn = d; tr_load(dn, tvb, lane); }
            tr_store(dc, tva, scr, lane);
            if (more) { dc = dn;
#pragma unroll
                for (int i = 0; i < 32; ++i) tva[i] = tvb[i]; }
            it = itn;
        }
    }
#undef DECODE
#undef SEG
#undef SEGP
    static_assert(NI_IN == 16 * ((384 + 64 + 384 + 384 + 384 + 64 + 512 + 64 + 512 + 512 + 256 + 256 + 3072) / 32), "segments");
    for (int idx = F.bid * 512 + tid0; idx < 1024 * 16; idx += F.G * 512) *(u32x4*)(Wt_br + (size_t)(2048 + (idx >> 4)) * 384 + 256 + (idx & 15) * 8) = (u32x4){0u, 0u, 0u, 0u};
    for (int idx = F.bid * 512 + tid0; idx < 64 * 1024; idx += F.G * 512) { const int rr = idx >> 10, k = idx & 1023;
        Wt_in[(size_t)(NKV + C_IW + rr) * 1024 + k] = rr < 8 ? (bf16_t)(cvt_pk_bf16(w_in[(size_t)k * D_IN + 2240 + rr], 0.f) & 0xffff) : (bf16_t)0; }
}

__device__ __forceinline__ void prep_tokens(const Ctx& F, int l) {
    bf16_t* P = (bf16_t*)(F.ws + WS_BIG);
    int lane_ = ((int)threadIdx.x & 63); asm volatile("" : "+v"(lane_));
    const int gw = F.bid * 8 + F.wave, NGW = F.G * 8, lane = lane_, head = lane >> 2, part = lane & 3;
    const float* gq = F.in(3) + l * 64 + part * 16; const float* gk = F.in(4) + l * 64 + part * 16;
    float g[16];
#pragma unroll
    for (int i = 0; i < 16; ++i) g[i] = head < 6 ? gq[i] : (head == 6 ? gk[i] : 1.f);
    const float inv[8] = {1.0f, 0.19392274474868576f, 0.03760603093086393f, 0.007292664737217109f, 0.001414213562373095f, 0.0002742481756762073f, 5.318295896944988e-05f, 1.031338537721246e-05f};
    for (int m0 = gw; m0 < M; m0 += 2 * NGW) {
        const bool two = m0 + NGW < M;
        bf16_t* pp[2] = {P + (size_t)m0 * NPROJ + C_DQ + lane * 16, P + (size_t)(two ? m0 + NGW : m0) * NPROJ + C_DQ + lane * 16};
        u32x4 ra[2], rb[2];
#pragma unroll
        for (int u = 0; u < 2; ++u) { ra[u] = *(const u32x4*)pp[u]; rb[u] = *(const u32x4*)(pp[u] + 8); }
#pragma unroll
        for (int u = 0; u < 2; ++u) {
            if (u == 1 && !two) break;
            const int m = m0 + u * NGW;
            const u32x4 a = ra[u], b = rb[u];
            float v[16] = {bflo(a.x), bfhi(a.x), bflo(a.y), bfhi(a.y), bflo(a.z), bfhi(a.z), bflo(a.w), bfhi(a.w), bflo(b.x), bfhi(b.x), bflo(b.y), bfhi(b.y), bflo(b.z), bfhi(b.z), bflo(b.w), bfhi(b.w)};
            float ss = 0.f;
#pragma unroll
            for (int i = 0; i < 16; ++i) ss += v[i] * v[i];
            ss += __shfl_xor(ss, 1); ss += __shfl_xor(ss, 2);
            const float rstd = head < 7 ? 1.f / sqrtf(ss * (1.f / 64.f) + EPS) : 1.f;
#pragma unroll
            for (int i = 0; i < 16; ++i) v[i] = v[i] * rstd * g[i];
            if (part == 0) {
                const float pos = (float)(m & (T - 1));
#pragma unroll
                for (int i = 0; i < 8; ++i) { const float ang = pos * inv[i], c = __cosf(ang), sn = __sinf(ang), x1 = v[i], x2 = v[i + 8]; v[i] = x1 * c - x2 * sn; v[i + 8] = x2 * c + x1 * sn; }
            }
            u32x4 oa, ob;
            oa.x = cvt_pk_bf16(v[0], v[1]); oa.y = cvt_pk_bf16(v[2], v[3]); oa.z = cvt_pk_bf16(v[4], v[5]); oa.w = cvt_pk_bf16(v[6], v[7]);
            ob.x = cvt_pk_bf16(v[8], v[9]); ob.y = cvt_pk_bf16(v[10], v[11]); ob.z = cvt_pk_bf16(v[12], v[13]); ob.w = cvt_pk_bf16(v[14], v[15]);
            if (head == 6 || head == 15) {
                const int bb = m >> 11, tt = m & (T - 1);
                bf16_t* kf = (bf16_t*)(F.ws + (head == 6 ? WS_KF_DSA : WS_KF_IDX)) + (size_t)(((bb * 64 + (tt >> 5)) * 4 + part)) * 512 + (tt & 31) * 8;
                *(u32x4*)kf = oa; *(u32x4*)(kf + 256) = ob;
            } else { *(u32x4*)pp[u] = oa; *(u32x4*)(pp[u] + 8) = ob; }
        }
    }
}

__device__ __forceinline__ f32x16 mfma32(bf16x8 a, bf16x8 b, f32x16 c) { return __builtin_amdgcn_mfma_f32_32x32x16_bf16(a, b, c, 0, 0, 0); }
__device__ __forceinline__ bf16x8 ld_frag(const bf16_t* p) { return *(const bf16x8*)p; }
__device__ __forceinline__ bf16x8 ld_vfrag(const bf16_t* p) {
    const u32x2 a = *(const u32x2*)p, b = *(const u32x2*)(p + 8); u32x4 w = {a.x, a.y, b.x, b.y}; return __builtin_bit_cast(bf16x8, w);
}
__device__ __forceinline__ bf16x8 pack_p(const f32x16& p, int s) {
    u32x4 w; w.x = cvt_pk_bf16(p[8 * s + 0], p[8 * s + 1]); w.y = cvt_pk_bf16(p[8 * s + 2], p[8 * s + 3]); w.z = cvt_pk_bf16(p[8 * s + 4], p[8 * s + 5]); w.w = cvt_pk_bf16(p[8 * s + 6], p[8 * s + 7]);
    return __builtin_bit_cast(bf16x8, w);
}
__device__ __forceinline__ void store_ot(bf16_t* orow  , const f32x16& o0, const f32x16& o1, int h, float sc) {
#pragma unroll
    for (int g = 0; g < 4; ++g) {
        u32x2 w0, w1; w0.x = cvt_pk_bf16(o0[4 * g] * sc, o0[4 * g + 1] * sc); w0.y = cvt_pk_bf16(o0[4 * g + 2] * sc, o0[4 * g + 3] * sc);
        w1.x = cvt_pk_bf16(o1[4 * g] * sc, o1[4 * g + 1] * sc); w1.y = cvt_pk_bf16(o1[4 * g + 2] * sc, o1[4 * g + 3] * sc);
        *(u32x2*)(orow + 8 * g + 4 * h) = w0; *(u32x2*)(orow + 32 + 8 * g + 4 * h) = w1;
    }
}

#define LOAD_KV(KF, VA, kp_, vp_) do { _Pragma("unroll") for (int s_ = 0; s_ < 4; ++s_) KF[s_] = ld_frag((kp_) + 512 * s_); \
    _Pragma("unroll") for (int db_ = 0; db_ < 2; ++db_) _Pragma("unroll") for (int s_ = 0; s_ < 2; ++s_) VA[db_][s_] = ld_frag((vp_) + 512 * (2 * db_ + s_)); } while (0)

__device__ __forceinline__ void sb_item(const Ctx& F, int b, int hh, int qt) {
    const bf16_t* P = (const bf16_t*)(F.ws + WS_BIG); bf16_t* BR = (bf16_t*)(F.ws + WS_BR);
    int lane_ = ((int)threadIdx.x & 63); asm volatile("" : "+v"(lane_));
    const int lane = lane_, c = lane & 31, h = lane >> 5, tb = b * T, q0 = 32 * qt, tq = q0 + c;
    bf16x8 qf[4];
#pragma unroll
    for (int s = 0; s < 4; ++s) qf[s] = ld_frag(P + (size_t)(tb + q0 + c) * NPROJ + C_SQ + hh * 64 + 16 * s + 8 * h);
    f32x16 o0, o1;
#pragma unroll
    for (int i = 0; i < 16; ++i) { o0[i] = 0.f; o1[i] = 0.f; }
    float carry = 0.f;
    const bf16_t* kp0 = (const bf16_t*)(F.ws + WS_KF_SB) + (size_t)((b * 6 + hh) * 64) * 2048 + lane * 8;
    const bf16_t* vt0 = (const bf16_t*)(F.ws + WS_VF_SB) + (size_t)((b * 6 + hh) * 64) * 2048 + lane * 8;
    bf16x8 kfn[4], van[2][2];
    LOAD_KV(kfn, van, kp0 + (size_t)qt * 2048, vt0 + (size_t)qt * 2048);
    for (int kt = qt; kt >= 0; --kt) {
        const int key0 = 32 * kt;
        bf16x8 kf[4], va[2][2];
#pragma unroll
        for (int s = 0; s < 4; ++s) kf[s] = kfn[s];
#pragma unroll
        for (int db = 0; db < 2; ++db) { va[db][0] = van[db][0]; va[db][1] = van[db][1]; }
        if (kt > 0) LOAD_KV(kfn, van, kp0 + (size_t)(kt - 1) * 2048, vt0 + (size_t)(kt - 1) * 2048);
        f32x16 st;
#pragma unroll
        for (int i = 0; i < 16; ++i) st[i] = 0.f;
#pragma unroll
        for (int s = 0; s < 4; ++s) st = mfma32(kf[s], qf[s], st);
        float z[16], lm[16];
#pragma unroll
        for (int r = 0; r < 16; ++r) {
            const int key = key0 + (r & 3) + 8 * (r >> 2) + 4 * h;
            z[r] = st[r] * 0.125f;
            const float az = fabsf(z[r]);
            const float sp = fmaxf(z[r], 0.f) + flog2(1.f + fexp(-az)) * 0.6931471805599453f;
            lm[r] = key < tq ? -sp : 0.f;
        }
        float gs[4], pg[4], hi[4];
#pragma unroll
        for (int g = 0; g < 4; ++g) { gs[g] = (lm[4 * g] + lm[4 * g + 1]) + (lm[4 * g + 2] + lm[4 * g + 3]); pg[g] = __shfl_xor(gs[g], 32); }
        hi[3] = 0.f; hi[2] = gs[3] + pg[3]; hi[1] = hi[2] + gs[2] + pg[2]; hi[0] = hi[1] + gs[1] + pg[1];
        const float tot = hi[0] + gs[0] + pg[0];
        f32x16 pa;
#pragma unroll
        for (int g = 0; g < 4; ++g) {
            float run = carry + hi[g] + (h == 0 ? pg[g] : 0.f);
#pragma unroll
            for (int i = 3; i >= 0; --i) {
                const int r = 4 * g + i; const int key = key0 + (r & 3) + 8 * (r >> 2) + 4 * h;
                run += lm[r];
                pa[r] = key < tq ? fexp(z[r] + run) : 0.f;
            }
        }
        carry += tot;
        const bf16x8 pb0 = pack_p(pa, 0), pb1 = pack_p(pa, 1);
        o0 = mfma32(va[0][0], pb0, o0); o0 = mfma32(va[0][1], pb1, o0);
        o1 = mfma32(va[1][0], pb0, o1); o1 = mfma32(va[1][1], pb1, o1);
        if (__all(carry < -104.f)) break;
    }
    store_ot(BR + (size_t)(tb + tq) * D + hh * 64, o0, o1, h, 1.f);
}

__device__ __forceinline__ void dsa_loadq(const Ctx& F, int b, int hh, int qt, bf16x8 (&qf)[4]) {
    const bf16_t* P = (const bf16_t*)(F.ws + WS_BIG);
    int lane_ = ((int)threadIdx.x & 63); asm volatile("" : "+v"(lane_));
    const int c = lane_ & 31, h = lane_ >> 5;
#pragma unroll
    for (int s = 0; s < 4; ++s) qf[s] = ld_frag(P + (size_t)(b * T + 32 * qt + c) * NPROJ + C_DQ + hh * 64 + 16 * s + 8 * h);
}
__device__ __forceinline__ void dsa_item(const Ctx& F, int b, int hh, int qt, const bf16x8 (&qf)[4]) {
    const bf16_t* P = (const bf16_t*)(F.ws + WS_BIG); bf16_t* BR = (bf16_t*)(F.ws + WS_BR);
    const unsigned* MK = (const unsigned*)(F.ws + WS_MASK);
    int lane_ = ((int)threadIdx.x & 63); asm volatile("" : "+v"(lane_));
    const int lane = lane_, c = lane & 31, h = lane >> 5, tb = b * T, q0 = 32 * qt, tq = q0 + c;
    f32x16 o0, o1;
#pragma unroll
    for (int i = 0; i < 16; ++i) { o0[i] = 0.f; o1[i] = 0.f; }
    float mrun = -1e30f, lrun = 0.f;
    const bf16_t* kp0 = (const bf16_t*)(F.ws + WS_KF_DSA) + (size_t)(b * 64) * 2048 + lane * 8;
    const bf16_t* vt0 = (const bf16_t*)(F.ws + WS_VF_DSA) + (size_t)(b * 64) * 2048 + lane * 8;
    const unsigned* mrow = MK + (size_t)(tb + tq) * 64;
    bf16x8 kfn[4], van[2][2]; unsigned mwn = mrow[0];
    LOAD_KV(kfn, van, kp0, vt0);
    constexpr float SC2 = 0.125f * LOG2E;
    for (int kt = 0; kt <= qt; ++kt) {
        bf16x8 kf[4], va[2][2]; const unsigned mw = mwn;
#pragma unroll
        for (int s = 0; s < 4; ++s) kf[s] = kfn[s];
#pragma unroll
        for (int db = 0; db < 2; ++db) { va[db][0] = van[db][0]; va[db][1] = van[db][1]; }
        if (kt < qt) { mwn = mrow[kt + 1]; LOAD_KV(kfn, van, kp0 + (size_t)(kt + 1) * 2048, vt0 + (size_t)(kt + 1) * 2048); }
        if (!__any(mw != 0u)) continue;
        f32x16 st;
#pragma unroll
        for (int i = 0; i < 16; ++i) st[i] = 0.f;
#pragma unroll
        for (int s = 0; s < 4; ++s) st = mfma32(kf[s], qf[s], st);
        float mx = fmaxf(fmaxf(fmaxf(st[0], st[1]), fmaxf(st[2], st[3])), fmaxf(fmaxf(st[4], st[5]), fmaxf(st[6], st[7])));
        mx = fmaxf(mx, fmaxf(fmaxf(fmaxf(st[8], st[9]), fmaxf(st[10], st[11])), fmaxf(fmaxf(st[12], st[13]), fmaxf(st[14], st[15]))));
        mx = fmaxf(mx, __shfl_xor(mx, 32));
        const float mnew = fmaxf(mrun, mx);
        if (__any(mnew > mrun)) {
            const float alpha = fexp2((mrun - mnew) * SC2);
            lrun *= alpha;
#pragma unroll
            for (int i = 0; i < 16; ++i) { o0[i] *= alpha; o1[i] *= alpha; }
            mrun = mnew;
        }
        const float nm = -mrun * SC2; const unsigned mh = mw >> (4 * h);
        float ps = 0.f; f32x16 pa;
#pragma unroll
        for (int r = 0; r < 16; ++r) {
            const unsigned keep = (unsigned)__builtin_amdgcn_sbfe((int)mh, (r & 3) + 8 * (r >> 2), 1);
            pa[r] = __builtin_bit_cast(float, __builtin_bit_cast(unsigned, fexp2(__builtin_fmaf(st[r], SC2, nm))) & keep); ps += pa[r];
        }
        ps += __shfl_xor(ps, 32);
        lrun += ps;
        const bf16x8 pb0 = pack_p(pa, 0), pb1 = pack_p(pa, 1);
        o0 = mfma32(va[0][0], pb0, o0); o0 = mfma32(va[0][1], pb1, o0);
        o1 = mfma32(va[1][0], pb0, o1); o1 = mfma32(va[1][1], pb1, o1);
    }
    store_ot(BR + (size_t)(tb + tq) * D + 384 + hh * 64, o0, o1, h, 1.f / lrun);
}

constexpr int SCP = 2052;
constexpr float IDX_SCALE = 0.044194173824159216f;
__device__ __forceinline__ unsigned mono_key(float f) { const unsigned u = __builtin_bit_cast(unsigned, f); return (u & 0x80000000u) ? ~u : (u | 0x80000000u); }
__device__ __forceinline__ int popc64(unsigned long long m) { return __builtin_popcountll(m); }
__device__ __forceinline__ int cnt_ge8(unsigned v0, unsigned v1, unsigned v2, unsigned v3, unsigned v4, unsigned v5, unsigned v6, unsigned v7, unsigned c) {
    unsigned long long m0, m1, m2, m3, m4, m5, m6, m7;
    asm("v_cmp_le_u32_e64 %0, %8, %9\n\tv_cmp_le_u32_e64 %1, %8, %10\n\tv_cmp_le_u32_e64 %2, %8, %11\n\tv_cmp_le_u32_e64 %3, %8, %12\n\t"
        "v_cmp_le_u32_e64 %4, %8, %13\n\tv_cmp_le_u32_e64 %5, %8, %14\n\tv_cmp_le_u32_e64 %6, %8, %15\n\tv_cmp_le_u32_e64 %7, %8, %16"
        : "=&s"(m0), "=&s"(m1), "=&s"(m2), "=&s"(m3), "=&s"(m4), "=&s"(m5), "=&s"(m6), "=&s"(m7)
        : "s"(c), "v"(v0), "v"(v1), "v"(v2), "v"(v3), "v"(v4), "v"(v5), "v"(v6), "v"(v7));
    return (__builtin_popcountll(m0) + __builtin_popcountll(m1)) + (__builtin_popcountll(m2) + __builtin_popcountll(m3)) + (__builtin_popcountll(m4) + __builtin_popcountll(m5)) + (__builtin_popcountll(m6) + __builtin_popcountll(m7));
}
__device__ __forceinline__ int wave_count6(int c) {
    int tot = 0;
#pragma unroll
    for (int b = 0; b < 6; ++b) tot += popc64(__ballot((c >> b) & 1)) << b;
    return tot;
}
__device__ __forceinline__ unsigned long long sel_mask(const unsigned (&uk)[32], unsigned U, int n, int lane, bool exact) {
    unsigned long long mine = 0ull;
    if (exact && n > 256) {
#pragma unroll
        for (int i = 0; i < 32; ++i) { const unsigned long long mk = __ballot(uk[i] >= U); if (lane == i) mine = mk; }
        return mine;
    }
    if (n <= 256) {
#pragma unroll
        for (int i = 0; i < 4; ++i) { const unsigned long long mk = __ballot(i * 64 + lane < n); if (lane == i) mine = mk; }
        return mine;
    }
    int cgt = 0, ce = 0;
#pragma unroll
    for (int i = 0; i < 32; ++i) { cgt += popc64(__ballot(uk[i] > U)); ce += popc64(__ballot(uk[i] == U)); }
    const int need = 256 - cgt;
    int X = 4096;
    if (ce > need) {
        int lo = 0, hi = 2047;
#pragma unroll 1
        while (lo < hi) {
            const int mid = (lo + hi) >> 1; int cl = 0;
#pragma unroll
            for (int i = 0; i < 32; ++i) cl += popc64(__ballot((uk[i] == U) & (i * 64 + lane <= mid)));
            if (cl >= need) hi = mid; else lo = mid + 1;
        }
        X = lo;
    }
#pragma unroll
    for (int i = 0; i < 32; ++i) {
        const unsigned long long mk = __ballot((uk[i] > U) | ((uk[i] == U) & (i * 64 + lane <= X)));
        if (lane == i) mine = mk;
    }
    return mine;
}
__device__ __forceinline__ void index_items(const Ctx& F, int do_sel = 1) {
    const bf16_t* P = (const bf16_t*)(F.ws + WS_BIG); unsigned long long* MK = (unsigned long long*)(F.ws + WS_MASK);
    LAS float* sc = (LAS float*)F.lds;
    int lane_ = ((int)threadIdx.x & 63); asm volatile("" : "+v"(lane_));
    const int lane = lane_, c = lane & 31, h = lane >> 5, wave = F.wave, qq = c & 15, hsel = c >> 4;
    bf16x8 qi[4][4], qn[4][4]; float wv[4], wn[4];
#define IDX_LOADQ(QI, WV, it_) do { const bf16_t* qrow = P + (size_t)(((it_) & 7) * T + 16 * (127 - ((it_) >> 3)) + qq) * NPROJ; \
        _Pragma("unroll") for (int g = 0; g < 4; ++g) { _Pragma("unroll") for (int s = 0; s < 4; ++s) QI[g][s] = ld_frag(qrow + C_IQ + (2 * g + hsel) * 64 + 16 * s + 8 * h); \
            WV[g] = bf2f(qrow[C_IW + 2 * g + hsel]) * IDX_SCALE; } } while (0)
    if (F.bid < NB * 128) IDX_LOADQ(qi, wv, F.bid);
    for (int it = F.bid; it < NB * 128; it += F.G) {
    const int b = it & 7, qb = 127 - (it >> 3), tb = b * T, q0 = 16 * qb;
    const int ntiles = (q0 + 16 + 31) >> 5;
    {
#define IDX_TILE(KF, key0_) do { float sa[16]; \
            _Pragma("unroll") for (int r = 0; r < 16; ++r) sa[r] = 0.f; \
            _Pragma("unroll") for (int g = 0; g < 4; ++g) { f32x16 st; \
                _Pragma("unroll") for (int i = 0; i < 16; ++i) st[i] = 0.f; \
                _Pragma("unroll") for (int s = 0; s < 4; ++s) st = mfma32(KF[s], qi[g][s], st); \
                _Pragma("unroll") for (int r = 0; r < 16; ++r) sa[r] += wv[g] * fmaxf(st[r], 0.f); } \
            _Pragma("unroll") for (int r = 0; r < 16; ++r) sa[r] += __shfl_xor(sa[r], 16); \
            if (hsel == 0) { _Pragma("unroll") for (int g4 = 0; g4 < 4; ++g4) *(LAS f32x4*)(sc + qq * SCP + (key0_) + 8 * g4 + 4 * h) = (f32x4){sa[4 * g4], sa[4 * g4 + 1], sa[4 * g4 + 2], sa[4 * g4 + 3]}; } } while (0)
        const bf16_t* kbase = (const bf16_t*)(F.ws + WS_KF_IDX) + (size_t)(b * 64) * 2048 + lane * 8;
        for (int kt = wave; kt < ntiles; kt += 16) {
            const int kt2 = kt + 8; const bool two = kt2 < ntiles;
            bf16x8 kfa[4], kfb[4];
#pragma unroll
            for (int s = 0; s < 4; ++s) kfa[s] = ld_frag(kbase + (size_t)kt * 2048 + 512 * s);
            if (two) {
#pragma unroll
                for (int s = 0; s < 4; ++s) kfb[s] = ld_frag(kbase + (size_t)kt2 * 2048 + 512 * s);
            }
            IDX_TILE(kfa, 32 * kt);
            if (two) IDX_TILE(kfb, 32 * kt2);
        }
#undef IDX_TILE
    }
    __syncthreads();
    if (it + F.G < NB * 128) IDX_LOADQ(qn, wn, it + F.G);
    if (do_sel) {
        const int qA = 2 * wave, nA = q0 + qA + 1, nB = nA + 1;
        unsigned ua[32], ub[32];
        {
            float sv[32];
#pragma unroll
            for (int i = 0; i < 32; ++i) sv[i] = sc[qA * SCP + i * 64 + lane];
#pragma unroll
            for (int i = 0; i < 32; ++i) ua[i] = (i * 64 + lane < nA) ? mono_key(sv[i]) : 0u;
#pragma unroll
            for (int i = 0; i < 32; ++i) sv[i] = sc[(qA + 1) * SCP + i * 64 + lane];
#pragma unroll
            for (int i = 0; i < 32; ++i) ub[i] = (i * 64 + lane < nB) ? mono_key(sv[i]) : 0u;
        }
        unsigned UA = 0u, UB = 0u; int cntA = 4096, cntB = 4096;
        if (nB > 256) {
            const int nb8 = (nB + 511) >> 9;
#pragma unroll 1
            for (int bit = 31; bit >= 0; --bit) {
                if (cntA == 256 && cntB == 256) break;
                const unsigned ca = UA | (1u << bit), cb = UB | (1u << bit); int na = 0, nbc = 0;
#pragma unroll
                for (int bk = 0; bk < 4; ++bk) if (bk < nb8) {
                    na += cnt_ge8(ua[8 * bk], ua[8 * bk + 1], ua[8 * bk + 2], ua[8 * bk + 3], ua[8 * bk + 4], ua[8 * bk + 5], ua[8 * bk + 6], ua[8 * bk + 7], ca);
                    nbc += cnt_ge8(ub[8 * bk], ub[8 * bk + 1], ub[8 * bk + 2], ub[8 * bk + 3], ub[8 * bk + 4], ub[8 * bk + 5], ub[8 * bk + 6], ub[8 * bk + 7], cb);
                }
                if (na >= 256) { UA = ca; cntA = na; }
                if (nbc >= 256) { UB = cb; cntB = nbc; }
            }
        }
        const unsigned long long mA = sel_mask(ua, UA, nA, lane, cntA == 256), mB = sel_mask(ub, UB, nB, lane, cntB == 256);
        if (lane < 32) { MK[(size_t)(tb + q0 + qA) * 32 + lane] = mA; MK[(size_t)(tb + q0 + qA + 1) * 32 + lane] = mB; }
    }
    __syncthreads();
    if (it + F.G < NB * 128) {
#pragma unroll
        for (int g = 0; g < 4; ++g) { wv[g] = wn[g];
#pragma unroll
            for (int s2 = 0; s2 < 4; ++s2) qi[g][s2] = qn[g][s2]; }
    }
    }
#undef IDX_LOADQ
}

constexpr int HP = 132, AP = 72, KP = 136, TP = 72, OP = 68;
constexpr int H_Q = 0, H_K = 64 * HP * 4, H_B = 2 * 64 * HP * 4;
constexpr int H_ATT = 3 * 64 * HP * 4;
constexpr int H_K2 = H_ATT + 64 * AP * 2;
constexpr int H_KT = H_K2 + 64 * KP * 2;
constexpr int H_DV = H_KT + 128 * TP * 2;
constexpr int H_END = H_DV + 512;
static_assert(H_END <= LDS_BYTES && 64 * KP * 2 <= 64 * HP * 4 && 64 * OP * 4 <= 64 * HP * 4 && 4 * 128 * 4 <= 64 * AP * 2, "hgrn lds");
__device__ __forceinline__ f32x4 mfma16(bf16x8 a, bf16x8 b, f32x4 c) { return __builtin_amdgcn_mfma_f32_16x16x32_bf16(a, b, c, 0, 0, 0); }
__device__ __forceinline__ bf16x8 pack8(const float* v) { u32x4 w; w.x = cvt_pk_bf16(v[0], v[1]); w.y = cvt_pk_bf16(v[2], v[3]); w.z = cvt_pk_bf16(v[4], v[5]); w.w = cvt_pk_bf16(v[6], v[7]); return __builtin_bit_cast(bf16x8, w); }
__device__ __forceinline__ bf16_t bf1(float a) { return (bf16_t)(cvt_pk_bf16(a, 0.f) & 0xffffu); }

template <int MODE>
__device__ __forceinline__ void hgrn_item(const Ctx& F, int l, int b, int hh, int sc) {
    const bf16_t* P = (const bf16_t*)(F.ws + WS_BIG); bf16_t* BR = (bf16_t*)(F.ws + WS_BR); float* HST = (float*)(F.ws + WS_HST);
    LAS unsigned char* L = F.lds;
    LAS float* qS = (LAS float*)(L + H_Q); LAS float* kS = (LAS float*)(L + H_K); LAS float* bS = (LAS float*)(L + H_B); LAS float* tot = (LAS float*)(L + H_ATT); LAS float* Dv = (LAS float*)(L + H_DV);
    LAS bf16_t* att = (LAS bf16_t*)(L + H_ATT); LAS bf16_t* k2 = (LAS bf16_t*)(L + H_K2); LAS bf16_t* kT = (LAS bf16_t*)(L + H_KT); LAS bf16_t* sT = (LAS bf16_t*)(L + H_B); LAS float* oS = (LAS float*)(L + H_Q);
    int tid_ = threadIdx.x; asm volatile("" : "+v"(tid_));
    const int tid = tid_, lane = tid & 63, w = F.wave, n16 = lane & 15, g4 = lane >> 4, tb = b * T + sc * 256;
    const int item = (b * 4 + hh) * 8 + sc;
    f32x4 S[4]; float Dt[4] = {1.f, 1.f, 1.f, 1.f};
#pragma unroll
    for (int i = 0; i < 4; ++i) S[i] = (f32x4){0.f, 0.f, 0.f, 0.f};
    if (MODE == 1 && sc > 0) {
        const float* hp0 = HST + (size_t)((b * 4 + hh) * 8) * HST_STRIDE;
        float dc[4], dn[4]; f32x4 cs[4], ns[4];
#pragma unroll
        for (int r = 0; r < 4; ++r) { const int kk = 16 * w + 4 * g4 + r; dc[r] = hp0[8192 + kk];
#pragma unroll
            for (int vt = 0; vt < 4; ++vt) cs[vt][r] = hp0[kk * 64 + 16 * vt + n16]; }
        for (int i = 0; i < sc; ++i) {
            if (i + 1 < sc) { const float* hp = hp0 + (size_t)(i + 1) * HST_STRIDE;
#pragma unroll
                for (int r = 0; r < 4; ++r) { const int kk = 16 * w + 4 * g4 + r; dn[r] = hp[8192 + kk];
#pragma unroll
                    for (int vt = 0; vt < 4; ++vt) ns[vt][r] = hp[kk * 64 + 16 * vt + n16]; } }
#pragma unroll
            for (int r = 0; r < 4; ++r)
#pragma unroll
                for (int vt = 0; vt < 4; ++vt) S[vt][r] = dc[r] * S[vt][r] + cs[vt][r];
            if (i + 1 < sc) {
#pragma unroll
                for (int r = 0; r < 4; ++r) dc[r] = dn[r];
#pragma unroll
                for (int vt = 0; vt < 4; ++vt) cs[vt] = ns[vt]; }
        }
    }
    const int lcg = (tid & 15) * 8;
    float lb[8];
#pragma unroll
    for (int e = 0; e < 8; ++e) {
        float v = 0.f;
        if (l == 1) { const float l0 = F.in(5)[hh * 128 + lcg + e], l1 = F.in(5)[512 + hh * 128 + lcg + e]; v = 1.f / (1.f + expf(l0 - l1)); }
        lb[e] = v;
    }
    const bf16_t* vf0 = (const bf16_t*)(F.ws + WS_VF_HG) + (size_t)(((b * 4 + hh) * 32 + sc * 4) * 8) * 512 + lane * 8;
    float onv[8];
#pragma unroll
    for (int e = 0; e < 8; ++e) onv[e] = (MODE == 1) ? F.in(6)[l * 64 + (tid & 7) * 8 + e] : 0.f;
    u32x4 fwn[2], qwn[2];
#pragma unroll
    for (int i = 0; i < 2; ++i) { const bf16_t* src = P + (size_t)(tb + ((tid + 512 * i) >> 4)) * NPROJ + hh * 128 + lcg; fwn[i] = *(const u32x4*)(src + C_HF); if (MODE == 1) qwn[i] = *(const u32x4*)(src + C_HQ); }
#pragma unroll 1
    for (int c = 0; c < 4; ++c) {
        const int tok0 = tb + c * 64;
        u32x4 gwp = {0u, 0u, 0u, 0u};
        if (MODE == 1) gwp = *(const u32x4*)(P + (size_t)(tok0 + (tid >> 3)) * NPROJ + C_HG + hh * 64 + (tid & 7) * 8);
        bf16x8 vf[4][2];
#pragma unroll
        for (int vt = 0; vt < 4; ++vt) { vf[vt][0] = ld_frag(vf0 + (size_t)(c * 8 + vt * 2) * 512); vf[vt][1] = ld_frag(vf0 + (size_t)(c * 8 + vt * 2 + 1) * 512); }
#pragma unroll
        for (int i = 0; i < 2; ++i) {
            const int p = tid + 512 * i, row = p >> 4;
            const u32x4 fw = fwn[i];
            const float fx[8] = {bflo(fw.x), bfhi(fw.x), bflo(fw.y), bfhi(fw.y), bflo(fw.z), bfhi(fw.z), bflo(fw.w), bfhi(fw.w)};
            float kv[8], bv[8];
#pragma unroll
            for (int e = 0; e < 8; ++e) { const float f = lb[e] + (1.f - lb[e]) * sigmoidf_(fx[e]); kv[e] = 1.f - f; bv[e] = flog2(fmaxf(f, 1e-12f)); }
            *(LAS f32x4*)(kS + row * HP + lcg) = (f32x4){kv[0], kv[1], kv[2], kv[3]}; *(LAS f32x4*)(kS + row * HP + lcg + 4) = (f32x4){kv[4], kv[5], kv[6], kv[7]};
            *(LAS f32x4*)(bS + row * HP + lcg) = (f32x4){bv[0], bv[1], bv[2], bv[3]}; *(LAS f32x4*)(bS + row * HP + lcg + 4) = (f32x4){bv[4], bv[5], bv[6], bv[7]};
            if (MODE == 1) {
                const u32x4 qw = qwn[i];
                const float qx[8] = {bflo(qw.x), bfhi(qw.x), bflo(qw.y), bfhi(qw.y), bflo(qw.z), bfhi(qw.z), bflo(qw.w), bfhi(qw.w)};
                float qv[8];
#pragma unroll
                for (int e = 0; e < 8; ++e) qv[e] = qx[e] * sigmoidf_(qx[e]);
                *(LAS f32x4*)(qS + row * HP + lcg) = (f32x4){qv[0], qv[1], qv[2], qv[3]}; *(LAS f32x4*)(qS + row * HP + lcg + 4) = (f32x4){qv[4], qv[5], qv[6], qv[7]};
            }
        }
        if (c < 3) {
#pragma unroll
            for (int i = 0; i < 2; ++i) { const bf16_t* src = P + (size_t)(tok0 + 64 + ((tid + 512 * i) >> 4)) * NPROJ + hh * 128 + lcg; fwn[i] = *(const u32x4*)(src + C_HF); if (MODE == 1) qwn[i] = *(const u32x4*)(src + C_HQ); }
        }
        __syncthreads();
        {
            const int part = tid >> 7, k2i = tid & 127;
            float pv[16]; float run = 0.f;
#pragma unroll
            for (int i = 0; i < 16; ++i) { run += bS[(part * 16 + i) * HP + k2i]; pv[i] = run; }
            tot[part * 128 + k2i] = run;
            __syncthreads();
            float pre = 0.f;
#pragma unroll
            for (int pp = 0; pp < 3; ++pp) if (pp < part) pre += tot[pp * 128 + k2i];
#pragma unroll
            for (int i = 0; i < 16; ++i) bS[(part * 16 + i) * HP + k2i] = pv[i] + pre;
        }
        __syncthreads();
        if (MODE == 1) {
            {
                const int t = tid >> 3, j = tid & 7, G = t >> 3, s = 8 * G + j;
                float a = 0.f;
                if (s <= t) {
#pragma unroll 4
                    for (int k4 = 0; k4 < 128; k4 += 4) {
                        const f32x4 q4 = *(const LAS f32x4*)(qS + t * HP + k4), bt = *(const LAS f32x4*)(bS + t * HP + k4), kx = *(const LAS f32x4*)(kS + s * HP + k4), bs = *(const LAS f32x4*)(bS + s * HP + k4);
                        a += q4.x * kx.x * fexp2(bt.x - bs.x) + q4.y * kx.y * fexp2(bt.y - bs.y) + q4.z * kx.z * fexp2(bt.z - bs.z) + q4.w * kx.w * fexp2(bt.w - bs.w);
                    }
                }
                att[t * AP + s] = bf1(a);
                for (int g2 = G + 1; g2 < 8; ++g2) att[t * AP + 8 * g2 + j] = (bf16_t)0;
            }
#pragma unroll
            for (int i = 0; i < 2; ++i) {
                const int p = tid + 512 * i, row = p >> 4, er = (row | 7);
                float kv[8];
#pragma unroll
                for (int e = 0; e < 8; ++e) kv[e] = kS[row * HP + lcg + e] * fexp2(bS[er * HP + lcg + e] - bS[row * HP + lcg + e]);
                *(LAS bf16x8*)(k2 + row * KP + lcg) = pack8(kv);
            }
            __syncthreads();
            for (int pr = w; pr < 16; pr += 8) {
                int I = 0, G = pr; while (G > 2 * I) { G -= 2 * I + 1; ++I; }
                const int t = 16 * I + n16, er = 8 * G + 7, sB = 8 * G + n16;
                f32x4 acc = {0.f, 0.f, 0.f, 0.f};
#pragma unroll
                for (int ks = 0; ks < 4; ++ks) {
                    const int k0 = 32 * ks + 8 * g4;
                    float qv[8];
#pragma unroll
                    for (int hs = 0; hs < 2; ++hs) {
                        const f32x4 q4 = *(const LAS f32x4*)(qS + t * HP + k0 + 4 * hs), bt = *(const LAS f32x4*)(bS + t * HP + k0 + 4 * hs), be = *(const LAS f32x4*)(bS + er * HP + k0 + 4 * hs);
                        qv[4 * hs] = q4.x * fexp2(fminf(bt.x - be.x, 0.f)); qv[4 * hs + 1] = q4.y * fexp2(fminf(bt.y - be.y, 0.f)); qv[4 * hs + 2] = q4.z * fexp2(fminf(bt.z - be.z, 0.f)); qv[4 * hs + 3] = q4.w * fexp2(fminf(bt.w - be.w, 0.f));
                    }
                    const bf16x8 bfr = *(const LAS bf16x8*)(k2 + (sB < 64 ? sB : 63) * KP + k0);
                    acc = mfma16(pack8(qv), bfr, acc);
                }
                if (n16 < 8) {
#pragma unroll
                    for (int r = 0; r < 4; ++r) { const int tt = 16 * I + 4 * g4 + r; if ((tt >> 3) > G) att[tt * AP + 8 * G + n16] = bf1(acc[r]); }
                }
            }
            __syncthreads();
        }
        if (tid < 128) Dv[tid] = fexp2(bS[63 * HP + tid]);
        if (MODE == 1) {
#pragma unroll
            for (int i = 0; i < 2; ++i) {
                const int p = tid + 512 * i, row = p >> 4;
                float qv[8];
#pragma unroll
                for (int e = 0; e < 8; ++e) qv[e] = qS[row * HP + lcg + e] * fexp2(bS[row * HP + lcg + e]);
                *(LAS bf16x8*)(k2 + row * KP + lcg) = pack8(qv);
            }
        }
#pragma unroll
        for (int i = 0; i < 2; ++i) {
            const int p = tid + 512 * i, kk = p & 127, sg = p >> 7;
            const float b63 = bS[63 * HP + kk];
            float kv[8];
#pragma unroll
            for (int e = 0; e < 8; ++e) kv[e] = kS[(8 * sg + e) * HP + kk] * fexp2(b63 - bS[(8 * sg + e) * HP + kk]);
            *(LAS bf16x8*)(kT + kk * TP + 8 * sg) = pack8(kv);
        }
        __syncthreads();
        if (MODE == 1) {
#pragma unroll
            for (int vt = 0; vt < 4; ++vt) { u32x2 pk; pk.x = cvt_pk_bf16(S[vt][0], S[vt][1]); pk.y = cvt_pk_bf16(S[vt][2], S[vt][3]); *(LAS u32x2*)(sT + (16 * vt + n16) * KP + 16 * w + 4 * g4) = pk; }
            __syncthreads();
            if (w < 4) {
                const int t = 16 * w + n16;
                f32x4 o[4];
#pragma unroll
                for (int vt = 0; vt < 4; ++vt) o[vt] = (f32x4){0.f, 0.f, 0.f, 0.f};
#pragma unroll
                for (int ks = 0; ks < 2; ++ks) { const bf16x8 a = *(const LAS bf16x8*)(att + t * AP + 32 * ks + 8 * g4);
#pragma unroll
                    for (int vt = 0; vt < 4; ++vt) o[vt] = mfma16(a, vf[vt][ks], o[vt]); }
#pragma unroll
                for (int ks = 0; ks < 4; ++ks) { const bf16x8 a = *(const LAS bf16x8*)(k2 + t * KP + 32 * ks + 8 * g4);
#pragma unroll
                    for (int vt = 0; vt < 4; ++vt) o[vt] = mfma16(a, *(const LAS bf16x8*)(sT + (16 * vt + n16) * KP + 32 * ks + 8 * g4), o[vt]); }
#pragma unroll
                for (int vt = 0; vt < 4; ++vt)
#pragma unroll
                    for (int r = 0; r < 4; ++r) oS[(16 * w + 4 * g4 + r) * OP + 16 * vt + n16] = o[vt][r];
            }
            __syncthreads();
            {
                const int t = tid >> 3, v0 = (tid & 7) * 8;
                const f32x4 oa = *(const LAS f32x4*)(oS + t * OP + v0), ob = *(const LAS f32x4*)(oS + t * OP + v0 + 4);
                float ss = (oa.x * oa.x + oa.y * oa.y) + (oa.z * oa.z + oa.w * oa.w) + (ob.x * ob.x + ob.y * ob.y) + (ob.z * ob.z + ob.w * ob.w);
                ss += __shfl_xor(ss, 1); ss += __shfl_xor(ss, 2); ss += __shfl_xor(ss, 4);
                const float rstd = 1.f / sqrtf(ss * (1.f / 64.f) + EPS);
                const u32x4 gw = gwp;
                const float gx[8] = {bflo(gw.x), bfhi(gw.x), bflo(gw.y), bfhi(gw.y), bflo(gw.z), bfhi(gw.z), bflo(gw.w), bfhi(gw.w)};
                const float ov[8] = {oa.x, oa.y, oa.z, oa.w, ob.x, ob.y, ob.z, ob.w};
                float y[8];
#pragma unroll
                for (int e = 0; e < 8; ++e) y[e] = ov[e] * rstd * onv[e] * (gx[e] * sigmoidf_(gx[e]));
                u32x4 wv; wv.x = cvt_pk_bf16(y[0], y[1]); wv.y = cvt_pk_bf16(y[2], y[3]); wv.z = cvt_pk_bf16(y[4], y[5]); wv.w = cvt_pk_bf16(y[6], y[7]);
                *(u32x4*)(BR + (size_t)(tok0 + t) * D + 768 + hh * 64 + v0) = wv;
            }
        }
        {
            bf16x8 ka[2];
#pragma unroll
            for (int ks = 0; ks < 2; ++ks) ka[ks] = *(const LAS bf16x8*)(kT + (16 * w + n16) * TP + 32 * ks + 8 * g4);
#pragma unroll
            for (int r = 0; r < 4; ++r) { const float d = Dv[16 * w + 4 * g4 + r]; Dt[r] *= d;
#pragma unroll
                for (int vt = 0; vt < 4; ++vt) S[vt][r] *= d; }
#pragma unroll
            for (int vt = 0; vt < 4; ++vt) { S[vt] = mfma16(ka[0], vf[vt][0], S[vt]); S[vt] = mfma16(ka[1], vf[vt][1], S[vt]); }
        }
        __syncthreads();
    }
    if (MODE == 0) {
        float* hp = HST + (size_t)item * HST_STRIDE;
#pragma unroll
        for (int r = 0; r < 4; ++r) { const int kk = 16 * w + 4 * g4 + r;
#pragma unroll
            for (int vt = 0; vt < 4; ++vt) hp[kk * 64 + 16 * vt + n16] = S[vt][r];
            if (n16 == 0) hp[8192 + kk] = Dt[r]; }
    }
}

#ifndef PHASE_MASK
#define PHASE_MASK 0xfff
#endif
#define PM(i) ((PHASE_MASK >> (i)) & 1)
#if defined(REPEAT_K) && defined(REP_SKIP_SEL)
#define IDX_DO_SEL (rep == 0)
#else
#define IDX_DO_SEL 1
#endif
constexpr int PH_PER_LAYER = 10, N_PHASES = DEPTH * PH_PER_LAYER;
struct Args { const float* in[14]; float* out; unsigned char* ws; int ph_lo, ph_hi; };
static_assert(offsetof(Args, out) == 112 && offsetof(Args, ws) == 120, "Args layout");

__global__ void __launch_bounds__(512, 2) hybrid_fwd(Args args) {
    extern __shared__ __attribute__((aligned(16))) unsigned char lds_raw[];
    cg::grid_group grid = cg::this_grid();
    Ctx F;
    F.lds = (LAS unsigned char*)lds_raw;
    F.wave = __builtin_amdgcn_readfirstlane((int)threadIdx.x >> 6); F.G = gridDim.x; F.bid = blockIdx.x;
    const int gw = F.bid * 8 + F.wave, NGW = F.G * 8;
    for (int i = threadIdx.x; i < LDS_BYTES / 16; i += 512) ((LAS u32x4*)F.lds)[i] = (u32x4){0u, 0u, 0u, 0u};
    __syncthreads();

    for (int ph = args.ph_lo; ph < args.ph_hi; ++ph) {
        const int l = ph / PH_PER_LAYER, k = ph - l * PH_PER_LAYER;
        {
            const CAS unsigned char* ka = (const CAS unsigned char*)__builtin_amdgcn_kernarg_segment_ptr(); asm volatile("" : "+s"(ka));
            F.ka = ka; F.out = *(float* const CAS*)(ka + 112); F.ws = *(unsigned char* const CAS*)(ka + 120);
        }
        unsigned char* ws = F.ws; unsigned char* wt = ws + WS_WT; unsigned char* big = ws + WS_BIG;
        bf16_t* Hb = (bf16_t*)(ws + WS_H); bf16_t* BR = (bf16_t*)(ws + WS_BR);
        const float* xin = (l == 0) ? F.in(0) : F.out;
#ifdef REPEAT_K
        for (int rep = 0; rep < ((k == REPEAT_K) ? REPEAT_N : 1); ++rep) {
        if (rep) grid.sync();
#endif
        if (k == 0 && PM(0)) {
            p0_weights(F, l);
            norm_rows(F, xin, F.in(1) + l * D, Hb);
        } else if (k == 2 && PM(2)) {
#ifdef REPEAT_K
            if (rep == 0)
#endif
            prep_tokens(F, l);
            for (int it = F.bid; it < 256; it += F.G) hgrn_item<0>(F, l, it >> 5, (it >> 3) & 3, it & 7);
        } else if (k == 3 && PM(3)) {
#if defined(REPEAT_K) && defined(REP_ONLY_HGRN)
            if (rep == 0)
#endif
            if (PM(10)) index_items(F, IDX_DO_SEL);
#if defined(REPEAT_K) && defined(REP_ONLY_INDEX)
            if (rep == 0)
#endif
            if (PM(11)) for (int it = F.bid; it < 256; it += F.G) hgrn_item<1>(F, l, it >> 5, (it >> 3) & 3, it & 7);
        } else if (k == 4 && PM(4)) {
            if (F.wave < 6) {
                for (int it = F.bid * 6 + F.wave; it < NB * 6 * 32; it += F.G * 6) { const int bh = it % 48, pi = it / 48; bf16x8 qa[4], qb[4]; dsa_loadq(F, bh / 6, bh % 6, 63 - pi, qa); dsa_loadq(F, bh / 6, bh % 6, pi, qb); dsa_item(F, bh / 6, bh % 6, 63 - pi, qa); dsa_item(F, bh / 6, bh % 6, pi, qb); }
            } else {
                if ((F.G & 7) == 0 && F.G * 12 == NB * 6 * 64) {
                    for (int j = F.wave - 6; j < 12; j += 2) { const int g = (F.bid >> 3) * 12 + j; sb_item(F, F.bid & 7, g % 6, g / 6); }
                } else {
                    for (int it = F.bid * 2 + (F.wave - 6); it < NB * 6 * 64; it += F.G * 2) { const int bh = it % 48, qt = it / 48; sb_item(F, bh / 6, bh % 6, qt); }
                }
            }
        } else if (k == 7 && PM(7)) {
            norm_rows(F, F.out, F.in(11) + l * D, Hb);
        } else if ((k == 1 || k == 5 || k == 6 || k >= 8) && PM(1)) {
            bf16_t* Gt = (bf16_t*)(big + BIG_GT); bf16_t* Mx = (bf16_t*)(big + BIG_MIX);
            const int nsub = (k == 5) ? 2 : 1;
#pragma unroll 1
            for (int sub = 0; sub < nsub; ++sub) {
                pg8::Gemm g; pg8::EpiAll E; E.KVB = ws; E.G16 = Gt; E.Xi = xin; E.Xo = F.out; E.O16 = (bf16_t*)big; E.ldo = D;
                g.M = M; g.N = D; g.K = D; g.lda = D; g.A = Hb; g.a_grp_off = 0; g.align = 1; int reps = 1;
                if (k == 1) { g.Bt = (const bf16_t*)(wt + WT_IN); g.N = NGEMM; E.mode = pg8::EM_PROJ; E.ldo = NPROJ; }
                else if (k == 5) {
                    g.N = 3072; reps = 3;
                    if (sub == 0) { g.Bt = (const bf16_t*)(wt + WT_G); E.mode = pg8::EM_GATE; E.O16 = Gt; E.ldo = 3072; }
                    else { g.A = BR; g.a_grp_off = 384; g.K = 384; g.Bt = (const bf16_t*)(wt + WT_BR); E.mode = pg8::EM_MIXB; E.O16 = Mx; }
                }
                else if (k == 6) { g.A = Mx; g.Bt = (const bf16_t*)(wt + WT_OUT); E.mode = pg8::EM_RES; }
                else if (k == 8) { g.Bt = (const bf16_t*)(wt + WT_UP); g.N = FF; E.mode = pg8::EM_UP; E.ldo = FF; }
                else { g.A = (const bf16_t*)big; g.K = FF; g.lda = FF; g.Bt = (const bf16_t*)(wt + WT_DOWN); E.mode = pg8::EM_RES; E.Xi = F.out; }
                pg8::StaticOrder S; S.init(M, g.N, F.G, F.bid, reps);
                pg8::gemm_phase(F.lds, g, S, E);
            }
        }
#ifdef REPEAT_K
        }
#endif
        if (ph + 1 < args.ph_hi) grid.sync();
    }
}

extern "C" void kernel_launch(void* const* d_in, const int* in_sizes, int n_in, void* d_out, int out_size, void* d_ws, size_t ws_size, hipStream_t stream) {
    static int grid = 0;
    if (grid == 0) {
        if (n_in != 14 || out_size != M * D || ws_size < WS_END) { fprintf(stderr, "kernel_launch: unexpected shapes (n_in %d out %d ws %zu)\n", n_in, out_size, ws_size); grid = -1; return; }
        int dev = 0, cus = 0, per_cu = 0;
        hipGetDevice(&dev); hipDeviceGetAttribute(&cus, hipDeviceAttributeMultiprocessorCount, dev);
        hipFuncSetAttribute((const void*)hybrid_fwd, hipFuncAttributeMaxDynamicSharedMemorySize, LDS_BYTES);
        hipOccupancyMaxActiveBlocksPerMultiprocessor(&per_cu, (const void*)hybrid_fwd, 512, LDS_BYTES);
        (void)hipGetLastError();
        if (per_cu < 1) { fprintf(stderr, "kernel_launch: occupancy query says %d blocks/CU\n", per_cu); per_cu = 1; }
        grid = cus * 1;
        fprintf(stderr, "kernel_launch: grid %d (cus %d, per_cu %d)\n", grid, cus, per_cu);
    }
    if (grid < 0) return;
#ifdef DIAG_MEMSET
    hipMemsetAsync((char*)d_ws + WS_KF_SB, 0, 30 * MiB, stream);
#endif
    Args a{};
    for (int i = 0; i < 14; ++i) a.in[i] = (const float*)d_in[i];
    a.out = (float*)d_out; a.ws = (unsigned char*)d_ws;
#if ONE_LAUNCH
    a.ph_lo = 0; a.ph_hi = N_PHASES;
    void* kargs[] = {&a};
    hipError_t e = hipLaunchCooperativeKernel((const void*)hybrid_fwd, dim3(grid), dim3(512), kargs, LDS_BYTES, stream);
    if (e != hipSuccess) fprintf(stderr, "cooperative launch failed: %s (grid %d)\n", hipGetErrorString(e), grid);
#else
    for (int ph = 0; ph < N_PHASES; ++ph) { a.ph_lo = ph; a.ph_hi = ph + 1; hipLaunchKernelGGL(hybrid_fwd, dim3(grid), dim3(512), LDS_BYTES, stream, a); }
#endif
}
```

```cpp
#include <hip/hip_runtime.h>
#include <hip/hip_cooperative_groups.h>
#include <cstdio>
#include <cstdint>
namespace cg = cooperative_groups;

#ifndef ONE_LAUNCH
#define ONE_LAUNCH 1
#endif

#define LAS __attribute__((address_space(3)))
typedef unsigned short bf16_t;
typedef short bf16x8 __attribute__((ext_vector_type(8)));
typedef short bf16x4 __attribute__((ext_vector_type(4)));
typedef float f32x4 __attribute__((ext_vector_type(4)));
typedef float f32x16 __attribute__((ext_vector_type(16)));
typedef unsigned u32x4 __attribute__((ext_vector_type(4)));
typedef unsigned u32x2 __attribute__((ext_vector_type(2)));

constexpr int D = 1024, NB = 8, T = 2048, DEPTH = 2, M = NB * T, FF = 4096;
constexpr int D_IN = 6856;
constexpr int NGEMM = 3840;
constexpr int G_SV = 0, G_DV = 384, G_SK = 448, NKV = 832, NPROJ = NGEMM - NKV;
constexpr int C_SQ = 0, C_DQ = 384, C_DK = 768, C_IQ = 832, C_IK = 1344, C_HQ = 1408, C_HF = 1920, C_HI = 2432, C_HG = 2688, C_IW = 2944;
constexpr float EPS = 1e-6f;
constexpr float LOG2E = 1.4426950408889634f;

constexpr size_t MiB = 1u << 20;
constexpr size_t WS_WT = 1 * MiB;
constexpr size_t WT_IN = 0, WT_G = WT_IN + (size_t)NGEMM * D * 2, WT_BR = WT_G + (size_t)3072 * D * 2  ,
                 WT_OUT = WT_BR + (size_t)3072 * 384 * 2, WT_UP = WT_OUT + (size_t)D * D * 2, WT_DOWN = WT_UP + (size_t)FF * D * 2,
                 WT_END = WT_DOWN + (size_t)D * FF * 2;
static_assert(WT_END <= 34 * MiB, "weights");
constexpr size_t WS_H = 35 * MiB;
constexpr size_t WS_BR = 67 * MiB;
constexpr size_t WS_BIG = 99 * MiB;
constexpr size_t BIG_GT = 0  , BIG_MIX = 96 * MiB;
constexpr size_t WS_KF_SB = WS_BIG + 96 * MiB, WS_VF_SB = WS_KF_SB + 12 * MiB, WS_KF_DSA = WS_VF_SB + 12 * MiB, WS_VF_DSA = WS_KF_DSA + 2 * MiB, WS_KF_IDX = WS_VF_DSA + 2 * MiB;
static_assert((size_t)M * NPROJ * 2 <= 96 * MiB && WS_KF_IDX + 2 * MiB <= WS_BIG + 128 * MiB, "big");
constexpr size_t WS_MASK = 227 * MiB;
constexpr size_t WS_HST = 231 * MiB;
constexpr size_t HST_STRIDE = 128 * 64 + 128;
constexpr size_t WS_VF_HG = 240 * MiB;
constexpr size_t WS_END = 248 * MiB;
static_assert(WS_HST + 256 * HST_STRIDE * 4 <= WS_END, "ws");

constexpr int LDS_BYTES = 147456;

__device__ __forceinline__ unsigned cvt_pk_bf16(float lo, float hi) { unsigned r; asm volatile("v_cvt_pk_bf16_f32 %0, %1, %2" : "=v"(r) : "v"(lo), "v"(hi)); return r; }
__device__ __forceinline__ float bf2f(unsigned short b) { return __builtin_bit_cast(float, (unsigned)b << 16); }
__device__ __forceinline__ float bflo(unsigned u) { return __builtin_bit_cast(float, u << 16); }
__device__ __forceinline__ float bfhi(unsigned u) { return __builtin_bit_cast(float, u & 0xffff0000u); }
__device__ __forceinline__ float fexp2(float x) { return __builtin_amdgcn_exp2f(x); }
__device__ __forceinline__ float fexp(float x) { return __builtin_amdgcn_exp2f(x * LOG2E); }
__device__ __forceinline__ float flog2(float x) { return __builtin_amdgcn_logf(x); }
__device__ __forceinline__ float frcp(float x) { return __builtin_amdgcn_rcpf(x); }
__device__ __forceinline__ float sigmoidf_(float x) { return frcp(1.f + fexp(-x)); }
__device__ __forceinline__ float wave_sum(float v) {
#pragma unroll
    for (int o = 1; o < 64; o <<= 1) v += __shfl_xor(v, o);
    return v;
}

namespace pg8 {
constexpr int BM = 256, BK = 64, HALF = 128, HTB = HALF * BK * 2, NXCD = 8, WGM = 8;
__host__ __device__ __forceinline__ int lds_byte(int r, int c) { const int st = (r >> 4) * 2 + (c >> 5), rr = r & 15, cc = c & 31, ob = rr * 64 + cc * 2; return st * 1024 + (ob ^ (((ob >> 9) & 1) << 5)); }
__host__ __device__ __forceinline__ void stage_rc(int b, int& R, int& C) { const int st = b / 1024, sb = b % 1024, swz = sb ^ (((sb >> 9) & 1) << 5); R = (st >> 1) * 16 + swz / 64; C = (st & 1) * 32 + (swz % 64) / 2; }
__host__ __device__ __forceinline__ int perm32(int rho) { const int n = rho >> 4, i = rho & 15; return 8 * (i >> 2) + 4 * n + (i & 3); }
struct Unit { int pm, pn; };
struct Gemm { const bf16_t* A; const bf16_t* Bt; int M, N, K, lda, a_grp_off, align; };
struct StaticOrder {
    int nM, nN, nwg, G, c, reps;
    __device__ void init(int M_, int N_, int G_, int c_, int reps_ = 1) { reps = reps_; nM = M_ / BM; nN = N_ / (BM * reps_); nwg = nM * nN; G = G_; c = c_; }
    __device__ bool next(int i, Unit& u) const {
        const int ib = i / reps, br = i - ib * reps;
        const long L = (long)ib * G + c; if (L >= nwg) return false;
        int wgid = (int)L; { const int q = nwg / NXCD, r = nwg % NXCD, xcd = wgid % NXCD, off = wgid / NXCD; wgid = (xcd < r ? xcd * (q + 1) : r * (q + 1) + (xcd - r) * q) + off; }
        const int nig = WGM * nN, gid = wgid / nig, fm = gid * WGM, gsz = (nM - fm) < WGM ? (nM - fm) : WGM;
        u.pm = fm + ((wgid % nig) % gsz); u.pn = br * nN + (wgid % nig) / gsz; return true;
    }
};
template <class Epi>
__device__ __forceinline__ void gemm_phase(LAS unsigned char* lds, const Gemm g, const StaticOrder& S, const Epi& E) {
    int tid_ = threadIdx.x; asm volatile("" : "+v"(tid_));
    const int tid = tid_, wid = __builtin_amdgcn_readfirstlane(tid >> 6), lane = tid & 63, wr = wid >> 2, wc = wid & 3, fr = lane & 15, fq = lane >> 4;
    const int K = g.K, nt = K / BK, lda = g.lda;
    unsigned voffA[2], voffB[2];
#pragma unroll
    for (int i = 0; i < 2; ++i) { int R, C; stage_rc(tid * 16 + i * 8192, R, C); const int Rb = (R & ~31) + perm32(R & 31);
        voffA[i] = (unsigned)(R * lda + C) * 2u; voffB[i] = (unsigned)(Rb * K + C) * 2u; }
    const size_t kstep = (size_t)(BK * 2);
    const size_t hstepA = (size_t)HALF * lda * 2, tstepA = 2 * hstepA;
    const size_t hstepB = (size_t)HALF * K * 2, tstepB = 2 * hstepB;
    const unsigned ldsw = (unsigned)wid * 1024u;
    const int aoff = lds_byte(wr * 64 + fr, fq * 8), boff = lds_byte(wc * 32 + fr, fq * 8);
#define PG8_SA(b, h) (((b) * 2 + (h)) * HTB)
#define PG8_SB(b, h) ((4 + (b) * 2 + (h)) * HTB)
#define PG8_STAGE(bufoff, gbase, voff) do { _Pragma("unroll") for (int _i = 0; _i < 2; ++_i) \
        __builtin_amdgcn_global_load_lds((const unsigned*)((const char*)(gbase) + (voff)[_i]), (LAS unsigned*)(lds + (bufoff) + ldsw + _i * 8192), 16, 0, 0); } while (0)
#define PG8_LDA(dst, b, h) do { _Pragma("unroll") for (int m = 0; m < 4; ++m) _Pragma("unroll") for (int k = 0; k < 2; ++k) dst[m][k] = *(const LAS bf16x8*)(lds + PG8_SA(b, h) + aoff + m * 2048 + k * 1024); } while (0)
#define PG8_LDB(dst, b, h) do { _Pragma("unroll") for (int n = 0; n < 2; ++n) _Pragma("unroll") for (int k = 0; k < 2; ++k) dst[n][k] = *(const LAS bf16x8*)(lds + PG8_SB(b, h) + boff + n * 2048 + k * 1024); } while (0)
#define PG8_MMA(ai, bj, At, Bt) do { __builtin_amdgcn_s_setprio(1); _Pragma("unroll") for (int m = 0; m < 4; ++m) _Pragma("unroll") for (int n = 0; n < 2; ++n) _Pragma("unroll") for (int k = 0; k < 2; ++k) \
        acc[ai][bj][m][n] = __builtin_amdgcn_mfma_f32_16x16x32_bf16(Bt[n][k], At[m][k], acc[ai][bj][m][n], 0, 0, 0); __builtin_amdgcn_s_setprio(0); } while (0)
#define PG8_WAIT_V(n) asm volatile("s_waitcnt vmcnt(" #n ")" ::: "memory")
#define PG8_WAIT_L(n) asm volatile("s_waitcnt lgkmcnt(" #n ")" ::: "memory")
#define PG8_BAR __builtin_amdgcn_s_barrier()
#define PG8_SCHED __builtin_amdgcn_sched_barrier(0)
    Unit cur, nxt; int ui = 0;
    if (!S.next(0, cur)) return;
    f32x4 acc[2][2][4][2];
#pragma unroll
    for (int a = 0; a < 2; ++a)
#pragma unroll
        for (int b = 0; b < 2; ++b)
#pragma unroll
            for (int m = 0; m < 4; ++m)
#pragma unroll
                for (int n = 0; n < 2; ++n) acc[a][b][m][n] = (f32x4){0.f, 0.f, 0.f, 0.f};
    bf16x8 At[4][2], B0[2][2], B1[2][2];
    const size_t agrp = (size_t)g.a_grp_off * 2;
    const char* cA = (const char*)g.A + (size_t)cur.pm * tstepA + (size_t)(cur.pn >> 2) * agrp; const char* cB = (const char*)g.Bt + (size_t)cur.pn * tstepB;
    PG8_STAGE(PG8_SB(0, 0), cB, voffB); PG8_STAGE(PG8_SB(0, 1), cB + hstepB, voffB); PG8_STAGE(PG8_SA(0, 0), cA, voffA); PG8_STAGE(PG8_SA(0, 1), cA + hstepA, voffA);
    if (wr == 1) PG8_BAR;
    PG8_WAIT_V(2); PG8_BAR;
    PG8_STAGE(PG8_SB(1, 0), cB + kstep, voffB); PG8_STAGE(PG8_SA(1, 0), cA + kstep, voffA); PG8_STAGE(PG8_SB(1, 1), cB + hstepB + kstep, voffB);
    PG8_WAIT_V(6); PG8_BAR;
    for (;;) {
        const bool has_next = S.next(ui + 1, nxt);
        const char* nA = has_next ? (const char*)g.A + (size_t)nxt.pm * tstepA + (size_t)(nxt.pn >> 2) * agrp : cA; const char* nB = has_next ? (const char*)g.Bt + (size_t)nxt.pn * tstepB : cB;
        for (int t = 0; t < nt; t += 2) {
            const bool last = (t == nt - 2);
            const char* a1 = cA + (size_t)(t + 1) * kstep;
            const char* a2 = last ? nA : cA + (size_t)(t + 2) * kstep; const char* b2 = last ? nB : cB + (size_t)(t + 2) * kstep;
            const char* a3 = a2 + kstep; const char* b3 = b2 + kstep;
            PG8_LDB(B0, 0, 0); PG8_LDB(B1, 0, 1); PG8_SCHED; PG8_LDA(At, 0, 0); PG8_STAGE(PG8_SA(1, 1), a1 + hstepA, voffA);
            PG8_WAIT_V(8); PG8_WAIT_L(0); PG8_BAR; PG8_MMA(0, 0, At, B0); PG8_MMA(0, 1, At, B1); PG8_BAR; PG8_SCHED;
            PG8_LDA(At, 0, 1); PG8_STAGE(PG8_SB(0, 0), b2, voffB); PG8_STAGE(PG8_SB(0, 1), b2 + hstepB, voffB); PG8_STAGE(PG8_SA(0, 0), a2, voffA);
            PG8_WAIT_V(8); PG8_WAIT_L(0); PG8_BAR; PG8_MMA(1, 0, At, B0); PG8_MMA(1, 1, At, B1); PG8_BAR; PG8_SCHED;
            PG8_LDB(B0, 1, 0); PG8_LDB(B1, 1, 1); PG8_SCHED; PG8_LDA(At, 1, 0); PG8_STAGE(PG8_SA(0, 1), a2 + hstepA, voffA);
            PG8_WAIT_V(8); PG8_WAIT_L(0); PG8_BAR; PG8_MMA(0, 0, At, B0); PG8_MMA(0, 1, At, B1); PG8_BAR; PG8_SCHED;
            PG8_LDA(At, 1, 1); PG8_STAGE(PG8_SB(1, 0), b3, voffB); PG8_STAGE(PG8_SB(1, 1), b3 + hstepB, voffB); PG8_STAGE(PG8_SA(1, 0), a3, voffA);
            PG8_WAIT_V(8); PG8_WAIT_L(0); PG8_BAR; PG8_MMA(1, 0, At, B0); PG8_MMA(1, 1, At, B1); PG8_BAR; PG8_SCHED;
        }
        if (g.align) { if (wr == 0) PG8_BAR; }
        E(acc, cur, wr, wc, fr, fq);
        if (!has_next) break;
#pragma unroll
        for (int a = 0; a < 2; ++a)
#pragma unroll
            for (int b = 0; b < 2; ++b)
#pragma unroll
                for (int m = 0; m < 4; ++m)
#pragma unroll
                    for (int n = 0; n < 2; ++n) acc[a][b][m][n] = (f32x4){0.f, 0.f, 0.f, 0.f};
        cur = nxt; cA = nA; cB = nB; ++ui;
        if (g.align) { if (wr == 1) PG8_BAR; }
    }
    PG8_WAIT_V(0);
    if (!g.align) { if (wr == 0) PG8_BAR; }
    PG8_BAR;
#undef PG8_SA
#undef PG8_SB
#undef PG8_STAGE
#undef PG8_LDA
#undef PG8_LDB
#undef PG8_MMA
#undef PG8_WAIT_V
#undef PG8_WAIT_L
#undef PG8_BAR
#undef PG8_SCHED
}

#define EPI_LOOP_BEGIN \
    _Pragma("unroll") for (int ai = 0; ai < 2; ++ai) _Pragma("unroll") for (int m = 0; m < 4; ++m) { const int row = u.pm * BM + ai * HALF + wr * 64 + m * 16 + fr; \
    _Pragma("unroll") for (int bj = 0; bj < 2; ++bj) { const int col = u.pn * BM + bj * HALF + wc * 32 + 8 * fq; const f32x4 v0 = acc[ai][bj][m][0], v1 = acc[ai][bj][m][1];
#define EPI_LOOP_END } }

enum { EM_PROJ = 0, EM_GATE = 1, EM_MIXB = 2, EM_RES = 5, EM_UP = 6 };
struct EpiAll {
    int mode; bf16_t* O16; int ldo; unsigned char* KVB  ; const bf16_t* G16; const float* Xi; float* Xo;
    __device__ __forceinline__ void operator()(const f32x4 (&acc)[2][2][4][2], const Unit& u, int wr, int wc, int fr, int fq) const {
        asm volatile("" : "+v"(fr), "+v"(fq));
        EPI_LOOP_BEGIN
            if (mode == EM_PROJ) {
                u32x4 w; w.x = cvt_pk_bf16(v0[0], v0[1]); w.y = cvt_pk_bf16(v0[2], v0[3]); w.z = cvt_pk_bf16(v1[0], v1[1]); w.w = cvt_pk_bf16(v1[2], v1[3]);
                const int bb = row >> 11, tt = row & (T - 1), kt = tt >> 5, r = tt & 31;
                if (col < G_SK) {
                    const int isd = col >= G_DV, cc = isd ? col - G_DV : col, hh = cc >> 6, d0 = cc & 63, db = d0 >> 5;
                    const int s2 = r >> 4, k16 = r & 15, jj = 4 * (k16 >> 3) + (k16 & 3), h = (k16 >> 2) & 1;
                    const size_t blk = isd ? (size_t)(((bb * 64 + kt) * 2 + db) * 2 + s2) : (size_t)((((bb * 6 + hh) * 64 + kt) * 2 + db) * 2 + s2);
                    bf16_t* vp = (bf16_t*)(KVB + (isd ? WS_VF_DSA : WS_VF_SB)) + blk * 512 + ((d0 & 31) + 32 * h) * 8 + jj;
                    vp[0] = (bf16_t)(w.x & 0xffff); vp[8] = (bf16_t)(w.x >> 16); vp[16] = (bf16_t)(w.y & 0xffff); vp[24] = (bf16_t)(w.y >> 16);
                    vp[32] = (bf16_t)(w.z & 0xffff); vp[40] = (bf16_t)(w.z >> 16); vp[48] = (bf16_t)(w.w & 0xffff); vp[56] = (bf16_t)(w.w >> 16);
                } else if (col < NKV) {
                    const int cc = col - G_SK, hh = cc >> 6, d0 = cc & 63, s = d0 >> 4, h = (d0 >> 3) & 1;
                    *(u32x4*)((bf16_t*)(KVB + WS_KF_SB) + (size_t)((((bb * 6 + hh) * 64 + kt) * 4 + s)) * 512 + (r + 32 * h) * 8) = w;
                } else if (col >= NKV + C_HI && col < NKV + C_HI + 256) {
                    const int cc = col - (NKV + C_HI), hh = cc >> 6, v0 = cc & 63, s = tt & 63;
                    bf16_t* vp = (bf16_t*)(KVB + WS_VF_HG) + ((size_t)(((((bb * 4 + hh) * 32 + (tt >> 6)) * 4 + (v0 >> 4)) * 2 + (s >> 5))) * 64 + (v0 & 15) + 16 * ((s >> 3) & 3)) * 8 + (s & 7);
                    vp[0] = (bf16_t)(w.x & 0xffff); vp[8] = (bf16_t)(w.x >> 16); vp[16] = (bf16_t)(w.y & 0xffff); vp[24] = (bf16_t)(w.y >> 16);
                    vp[32] = (bf16_t)(w.z & 0xffff); vp[40] = (bf16_t)(w.z >> 16); vp[48] = (bf16_t)(w.w & 0xffff); vp[56] = (bf16_t)(w.w >> 16);
                } else {
                    *(u32x4*)(O16 + (size_t)row * ldo + col - NKV) = w;
                }
            } else if (mode == EM_GATE) {
                u32x4 w; w.x = cvt_pk_bf16(sigmoidf_(v0[0]), sigmoidf_(v0[1])); w.y = cvt_pk_bf16(sigmoidf_(v0[2]), sigmoidf_(v0[3]));
                w.z = cvt_pk_bf16(sigmoidf_(v1[0]), sigmoidf_(v1[1])); w.w = cvt_pk_bf16(sigmoidf_(v1[2]), sigmoidf_(v1[3]));
                *(u32x4*)(O16 + (size_t)row * ldo + col) = w;
            } else if (mode == EM_MIXB) {
                const u32x4 gw = *(const u32x4*)(G16 + (size_t)row * 3072 + col);
                f32x4 r0 = {bflo(gw.x) * v0[0], bfhi(gw.x) * v0[1], bflo(gw.y) * v0[2], bfhi(gw.y) * v0[3]};
                f32x4 r1 = {bflo(gw.z) * v1[0], bfhi(gw.z) * v1[1], bflo(gw.w) * v1[2], bfhi(gw.w) * v1[3]};
                bf16_t* mp = O16 + (size_t)row * D + (col & 1023);
                if (col >= 1024) { const u32x4 pw = *(const u32x4*)mp;
                    r0 += (f32x4){bflo(pw.x), bfhi(pw.x), bflo(pw.y), bfhi(pw.y)}; r1 += (f32x4){bflo(pw.z), bfhi(pw.z), bflo(pw.w), bfhi(pw.w)}; }
                u32x4 w; w.x = cvt_pk_bf16(r0[0], r0[1]); w.y = cvt_pk_bf16(r0[2], r0[3]); w.z = cvt_pk_bf16(r1[0], r1[1]); w.w = cvt_pk_bf16(r1[2], r1[3]);
                *(u32x4*)mp = w;
            } else if (mode == EM_RES) {
                const float* xp = Xi + (size_t)row * D + col; float* op = Xo + (size_t)row * D + col;
                const f32x4 x0 = *(const f32x4*)xp, x1 = *(const f32x4*)(xp + 4);
                *(f32x4*)op = x0 + v0; *(f32x4*)(op + 4) = x1 + v1;
            } else {
                f32x4 a = __builtin_elementwise_max(v0, (f32x4){0.f, 0.f, 0.f, 0.f}), b = __builtin_elementwise_max(v1, (f32x4){0.f, 0.f, 0.f, 0.f}); a = a * a; b = b * b;
                u32x4 w; w.x = cvt_pk_bf16(a[0], a[1]); w.y = cvt_pk_bf16(a[2], a[3]); w.z = cvt_pk_bf16(b[0], b[1]); w.w = cvt_pk_bf16(b[2], b[3]);
                *(u32x4*)(O16 + (size_t)row * ldo + col) = w;
            }
        EPI_LOOP_END
    }
};
}

#define CAS __attribute__((address_space(4)))
struct Ctx {
    LAS unsigned char* lds; int wave, G, bid;
    const CAS unsigned char* ka; float* out; unsigned char* ws;
    __device__ __forceinline__ const float* in(int i) const { return *(const float* const CAS*)(ka + 8 * i); }
};
#define LDS_WAIT() asm volatile("s_waitcnt lgkmcnt(0)" ::: "memory")

struct TrDesc { const float* src; bf16_t* dst; int ldw, ldt; };
__device__ __forceinline__ void tr_load(const TrDesc& d, float (&tv)[32], int lane) {
    const float* wp = d.src + (size_t)(lane >> 5) * d.ldw + (lane & 31);
#pragma unroll
    for (int i = 0; i < 32; ++i) tv[i] = __builtin_nontemporal_load(wp + (size_t)(2 * i) * d.ldw);
}
__device__ __forceinline__ void tr_store(const TrDesc& d, const float (&tv)[32], LAS float* scr, int lane) {
#pragma unroll
    for (int i = 0; i < 32; ++i) scr[(2 * i + (lane >> 5)) * 33 + (lane & 31)] = tv[i];
    LDS_WAIT(); asm volatile("" ::: "memory");
    const int c = lane & 7;
#pragma unroll
    for (int j = 0; j < 4; ++j) { const int n = (lane >> 3) + 8 * j; const LAS float* sp = scr + (8 * c) * 33 + n;
        u32x4 o; o.x = cvt_pk_bf16(sp[0 * 33], sp[1 * 33]); o.y = cvt_pk_bf16(sp[2 * 33], sp[3 * 33]); o.z = cvt_pk_bf16(sp[4 * 33], sp[5 * 33]); o.w = cvt_pk_bf16(sp[6 * 33], sp[7 * 33]);
        *(u32x4*)(d.dst + (size_t)n * d.ldt + 8 * c) = o; }
    LDS_WAIT(); asm volatile("" ::: "memory");
}
__device__ __forceinline__ void rms_row_to_bf16(const float* xrow, const float* gain, bf16_t* orow, int lane) {
    asm volatile("" : "+v"(lane));
    const f32x4* xr = (const f32x4*)xrow + lane; const f32x4* gr = (const f32x4*)gain + lane;
    f32x4 v[4]; float s = 0.f;
#pragma unroll
    for (int j = 0; j < 4; ++j) { v[j] = xr[64 * j]; s += (v[j].x * v[j].x + v[j].y * v[j].y) + (v[j].z * v[j].z + v[j].w * v[j].w); }
    const float rstd = 1.f / sqrtf(wave_sum(s) * (1.f / D) + EPS);
    u32x2* o8 = (u32x2*)orow + lane;
#pragma unroll
    for (int j = 0; j < 4; ++j) { const f32x4 g = gr[64 * j]; u32x2 w; w.x = cvt_pk_bf16(v[j].x * rstd * g.x, v[j].y * rstd * g.y); w.y = cvt_pk_bf16(v[j].z * rstd * g.z, v[j].w * rstd * g.w); o8[64 * j] = w; }
}
__device__ __forceinline__ void norm_rows(const Ctx& F, const float* X, const float* gain, bf16_t* O) {
    const int gw = F.bid * 8 + F.wave, NGW = F.G * 8;
    int lane = (int)threadIdx.x & 63; asm volatile("" : "+v"(lane));
    const f32x4* gr = (const f32x4*)gain + lane;
    for (int m = gw; m < M; m += 2 * NGW) {
        const int m2 = m + NGW; const bool two = m2 < M;
        const f32x4* xa = (const f32x4*)(X + (size_t)m * D) + lane; const f32x4* xb = (const f32x4*)(X + (size_t)(two ? m2 : m) * D) + lane;
        f32x4 va[4], vb[4]; float sa = 0.f, sb = 0.f;
#pragma unroll
        for (int j = 0; j < 4; ++j) { va[j] = xa[64 * j]; vb[j] = xb[64 * j]; }
#pragma unroll
        for (int j = 0; j < 4; ++j) { sa += (va[j].x * va[j].x + va[j].y * va[j].y) + (va[j].z * va[j].z + va[j].w * va[j].w); sb += (vb[j].x * vb[j].x + vb[j].y * vb[j].y) + (vb[j].z * vb[j].z + vb[j].w * vb[j].w); }
#pragma unroll
        for (int o = 1; o < 64; o <<= 1) { sa += __shfl_xor(sa, o); sb += __shfl_xor(sb, o); }
        const float ra = 1.f / sqrtf(sa * (1.f / D) + EPS), rb = 1.f / sqrtf(sb * (1.f / D) + EPS);
        u32x2* oa = (u32x2*)(O + (size_t)m * D) + lane; u32x2* ob = (u32x2*)(O + (size_t)m2 * D) + lane;
#pragma unroll
        for (int j = 0; j < 4; ++j) { const f32x4 g = gr[64 * j];
            u32x2 w; w.x = cvt_pk_bf16(va[j].x * ra * g.x, va[j].y * ra * g.y); w.y = cvt_pk_bf16(va[j].z * ra * g.z, va[j].w * ra * g.w); oa[64 * j] = w;
            if (two) { u32x2 w2; w2.x = cvt_pk_bf16(vb[j].x * rb * g.x, vb[j].y * rb * g.y); w2.y = cvt_pk_bf16(vb[j].z * rb * g.z, vb[j].w * rb * g.w); ob[64 * j] = w2; } }
    }
}
__device__ __forceinline__ void p0_weights(const Ctx& F, int l) {
    LAS float* scr = (LAS float*)(F.lds + F.wave * 16384);
    int tid0 = threadIdx.x; asm volatile("" : "+v"(tid0));
    const int gw = F.bid * 8 + F.wave, NGW = F.G * 8;
    unsigned char* wt = F.ws + WS_WT;
    bf16_t* Wt_in = (bf16_t*)(wt + WT_IN); bf16_t* Wt_g = (bf16_t*)(wt + WT_G); bf16_t* Wt_br = (bf16_t*)(wt + WT_BR);
    bf16_t* Wt_out = (bf16_t*)(wt + WT_OUT); bf16_t* Wt_up = (bf16_t*)(wt + WT_UP); bf16_t* Wt_down = (bf16_t*)(wt + WT_DOWN);
    const float* w_in = F.in(2) + (size_t)l * D * D_IN;
    const float* w_sb = F.in(7) + (size_t)l * 384 * D; const float* w_dsa = F.in(8) + (size_t)l * 384 * D; const float* w_hg = F.in(9) + (size_t)l * 256 * D;
    const float* w_out = F.in(10) + (size_t)l * D * D; const float* w_up = F.in(12) + (size_t)l * D * FF; const float* w_down = F.in(13) + (size_t)l * FF * D;
    constexpr int NI_IN = 16 * (3776 / 32 + 3072 / 32);
    constexpr int NI_TOT = NI_IN + 2 * (6 * 32) + 4 * 32 + 16 * 32 + 16 * 128 + 64 * 32;
#define SEGP(W_, ldw_, c0_, nc_, K_, P_, WT_, r0_) { constexpr int nbk = (nc_) / 32, ni = ((K_) / 64) * nbk; if (r < ni) { const int kb = r / nbk, nb = r - kb * nbk; \
        d.src = (W_) + (size_t)(64 * kb) * (ldw_) + (c0_) + 32 * nb; d.dst = (WT_) + (size_t)((r0_) + 32 * nb) * (P_) + 64 * kb; d.ldw = (ldw_); d.ldt = (P_); break; } r -= ni; }
#define SEG(W_, ldw_, c0_, nc_, K_, WT_, r0_) SEGP(W_, ldw_, c0_, nc_, K_, K_, WT_, r0_)
#define DECODE(it_, d) do { int r = (it_); \
        SEG(w_in, D_IN, 768, 384, 1024, Wt_in, G_SV) SEG(w_in, D_IN, 1600, 64, 1024, Wt_in, G_DV) SEG(w_in, D_IN, 0, 384, 1024, Wt_in, NKV + C_SQ) SEG(w_in, D_IN, 384, 384, 1024, Wt_in, G_SK) \
        SEG(w_in, D_IN, 1152, 384, 1024, Wt_in, NKV + C_DQ) SEG(w_in, D_IN, 1536, 64, 1024, Wt_in, NKV + C_DK) SEG(w_in, D_IN, 1664, 512, 1024, Wt_in, NKV + C_IQ) SEG(w_in, D_IN, 2176, 64, 1024, Wt_in, NKV + C_IK) \
        SEG(w_in, D_IN, 2248, 512, 1024, Wt_in, NKV + C_HQ) SEG(w_in, D_IN, 2760, 512, 1024, Wt_in, NKV + C_HF) SEG(w_in, D_IN, 3272, 256, 1024, Wt_in, NKV + C_HI) SEG(w_in, D_IN, 3528, 256, 1024, Wt_in, NKV + C_HG) \
        SEG(w_in, D_IN, 3784, 3072, 1024, Wt_g, 0) SEG(w_sb, D, 0, 1024, 384, Wt_br, 0) SEG(w_dsa, D, 0, 1024, 384, Wt_br, 1024) SEGP(w_hg, D, 0, 1024, 256, 384, Wt_br, 2048) \
        SEG(w_out, D, 0, 1024, 1024, Wt_out, 0) SEG(w_up, FF, 0, 4096, 1024, Wt_up, 0) SEG(w_down, D, 0, 1024, 4096, Wt_down, 0) } while (0)
    {
        int lane = (int)threadIdx.x & 63; asm volatile("" : "+v"(lane));
        TrDesc dc, dn; float tva[32], tvb[32];
        int it = gw;
        if (it < NI_TOT) { TrDesc d; DECODE(it, d); dc = d; tr_load(dc, tva, lane); }
        while (it < NI_TOT) {
            const int itn = it + NGW; const bool more = itn < NI_TOT;
            if (more) { TrDesc d; DECODE(itn, d); dn = d; tr_load(dn, tvb, lane); }
            tr_store(dc, tva, scr, lane);
            if (more) { dc = dn;
#pragma unroll
                for (int i = 0; i < 32; ++i) tva[i] = tvb[i]; }
            it = itn;
        }
    }
#undef DECODE
#undef SEG
#undef SEGP
    static_assert(NI_IN == 16 * ((384 + 64 + 384 + 384 + 384 + 64 + 512 + 64 + 512 + 512 + 256 + 256 + 3072) / 32), "segments");
    for (int idx = F.bid * 512 + tid0; idx < 1024 * 16; idx += F.G * 512) *(u32x4*)(Wt_br + (size_t)(2048 + (idx >> 4)) * 384 + 256 + (idx & 15) * 8) = (u32x4){0u, 0u, 0u, 0u};
    for (int idx = F.bid * 512 + tid0; idx < 64 * 1024; idx += F.G * 512) { const int rr = idx >> 10, k = idx & 1023;
        Wt_in[(size_t)(NKV + C_IW + rr) * 1024 + k] = rr < 8 ? (bf16_t)(cvt_pk_bf16(w_in[(size_t)k * D_IN + 2240 + rr], 0.f) & 0xffff) : (bf16_t)0; }
}

__device__ __forceinline__ void prep_tokens(const Ctx& F, int l) {
    bf16_t* P = (bf16_t*)(F.ws + WS_BIG);
    int lane_ = ((int)threadIdx.x & 63); asm volatile("" : "+v"(lane_));
    const int gw = F.bid * 8 + F.wave, NGW = F.G * 8, lane = lane_, head = lane >> 2, part = lane & 3;
    const float* gq = F.in(3) + l * 64 + part * 16; const float* gk = F.in(4) + l * 64 + part * 16;
    float g[16];
#pragma unroll
    for (int i = 0; i < 16; ++i) g[i] = head < 6 ? gq[i] : (head == 6 ? gk[i] : 1.f);
    const float inv[8] = {1.0f, 0.19392274474868576f, 0.03760603093086393f, 0.007292664737217109f, 0.001414213562373095f, 0.0002742481756762073f, 5.318295896944988e-05f, 1.031338537721246e-05f};
    for (int m0 = gw; m0 < M; m0 += 2 * NGW) {
        const bool two = m0 + NGW < M;
        bf16_t* pp[2] = {P + (size_t)m0 * NPROJ + C_DQ + lane * 16, P + (size_t)(two ? m0 + NGW : m0) * NPROJ + C_DQ + lane * 16};
        u32x4 ra[2], rb[2];
#pragma unroll
        for (int u = 0; u < 2; ++u) { ra[u] = *(const u32x4*)pp[u]; rb[u] = *(const u32x4*)(pp[u] + 8); }
#pragma unroll
        for (int u = 0; u < 2; ++u) {
            if (u == 1 && !two) break;
            const int m = m0 + u * NGW;
            const u32x4 a = ra[u], b = rb[u];
            float v[16] = {bflo(a.x), bfhi(a.x), bflo(a.y), bfhi(a.y), bflo(a.z), bfhi(a.z), bflo(a.w), bfhi(a.w), bflo(b.x), bfhi(b.x), bflo(b.y), bfhi(b.y), bflo(b.z), bfhi(b.z), bflo(b.w), bfhi(b.w)};
            float ss = 0.f;
#pragma unroll
            for (int i = 0; i < 16; ++i) ss += v[i] * v[i];
            ss += __shfl_xor(ss, 1); ss += __shfl_xor(ss, 2);
            const float rstd = head < 7 ? 1.f / sqrtf(ss * (1.f / 64.f) + EPS) : 1.f;
#pragma unroll
            for (int i = 0; i < 16; ++i) v[i] = v[i] * rstd * g[i];
            if (part == 0) {
                const float pos = (float)(m & (T - 1));
#pragma unroll
                for (int i = 0; i < 8; ++i) { const float ang = pos * inv[i], c = __cosf(ang), sn = __sinf(ang), x1 = v[i], x2 = v[i + 8]; v[i] = x1 * c - x2 * sn; v[i + 8] = x2 * c + x1 * sn; }
            }
            u32x4 oa, ob;
            oa.x = cvt_pk_bf16(v[0], v[1]); oa.y = cvt_pk_bf16(v[2], v[3]); oa.z = cvt_pk_bf16(v[4], v[5]); oa.w = cvt_pk_bf16(v[6], v[7]);
            ob.x = cvt_pk_bf16(v[8], v[9]); ob.y = cvt_pk_bf16(v[10], v[11]); ob.z = cvt_pk_bf16(v[12], v[13]); ob.w = cvt_pk_bf16(v[14], v[15]);
            if (head == 6 || head == 15) {
                const int bb = m >> 11, tt = m & (T - 1);
                bf16_t* kf = (bf16_t*)(F.ws + (head == 6 ? WS_KF_DSA : WS_KF_IDX)) + (size_t)(((bb * 64 + (tt >> 5)) * 4 + part)) * 512 + (tt & 31) * 8;
                *(u32x4*)kf = oa; *(u32x4*)(kf + 256) = ob;
            } else { *(u32x4*)pp[u] = oa; *(u32x4*)(pp[u] + 8) = ob; }
        }
    }
}

__device__ __forceinline__ f32x16 mfma32(bf16x8 a, bf16x8 b, f32x16 c) { return __builtin_amdgcn_mfma_f32_32x32x16_bf16(a, b, c, 0, 0, 0); }
__device__ __forceinline__ bf16x8 ld_frag(const bf16_t* p) { return *(const bf16x8*)p; }
__device__ __forceinline__ bf16x8 ld_vfrag(const bf16_t* p) {
    const u32x2 a = *(const u32x2*)p, b = *(const u32x2*)(p + 8); u32x4 w = {a.x, a.y, b.x, b.y}; return __builtin_bit_cast(bf16x8, w);
}
__device__ __forceinline__ bf16x8 pack_p(const f32x16& p, int s) {
    u32x4 w; w.x = cvt_pk_bf16(p[8 * s + 0], p[8 * s + 1]); w.y = cvt_pk_bf16(p[8 * s + 2], p[8 * s + 3]); w.z = cvt_pk_bf16(p[8 * s + 4], p[8 * s + 5]); w.w = cvt_pk_bf16(p[8 * s + 6], p[8 * s + 7]);
    return __builtin_bit_cast(bf16x8, w);
}
__device__ __forceinline__ void store_ot(bf16_t* orow  , const f32x16& o0, const f32x16& o1, int h, float sc) {
#pragma unroll
    for (int g = 0; g < 4; ++g) {
        u32x2 w0, w1; w0.x = cvt_pk_bf16(o0[4 * g] * sc, o0[4 * g + 1] * sc); w0.y = cvt_pk_bf16(o0[4 * g + 2] * sc, o0[4 * g + 3] * sc);
        w1.x = cvt_pk_bf16(o1[4 * g] * sc, o1[4 * g + 1] * sc); w1.y = cvt_pk_bf16(o1[4 * g + 2] * sc, o1[4 * g + 3] * sc);
        *(u32x2*)(orow + 8 * g + 4 * h) = w0; *(u32x2*)(orow + 32 + 8 * g + 4 * h) = w1;
    }
}

#define LOAD_KV(KF, VA, kp_, vp_) do { _Pragma("unroll") for (int s_ = 0; s_ < 4; ++s_) KF[s_] = ld_frag((kp_) + 512 * s_); \
    _Pragma("unroll") for (int db_ = 0; db_ < 2; ++db_) _Pragma("unroll") for (int s_ = 0; s_ < 2; ++s_) VA[db_][s_] = ld_frag((vp_) + 512 * (2 * db_ + s_)); } while (0)

__device__ __forceinline__ void sb_item(const Ctx& F, int b, int hh, int qt) {
    const bf16_t* P = (const bf16_t*)(F.ws + WS_BIG); bf16_t* BR = (bf16_t*)(F.ws + WS_BR);
    int lane_ = ((int)threadIdx.x & 63); asm volatile("" : "+v"(lane_));
    const int lane = lane_, c = lane & 31, h = lane >> 5, tb = b * T, q0 = 32 * qt, tq = q0 + c;
    bf16x8 qf[4];
#pragma unroll
    for (int s = 0; s < 4; ++s) qf[s] = ld_frag(P + (size_t)(tb + q0 + c) * NPROJ + C_SQ + hh * 64 + 16 * s + 8 * h);
    f32x16 o0, o1;
#pragma unroll
    for (int i = 0; i < 16; ++i) { o0[i] = 0.f; o1[i] = 0.f; }
    float carry = 0.f;
    const bf16_t* kp0 = (const bf16_t*)(F.ws + WS_KF_SB) + (size_t)((b * 6 + hh) * 64) * 2048 + lane * 8;
    const bf16_t* vt0 = (const bf16_t*)(F.ws + WS_VF_SB) + (size_t)((b * 6 + hh) * 64) * 2048 + lane * 8;
    bf16x8 kfn[4], van[2][2];
    LOAD_KV(kfn, van, kp0 + (size_t)qt * 2048, vt0 + (size_t)qt * 2048);
    for (int kt = qt; kt >= 0; --kt) {
        const int key0 = 32 * kt;
        bf16x8 kf[4], va[2][2];
#pragma unroll
        for (int s = 0; s < 4; ++s) kf[s] = kfn[s];
#pragma unroll
        for (int db = 0; db < 2; ++db) { va[db][0] = van[db][0]; va[db][1] = van[db][1]; }
        if (kt > 0) LOAD_KV(kfn, van, kp0 + (size_t)(kt - 1) * 2048, vt0 + (size_t)(kt - 1) * 2048);
        f32x16 st;
#pragma unroll
        for (int i = 0; i < 16; ++i) st[i] = 0.f;
#pragma unroll
        for (int s = 0; s < 4; ++s) st = mfma32(kf[s], qf[s], st);
        float z[16], lm[16];
#pragma unroll
        for (int r = 0; r < 16; ++r) {
            const int key = key0 + (r & 3) + 8 * (r >> 2) + 4 * h;
            z[r] = st[r] * 0.125f;
            const float az = fabsf(z[r]);
            const float sp = fmaxf(z[r], 0.f) + flog2(1.f + fexp(-az)) * 0.6931471805599453f;
            lm[r] = key < tq ? -sp : 0.f;
        }
        float gs[4], pg[4], hi[4];
#pragma unroll
        for (int g = 0; g < 4; ++g) { gs[g] = (lm[4 * g] + lm[4 * g + 1]) + (lm[4 * g + 2] + lm[4 * g + 3]); pg[g] = __shfl_xor(gs[g], 32); }
        hi[3] = 0.f; hi[2] = gs[3] + pg[3]; hi[1] = hi[2] + gs[2] + pg[2]; hi[0] = hi[1] + gs[1] + pg[1];
        const float tot = hi[0] + gs[0] + pg[0];
        f32x16 pa;
#pragma unroll
        for (int g = 0; g < 4; ++g) {
            float run = carry + hi[g] + (h == 0 ? pg[g] : 0.f);
#pragma unroll
            for (int i = 3; i >= 0; --i) {
                const int r = 4 * g + i; const int key = key0 + (r & 3) + 8 * (r >> 2) + 4 * h;
                run += lm[r];
                pa[r] = key < tq ? fexp(z[r] + run) : 0.f;
            }
        }
        carry += tot;
        const bf16x8 pb0 = pack_p(pa, 0), pb1 = pack_p(pa, 1);
        o0 = mfma32(va[0][0], pb0, o0); o0 = mfma32(va[0][1], pb1, o0);
        o1 = mfma32(va[1][0], pb0, o1); o1 = mfma32(va[1][1], pb1, o1);
        if (__all(carry < -104.f)) break;
    }
    store_ot(BR + (size_t)(tb + tq) * D + hh * 64, o0, o1, h, 1.f);
}

__device__ __forceinline__ void dsa_loadq(const Ctx& F, int b, int hh, int qt, bf16x8 (&qf)[4]) {
    const bf16_t* P = (const bf16_t*)(F.ws + WS_BIG);
    int lane_ = ((int)threadIdx.x & 63); asm volatile("" : "+v"(lane_));
    const int c = lane_ & 31, h = lane_ >> 5;
#pragma unroll
    for (int s = 0; s < 4; ++s) qf[s] = ld_frag(P + (size_t)(b * T + 32 * qt + c) * NPROJ + C_DQ + hh * 64 + 16 * s + 8 * h);
}
__device__ __forceinline__ void dsa_item(const Ctx& F, int b, int hh, int qt, const bf16x8 (&qf)[4]) {
    const bf16_t* P = (const bf16_t*)(F.ws + WS_BIG); bf16_t* BR = (bf16_t*)(F.ws + WS_BR);
    const unsigned* MK = (const unsigned*)(F.ws + WS_MASK);
    int lane_ = ((int)threadIdx.x & 63); asm volatile("" : "+v"(lane_));
    const int lane = lane_, c = lane & 31, h = lane >> 5, tb = b * T, q0 = 32 * qt, tq = q0 + c;
    f32x16 o0, o1;
#pragma unroll
    for (int i = 0; i < 16; ++i) { o0[i] = 0.f; o1[i] = 0.f; }
    float mrun = -1e30f, lrun = 0.f;
    const bf16_t* kp0 = (const bf16_t*)(F.ws + WS_KF_DSA) + (size_t)(b * 64) * 2048 + lane * 8;
    const bf16_t* vt0 = (const bf16_t*)(F.ws + WS_VF_DSA) + (size_t)(b * 64) * 2048 + lane * 8;
    const unsigned* mrow = MK + (size_t)(tb + tq) * 64;
    bf16x8 kfn[4], van[2][2]; unsigned mwn = mrow[0];
    LOAD_KV(kfn, van, kp0, vt0);
    constexpr float SC2 = 0.125f * LOG2E;
    for (int kt = 0; kt <= qt; ++kt) {
        bf16x8 kf[4], va[2][2]; const unsigned mw = mwn;
#pragma unroll
        for (int s = 0; s < 4; ++s) kf[s] = kfn[s];
#pragma unroll
        for (int db = 0; db < 2; ++db) { va[db][0] = van[db][0]; va[db][1] = van[db][1]; }
        if (kt < qt) { mwn = mrow[kt + 1]; LOAD_KV(kfn, van, kp0 + (size_t)(kt + 1) * 2048, vt0 + (size_t)(kt + 1) * 2048); }
        if (!__any(mw != 0u)) continue;
        f32x16 st;
#pragma unroll
        for (int i = 0; i < 16; ++i) st[i] = 0.f;
#pragma unroll
        for (int s = 0; s < 4; ++s) st = mfma32(kf[s], qf[s], st);
        float mx = fmaxf(fmaxf(fmaxf(st[0], st[1]), fmaxf(st[2], st[3])), fmaxf(fmaxf(st[4], st[5]), fmaxf(st[6], st[7])));
        mx = fmaxf(mx, fmaxf(fmaxf(fmaxf(st[8], st[9]), fmaxf(st[10], st[11])), fmaxf(fmaxf(st[12], st[13]), fmaxf(st[14], st[15]))));
        mx = fmaxf(mx, __shfl_xor(mx, 32));
        const float mnew = fmaxf(mrun, mx);
        if (__any(mnew > mrun)) {
            const float alpha = fexp2((mrun - mnew) * SC2);
            lrun *= alpha;
#pragma unroll
            for (int i = 0; i < 16; ++i) { o0[i] *= alpha; o1[i] *= alpha; }
            mrun = mnew;
        }
        const float nm = -mrun * SC2; const unsigned mh = mw >> (4 * h);
        float ps = 0.f; f32x16 pa;
#pragma unroll
        for (int r = 0; r < 16; ++r) {
            const unsigned keep = (unsigned)__builtin_amdgcn_sbfe((int)mh, (r & 3) + 8 * (r >> 2), 1);
            pa[r] = __builtin_bit_cast(float, __builtin_bit_cast(unsigned, fexp2(__builtin_fmaf(st[r], SC2, nm))) & keep); ps += pa[r];
        }
        ps += __shfl_xor(ps, 32);
        lrun += ps;
        const bf16x8 pb0 = pack_p(pa, 0), pb1 = pack_p(pa, 1);
        o0 = mfma32(va[0][0], pb0, o0); o0 = mfma32(va[0][1], pb1, o0);
        o1 = mfma32(va[1][0], pb0, o1); o1 = mfma32(va[1][1], pb1, o1);
    }
    store_ot(BR + (size_t)(tb + tq) * D + 384 + hh * 64, o0, o1, h, 1.f / lrun);
}

constexpr int SCP = 2052;
constexpr float IDX_SCALE = 0.044194173824159216f;
__device__ __forceinline__ unsigned mono_key(float f) { const unsigned u = __builtin_bit_cast(unsigned, f); return (u & 0x80000000u) ? ~u : (u | 0x80000000u); }
__device__ __forceinline__ int popc64(unsigned long long m) { return __builtin_popcountll(m); }
__device__ __forceinline__ int cnt_ge8(unsigned v0, unsigned v1, unsigned v2, unsigned v3, unsigned v4, unsigned v5, unsigned v6, unsigned v7, unsigned c) {
    unsigned long long m0, m1, m2, m3, m4, m5, m6, m7;
    asm("v_cmp_le_u32_e64 %0, %8, %9\n\tv_cmp_le_u32_e64 %1, %8, %10\n\tv_cmp_le_u32_e64 %2, %8, %11\n\tv_cmp_le_u32_e64 %3, %8, %12\n\t"
        "v_cmp_le_u32_e64 %4, %8, %13\n\tv_cmp_le_u32_e64 %5, %8, %14\n\tv_cmp_le_u32_e64 %6, %8, %15\n\tv_cmp_le_u32_e64 %7, %8, %16"
        : "=&s"(m0), "=&s"(m1), "=&s"(m2), "=&s"(m3), "=&s"(m4), "=&s"(m5), "=&s"(m6), "=&s"(m7)
        : "s"(c), "v"(v0), "v"(v1), "v"(v2), "v"(v3), "v"(v4), "v"(v5), "v"(v6), "v"(v7));
    return (__builtin_popcountll(m0) + __builtin_popcountll(m1)) + (__builtin_popcountll(m2) + __builtin_popcountll(m3)) + (__builtin_popcountll(m4) + __builtin_popcountll(m5)) + (__builtin_popcountll(m6) + __builtin_popcountll(m7));
}
__device__ __forceinline__ int wave_count6(int c) {
    int tot = 0;
#pragma unroll
    for (int b = 0; b < 6; ++b) tot += popc64(__ballot((c >> b) & 1)) << b;
    return tot;
}
__device__ __forceinline__ unsigned long long sel_mask(const unsigned (&uk)[32], unsigned U, int n, int lane, bool exact) {
    unsigned long long mine = 0ull;
    if (exact && n > 256) {
#pragma unroll
        for (int i = 0; i < 32; ++i) { const unsigned long long mk = __ballot(uk[i] >= U); if (lane == i) mine = mk; }
        return mine;
    }
    if (n <= 256) {
#pragma unroll
        for (int i = 0; i < 4; ++i) { const unsigned long long mk = __ballot(i * 64 + lane < n); if (lane == i) mine = mk; }
        return mine;
    }
    int cgt = 0, ce = 0;
#pragma unroll
    for (int i = 0; i < 32; ++i) { cgt += popc64(__ballot(uk[i] > U)); ce += popc64(__ballot(uk[i] == U)); }
    const int need = 256 - cgt;
    int X = 4096;
    if (ce > need) {
        int lo = 0, hi = 2047;
#pragma unroll 1
        while (lo < hi) {
            const int mid = (lo + hi) >> 1; int cl = 0;
#pragma unroll
            for (int i = 0; i < 32; ++i) cl += popc64(__ballot((uk[i] == U) & (i * 64 + lane <= mid)));
            if (cl >= need) hi = mid; else lo = mid + 1;
        }
        X = lo;
    }
#pragma unroll
    for (int i = 0; i < 32; ++i) {
        const unsigned long long mk = __ballot((uk[i] > U) | ((uk[i] == U) & (i * 64 + lane <= X)));
        if (lane == i) mine = mk;
    }
    return mine;
}
__device__ __forceinline__ void index_items(const Ctx& F, int do_sel = 1) {
    const bf16_t* P = (const bf16_t*)(F.ws + WS_BIG); unsigned long long* MK = (unsigned long long*)(F.ws + WS_MASK);
    LAS float* sc = (LAS float*)F.lds;
    int lane_ = ((int)threadIdx.x & 63); asm volatile("" : "+v"(lane_));
    const int lane = lane_, c = lane & 31, h = lane >> 5, wave = F.wave, qq = c & 15, hsel = c >> 4;
    bf16x8 qi[4][4], qn[4][4]; float wv[4], wn[4];
#define IDX_LOADQ(QI, WV, it_) do { const bf16_t* qrow = P + (size_t)(((it_) & 7) * T + 16 * (127 - ((it_) >> 3)) + qq) * NPROJ; \
        _Pragma("unroll") for (int g = 0; g < 4; ++g) { _Pragma("unroll") for (int s = 0; s < 4; ++s) QI[g][s] = ld_frag(qrow + C_IQ + (2 * g + hsel) * 64 + 16 * s + 8 * h); \
            WV[g] = bf2f(qrow[C_IW + 2 * g + hsel]) * IDX_SCALE; } } while (0)
    if (F.bid < NB * 128) IDX_LOADQ(qi, wv, F.bid);
    for (int it = F.bid; it < NB * 128; it += F.G) {
    const int b = it & 7, qb = 127 - (it >> 3), tb = b * T, q0 = 16 * qb;
    const int ntiles = (q0 + 16 + 31) >> 5;
    {
#define IDX_TILE(KF, key0_) do { float sa[16]; \
            _Pragma("unroll") for (int r = 0; r < 16; ++r) sa[r] = 0.f; \
            _Pragma("unroll") for (int g = 0; g < 4; ++g) { f32x16 st; \
                _Pragma("unroll") for (int i = 0; i < 16; ++i) st[i] = 0.f; \
                _Pragma("unroll") for (int s = 0; s < 4; ++s) st = mfma32(KF[s], qi[g][s], st); \
                _Pragma("unroll") for (int r = 0; r < 16; ++r) sa[r] += wv[g] * fmaxf(st[r], 0.f); } \
            _Pragma("unroll") for (int r = 0; r < 16; ++r) sa[r] += __shfl_xor(sa[r], 16); \
            if (hsel == 0) { _Pragma("unroll") for (int g4 = 0; g4 < 4; ++g4) *(LAS f32x4*)(sc + qq * SCP + (key0_) + 8 * g4 + 4 * h) = (f32x4){sa[4 * g4], sa[4 * g4 + 1], sa[4 * g4 + 2], sa[4 * g4 + 3]}; } } while (0)
        const bf16_t* kbase = (const bf16_t*)(F.ws + WS_KF_IDX) + (size_t)(b * 64) * 2048 + lane * 8;
        for (int kt = wave; kt < ntiles; kt += 16) {
            const int kt2 = kt + 8; const bool two = kt2 < ntiles;
            bf16x8 kfa[4], kfb[4];
#pragma unroll
            for (int s = 0; s < 4; ++s) kfa[s] = ld_frag(kbase + (size_t)kt * 2048 + 512 * s);
            if (two) {
#pragma unroll
                for (int s = 0; s < 4; ++s) kfb[s] = ld_frag(kbase + (size_t)kt2 * 2048 + 512 * s);
            }
            IDX_TILE(kfa, 32 * kt);
            if (two) IDX_TILE(kfb, 32 * kt2);
        }
#undef IDX_TILE
    }
    __syncthreads();
    if (it + F.G < NB * 128) IDX_LOADQ(qn, wn, it + F.G);
    if (do_sel) {
        const int qA = 2 * wave, nA = q0 + qA + 1, nB = nA + 1;
        unsigned ua[32], ub[32];
        {
            float sv[32];
#pragma unroll
            for (int i = 0; i < 32; ++i) sv[i] = sc[qA * SCP + i * 64 + lane];
#pragma unroll
            for (int i = 0; i < 32; ++i) ua[i] = (i * 64 + lane < nA) ? mono_key(sv[i]) : 0u;
#pragma unroll
            for (int i = 0; i < 32; ++i) sv[i] = sc[(qA + 1) * SCP + i * 64 + lane];
#pragma unroll
            for (int i = 0; i < 32; ++i) ub[i] = (i * 64 + lane < nB) ? mono_key(sv[i]) : 0u;
        }
        unsigned UA = 0u, UB = 0u; int cntA = 4096, cntB = 4096;
        if (nB > 256) {
            const int nb8 = (nB + 511) >> 9;
#pragma unroll 1
            for (int bit = 31; bit >= 0; --bit) {
                if (cntA == 256 && cntB == 256) break;
                const unsigned ca = UA | (1u << bit), cb = UB | (1u << bit); int na = 0, nbc = 0;
#pragma unroll
                for (int bk = 0; bk < 4; ++bk) if (bk < nb8) {
                    na += cnt_ge8(ua[8 * bk], ua[8 * bk + 1], ua[8 * bk + 2], ua[8 * bk + 3], ua[8 * bk + 4], ua[8 * bk + 5], ua[8 * bk + 6], ua[8 * bk + 7], ca);
                    nbc += cnt_ge8(ub[8 * bk], ub[8 * bk + 1], ub[8 * bk + 2], ub[8 * bk + 3], ub[8 * bk + 4], ub[8 * bk + 5], ub[8 * bk + 6], ub[8 * bk + 7], cb);
                }
                if (na >= 256) { UA = ca; cntA = na; }
                if (nbc >= 256) { UB = cb; cntB = nbc; }
            }
        }
        const unsigned long long mA = sel_mask(ua, UA, nA, lane, cntA == 256), mB = sel_mask(ub, UB, nB, lane, cntB == 256);
        if (lane < 32) { MK[(size_t)(tb + q0 + qA) * 32 + lane] = mA; MK[(size_t)(tb + q0 + qA + 1) * 32 + lane] = mB; }
    }
    __syncthreads();
    if (it + F.G < NB * 128) {
#pragma unroll
        for (int g = 0; g < 4; ++g) { wv[g] = wn[g];
#pragma unroll
            for (int s2 = 0; s2 < 4; ++s2) qi[g][s2] = qn[g][s2]; }
    }
    }
#undef IDX_LOADQ
}

constexpr int HP = 132, AP = 72, KP = 136, TP = 72, OP = 68;
constexpr int H_Q = 0, H_K = 64 * HP * 4, H_B = 2 * 64 * HP * 4;
constexpr int H_ATT = 3 * 64 * HP * 4;
constexpr int H_K2 = H_ATT + 64 * AP * 2;
constexpr int H_KT = H_K2 + 64 * KP * 2;
constexpr int H_DV = H_KT + 128 * TP * 2;
constexpr int H_END = H_DV + 512;
static_assert(H_END <= LDS_BYTES && 64 * KP * 2 <= 64 * HP * 4 && 64 * OP * 4 <= 64 * HP * 4 && 4 * 128 * 4 <= 64 * AP * 2, "hgrn lds");
__device__ __forceinline__ f32x4 mfma16(bf16x8 a, bf16x8 b, f32x4 c) { return __builtin_amdgcn_mfma_f32_16x16x32_bf16(a, b, c, 0, 0, 0); }
__device__ __forceinline__ bf16x8 pack8(const float* v) { u32x4 w; w.x = cvt_pk_bf16(v[0], v[1]); w.y = cvt_pk_bf16(v[2], v[3]); w.z = cvt_pk_bf16(v[4], v[5]); w.w = cvt_pk_bf16(v[6], v[7]); return __builtin_bit_cast(bf16x8, w); }
__device__ __forceinline__ bf16_t bf1(float a) { return (bf16_t)(cvt_pk_bf16(a, 0.f) & 0xffffu); }

template <int MODE>
__device__ __forceinline__ void hgrn_item(const Ctx& F, int l, int b, int hh, int sc) {
    const bf16_t* P = (const bf16_t*)(F.ws + WS_BIG); bf16_t* BR = (bf16_t*)(F.ws + WS_BR); float* HST = (float*)(F.ws + WS_HST);
    LAS unsigned char* L = F.lds;
    LAS float* qS = (LAS float*)(L + H_Q); LAS float* kS = (LAS float*)(L + H_K); LAS float* bS = (LAS float*)(L + H_B); LAS float* tot = (LAS float*)(L + H_ATT); LAS float* Dv = (LAS float*)(L + H_DV);
    LAS bf16_t* att = (LAS bf16_t*)(L + H_ATT); LAS bf16_t* k2 = (LAS bf16_t*)(L + H_K2); LAS bf16_t* kT = (LAS bf16_t*)(L + H_KT); LAS bf16_t* sT = (LAS bf16_t*)(L + H_B); LAS float* oS = (LAS float*)(L + H_Q);
    int tid_ = threadIdx.x; asm volatile("" : "+v"(tid_));
    const int tid = tid_, lane = tid & 63, w = F.wave, n16 = lane & 15, g4 = lane >> 4, tb = b * T + sc * 256;
    const int item = (b * 4 + hh) * 8 + sc;
    f32x4 S[4]; float Dt[4] = {1.f, 1.f, 1.f, 1.f};
#pragma unroll
    for (int i = 0; i < 4; ++i) S[i] = (f32x4){0.f, 0.f, 0.f, 0.f};
    if (MODE == 1 && sc > 0) {
        const float* hp0 = HST + (size_t)((b * 4 + hh) * 8) * HST_STRIDE;
        float dc[4], dn[4]; f32x4 cs[4], ns[4];
#pragma unroll
        for (int r = 0; r < 4; ++r) { const int kk = 16 * w + 4 * g4 + r; dc[r] = hp0[8192 + kk];
#pragma unroll
            for (int vt = 0; vt < 4; ++vt) cs[vt][r] = hp0[kk * 64 + 16 * vt + n16]; }
        for (int i = 0; i < sc; ++i) {
            if (i + 1 < sc) { const float* hp = hp0 + (size_t)(i + 1) * HST_STRIDE;
#pragma unroll
                for (int r = 0; r < 4; ++r) { const int kk = 16 * w + 4 * g4 + r; dn[r] = hp[8192 + kk];
#pragma unroll
                    for (int vt = 0; vt < 4; ++vt) ns[vt][r] = hp[kk * 64 + 16 * vt + n16]; } }
#pragma unroll
            for (int r = 0; r < 4; ++r)
#pragma unroll
                for (int vt = 0; vt < 4; ++vt) S[vt][r] = dc[r] * S[vt][r] + cs[vt][r];
            if (i + 1 < sc) {
#pragma unroll
                for (int r = 0; r < 4; ++r) dc[r] = dn[r];
#pragma unroll
                for (int vt = 0; vt < 4; ++vt) cs[vt] = ns[vt]; }
        }
    }
    const int lcg = (tid & 15) * 8;
    float lb[8];
#pragma unroll
    for (int e = 0; e < 8; ++e) {
        float v = 0.f;
        if (l == 1) { const float l0 = F.in(5)[hh * 128 + lcg + e], l1 = F.in(5)[512 + hh * 128 + lcg + e]; v = 1.f / (1.f + expf(l0 - l1)); }
        lb[e] = v;
    }
    const bf16_t* vf0 = (const bf16_t*)(F.ws + WS_VF_HG) + (size_t)(((b * 4 + hh) * 32 + sc * 4) * 8) * 512 + lane * 8;
    float onv[8];
#pragma unroll
    for (int e = 0; e < 8; ++e) onv[e] = (MODE == 1) ? F.in(6)[l * 64 + (tid & 7) * 8 + e] : 0.f;
    u32x4 fwn[2], qwn[2];
#pragma unroll
    for (int i = 0; i < 2; ++i) { const bf16_t* src = P + (size_t)(tb + ((tid + 512 * i) >> 4)) * NPROJ + hh * 128 + lcg; fwn[i] = *(const u32x4*)(src + C_HF); if (MODE == 1) qwn[i] = *(const u32x4*)(src + C_HQ); }
#pragma unroll 1
    for (int c = 0; c < 4; ++c) {
        const int tok0 = tb + c * 64;
        u32x4 gwp = {0u, 0u, 0u, 0u};
        if (MODE == 1) gwp = *(const u32x4*)(P + (size_t)(tok0 + (tid >> 3)) * NPROJ + C_HG + hh * 64 + (tid & 7) * 8);
        bf16x8 vf[4][2];
#pragma unroll
        for (int vt = 0; vt < 4; ++vt) { vf[vt][0] = ld_frag(vf0 + (size_t)(c * 8 + vt * 2) * 512); vf[vt][1] = ld_frag(vf0 + (size_t)(c * 8 + vt * 2 + 1) * 512); }
#pragma unroll
        for (int i = 0; i < 2; ++i) {
            const int p = tid + 512 * i, row = p >> 4;
            const u32x4 fw = fwn[i];
            const float fx[8] = {bflo(fw.x), bfhi(fw.x), bflo(fw.y), bfhi(fw.y), bflo(fw.z), bfhi(fw.z), bflo(fw.w), bfhi(fw.w)};
            float kv[8], bv[8];
#pragma unroll
            for (int e = 0; e < 8; ++e) { const float f = lb[e] + (1.f - lb[e]) * sigmoidf_(fx[e]); kv[e] = 1.f - f; bv[e] = flog2(fmaxf(f, 1e-12f)); }
            *(LAS f32x4*)(kS + row * HP + lcg) = (f32x4){kv[0], kv[1], kv[2], kv[3]}; *(LAS f32x4*)(kS + row * HP + lcg + 4) = (f32x4){kv[4], kv[5], kv[6], kv[7]};
            *(LAS f32x4*)(bS + row * HP + lcg) = (f32x4){bv[0], bv[1], bv[2], bv[3]}; *(LAS f32x4*)(bS + row * HP + lcg + 4) = (f32x4){bv[4], bv[5], bv[6], bv[7]};
            if (MODE == 1) {
                const u32x4 qw = qwn[i];
                const float qx[8] = {bflo(qw.x), bfhi(qw.x), bflo(qw.y), bfhi(qw.y), bflo(qw.z), bfhi(qw.z), bflo(qw.w), bfhi(qw.w)};
                float qv[8];
#pragma unroll
                for (int e = 0; e < 8; ++e) qv[e] = qx[e] * sigmoidf_(qx[e]);
                *(LAS f32x4*)(qS + row * HP + lcg) = (f32x4){qv[0], qv[1], qv[2], qv[3]}; *(LAS f32x4*)(qS + row * HP + lcg + 4) = (f32x4){qv[4], qv[5], qv[6], qv[7]};
            }
        }
        if (c < 3) {
#pragma unroll
            for (int i = 0; i < 2; ++i) { const bf16_t* src = P + (size_t)(tok0 + 64 + ((tid + 512 * i) >> 4)) * NPROJ + hh * 128 + lcg; fwn[i] = *(const u32x4*)(src + C_HF); if (MODE == 1) qwn[i] = *(const u32x4*)(src + C_HQ); }
        }
        __syncthreads();
        {
            const int part = tid >> 7, k2i = tid & 127;
            float pv[16]; float run = 0.f;
#pragma unroll
            for (int i = 0; i < 16; ++i) { run += bS[(part * 16 + i) * HP + k2i]; pv[i] = run; }
            tot[part * 128 + k2i] = run;
            __syncthreads();
            float pre = 0.f;
#pragma unroll
            for (int pp = 0; pp < 3; ++pp) if (pp < part) pre += tot[pp * 128 + k2i];
#pragma unroll
            for (int i = 0; i < 16; ++i) bS[(part * 16 + i) * HP + k2i] = pv[i] + pre;
        }
        __syncthreads();
        if (MODE == 1) {
            {
                const int t = tid >> 3, j = tid & 7, G = t >> 3, s = 8 * G + j;
                float a = 0.f;
                if (s <= t) {
#pragma unroll 4
                    for (int k4 = 0; k4 < 128; k4 += 4) {
                        const f32x4 q4 = *(const LAS f32x4*)(qS + t * HP + k4), bt = *(const LAS f32x4*)(bS + t * HP + k4), kx = *(const LAS f32x4*)(kS + s * HP + k4), bs = *(const LAS f32x4*)(bS + s * HP + k4);
                        a += q4.x * kx.x * fexp2(bt.x - bs.x) + q4.y * kx.y * fexp2(bt.y - bs.y) + q4.z * kx.z * fexp2(bt.z - bs.z) + q4.w * kx.w * fexp2(bt.w - bs.w);
                    }
                }
                att[t * AP + s] = bf1(a);
                for (int g2 = G + 1; g2 < 8; ++g2) att[t * AP + 8 * g2 + j] = (bf16_t)0;
            }
#pragma unroll
            for (int i = 0; i < 2; ++i) {
                const int p = tid + 512 * i, row = p >> 4, er = (row | 7);
                float kv[8];
#pragma unroll
                for (int e = 0; e < 8; ++e) kv[e] = kS[row * HP + lcg + e] * fexp2(bS[er * HP + lcg + e] - bS[row * HP + lcg + e]);
                *(LAS bf16x8*)(k2 + row * KP + lcg) = pack8(kv);
            }
            __syncthreads();
            for (int pr = w; pr < 16; pr += 8) {
                int I = 0, G = pr; while (G > 2 * I) { G -= 2 * I + 1; ++I; }
                const int t = 16 * I + n16, er = 8 * G + 7, sB = 8 * G + n16;
                f32x4 acc = {0.f, 0.f, 0.f, 0.f};
#pragma unroll
                for (int ks = 0; ks < 4; ++ks) {
                    const int k0 = 32 * ks + 8 * g4;
                    float qv[8];
#pragma unroll
                    for (int hs = 0; hs < 2; ++hs) {
                        const f32x4 q4 = *(const LAS f32x4*)(qS + t * HP + k0 + 4 * hs), bt = *(const LAS f32x4*)(bS + t * HP + k0 + 4 * hs), be = *(const LAS f32x4*)(bS + er * HP + k0 + 4 * hs);
                        qv[4 * hs] = q4.x * fexp2(fminf(bt.x - be.x, 0.f)); qv[4 * hs + 1] = q4.y * fexp2(fminf(bt.y - be.y, 0.f)); qv[4 * hs + 2] = q4.z * fexp2(fminf(bt.z - be.z, 0.f)); qv[4 * hs + 3] = q4.w * fexp2(fminf(bt.w - be.w, 0.f));
                    }
                    const bf16x8 bfr = *(const LAS bf16x8*)(k2 + (sB < 64 ? sB : 63) * KP + k0);
                    acc = mfma16(pack8(qv), bfr, acc);
                }
                if (n16 < 8) {
#pragma unroll
                    for (int r = 0; r < 4; ++r) { const int tt = 16 * I + 4 * g4 + r; if ((tt >> 3) > G) att[tt * AP + 8 * G + n16] = bf1(acc[r]); }
                }
            }
            __syncthreads();
        }
        if (tid < 128) Dv[tid] = fexp2(bS[63 * HP + tid]);
        if (MODE == 1) {
#pragma unroll
            for (int i = 0; i < 2; ++i) {
                const int p = tid + 512 * i, row = p >> 4;
                float qv[8];
#pragma unroll
                for (int e = 0; e < 8; ++e) qv[e] = qS[row * HP + lcg + e] * fexp2(bS[row * HP + lcg + e]);
                *(LAS bf16x8*)(k2 + row * KP + lcg) = pack8(qv);
            }
        }
#pragma unroll
        for (int i = 0; i < 2; ++i) {
            const int p = tid + 512 * i, kk = p & 127, sg = p >> 7;
            const float b63 = bS[63 * HP + kk];
            float kv[8];
#pragma unroll
            for (int e = 0; e < 8; ++e) kv[e] = kS[(8 * sg + e) * HP + kk] * fexp2(b63 - bS[(8 * sg + e) * HP + kk]);
            *(LAS bf16x8*)(kT + kk * TP + 8 * sg) = pack8(kv);
        }
        __syncthreads();
        if (MODE == 1) {
#pragma unroll
            for (int vt = 0; vt < 4; ++vt) { u32x2 pk; pk.x = cvt_pk_bf16(S[vt][0], S[vt][1]); pk.y = cvt_pk_bf16(S[vt][2], S[vt][3]); *(LAS u32x2*)(sT + (16 * vt + n16) * KP + 16 * w + 4 * g4) = pk; }
            __syncthreads();
            if (w < 4) {
                const int t = 16 * w + n16;
                f32x4 o[4];
#pragma unroll
                for (int vt = 0; vt < 4; ++vt) o[vt] = (f32x4){0.f, 0.f, 0.f, 0.f};
#pragma unroll
                for (int ks = 0; ks < 2; ++ks) { const bf16x8 a = *(const LAS bf16x8*)(att + t * AP + 32 * ks + 8 * g4);
#pragma unroll
                    for (int vt = 0; vt < 4; ++vt) o[vt] = mfma16(a, vf[vt][ks], o[vt]); }
#pragma unroll
                for (int ks = 0; ks < 4; ++ks) { const bf16x8 a = *(const LAS bf16x8*)(k2 + t * KP + 32 * ks + 8 * g4);
#pragma unroll
                    for (int vt = 0; vt < 4; ++vt) o[vt] = mfma16(a, *(const LAS bf16x8*)(sT + (16 * vt + n16) * KP + 32 * ks + 8 * g4), o[vt]); }
#pragma unroll
                for (int vt = 0; vt < 4; ++vt)
#pragma unroll
                    for (int r = 0; r < 4; ++r) oS[(16 * w + 4 * g4 + r) * OP + 16 * vt + n16] = o[vt][r];
            }
            __syncthreads();
            {
                const int t = tid >> 3, v0 = (tid & 7) * 8;
                const f32x4 oa = *(const LAS f32x4*)(oS + t * OP + v0), ob = *(const LAS f32x4*)(oS + t * OP + v0 + 4);
                float ss = (oa.x * oa.x + oa.y * oa.y) + (oa.z * oa.z + oa.w * oa.w) + (ob.x * ob.x + ob.y * ob.y) + (ob.z * ob.z + ob.w * ob.w);
                ss += __shfl_xor(ss, 1); ss += __shfl_xor(ss, 2); ss += __shfl_xor(ss, 4);
                const float rstd = 1.f / sqrtf(ss * (1.f / 64.f) + EPS);
                const u32x4 gw = gwp;
                const float gx[8] = {bflo(gw.x), bfhi(gw.x), bflo(gw.y), bfhi(gw.y), bflo(gw.z), bfhi(gw.z), bflo(gw.w), bfhi(gw.w)};
                const float ov[8] = {oa.x, oa.y, oa.z, oa.w, ob.x, ob.y, ob.z, ob.w};
                float y[8];
#pragma unroll
                for (int e = 0; e < 8; ++e) y[e] = ov[e] * rstd * onv[e] * (gx[e] * sigmoidf_(gx[e]));
                u32x4 wv; wv.x = cvt_pk_bf16(y[0], y[1]); wv.y = cvt_pk_bf16(y[2], y[3]); wv.z = cvt_pk_bf16(y[4], y[5]); wv.w = cvt_pk_bf16(y[6], y[7]);
                *(u32x4*)(BR + (size_t)(tok0 + t) * D + 768 + hh * 64 + v0) = wv;
            }
        }
        {
            bf16x8 ka[2];
#pragma unroll
            for (int ks = 0; ks < 2; ++ks) ka[ks] = *(const LAS bf16x8*)(kT + (16 * w + n16) * TP + 32 * ks + 8 * g4);
#pragma unroll
            for (int r = 0; r < 4; ++r) { const float d = Dv[16 * w + 4 * g4 + r]; Dt[r] *= d;
#pragma unroll
                for (int vt = 0; vt < 4; ++vt) S[vt][r] *= d; }
#pragma unroll
            for (int vt = 0; vt < 4; ++vt) { S[vt] = mfma16(ka[0], vf[vt][0], S[vt]); S[vt] = mfma16(ka[1], vf[vt][1], S[vt]); }
        }
        __syncthreads();
    }
    if (MODE == 0) {
        float* hp = HST + (size_t)item * HST_STRIDE;
#pragma unroll
        for (int r = 0; r < 4; ++r) { const int kk = 16 * w + 4 * g4 + r;
#pragma unroll
            for (int vt = 0; vt < 4; ++vt) hp[kk * 64 + 16 * vt + n16] = S[vt][r];
            if (n16 == 0) hp[8192 + kk] = Dt[r]; }
    }
}

#ifndef PHASE_MASK
#define PHASE_MASK 0xfff
#endif
#define PM(i) ((PHASE_MASK >> (i)) & 1)
#if defined(REPEAT_K) && defined(REP_SKIP_SEL)
#define IDX_DO_SEL (rep == 0)
#else
#define IDX_DO_SEL 1
#endif
constexpr int PH_PER_LAYER = 10, N_PHASES = DEPTH * PH_PER_LAYER;
struct Args { const float* in[14]; float* out; unsigned char* ws; int ph_lo, ph_hi; };
static_assert(offsetof(Args, out) == 112 && offsetof(Args, ws) == 120, "Args layout");

__global__ void __launch_bounds__(512, 2) hybrid_fwd(Args args) {
    extern __shared__ __attribute__((aligned(16))) unsigned char lds_raw[];
    cg::grid_group grid = cg::this_grid();
    Ctx F;
    F.lds = (LAS unsigned char*)lds_raw;
    F.wave = __builtin_amdgcn_readfirstlane((int)threadIdx.x >> 6); F.G = gridDim.x; F.bid = blockIdx.x;
    const int gw = F.bid * 8 + F.wave, NGW = F.G * 8;
    for (int i = threadIdx.x; i < LDS_BYTES / 16; i += 512) ((LAS u32x4*)F.lds)[i] = (u32x4){0u, 0u, 0u, 0u};
    __syncthreads();

    for (int ph = args.ph_lo; ph < args.ph_hi; ++ph) {
        const int l = ph / PH_PER_LAYER, k = ph - l * PH_PER_LAYER;
        {
            const CAS unsigned char* ka = (const CAS unsigned char*)__builtin_amdgcn_kernarg_segment_ptr(); asm volatile("" : "+s"(ka));
            F.ka = ka; F.out = *(float* const CAS*)(ka + 112); F.ws = *(unsigned char* const CAS*)(ka + 120);
        }
        unsigned char* ws = F.ws; unsigned char* wt = ws + WS_WT; unsigned char* big = ws + WS_BIG;
        bf16_t* Hb = (bf16_t*)(ws + WS_H); bf16_t* BR = (bf16_t*)(ws + WS_BR);
        const float* xin = (l == 0) ? F.in(0) : F.out;
#ifdef REPEAT_K
        for (int rep = 0; rep < ((k == REPEAT_K) ? REPEAT_N : 1); ++rep) {
        if (rep) grid.sync();
#endif
        if (k == 0 && PM(0)) {
            p0_weights(F, l);
            norm_rows(F, xin, F.in(1) + l * D, Hb);
        } else if (k == 2 && PM(2)) {
#ifdef REPEAT_K
            if (rep == 0)
#endif
            prep_tokens(F, l);
            for (int it = F.bid; it < 256; it += F.G) hgrn_item<0>(F, l, it >> 5, (it >> 3) & 3, it & 7);
        } else if (k == 3 && PM(3)) {
#if defined(REPEAT_K) && defined(REP_ONLY_HGRN)
            if (rep == 0)
#endif
            if (PM(10)) index_items(F, IDX_DO_SEL);
#if defined(REPEAT_K) && defined(REP_ONLY_INDEX)
            if (rep == 0)
#endif
            if (PM(11)) for (int it = F.bid; it < 256; it += F.G) hgrn_item<1>(F, l, it >> 5, (it >> 3) & 3, it & 7);
        } else if (k == 4 && PM(4)) {
            if (F.wave < 6) {
                __builtin_amdgcn_s_setprio(1);
                for (int it = F.bid * 6 + F.wave; it < NB * 6 * 32; it += F.G * 6) { const int bh = it % 48, pi = it / 48; bf16x8 qa[4], qb[4]; dsa_loadq(F, bh / 6, bh % 6, 63 - pi, qa); dsa_loadq(F, bh / 6, bh % 6, pi, qb); dsa_item(F, bh / 6, bh % 6, 63 - pi, qa); dsa_item(F, bh / 6, bh % 6, pi, qb); }
                __builtin_amdgcn_s_setprio(0);
            } else {
                if ((F.G & 7) == 0 && F.G * 12 == NB * 6 * 64) {
                    for (int j = F.wave - 6; j < 12; j += 2) { const int g = (F.bid >> 3) * 12 + j; sb_item(F, F.bid & 7, g % 6, g / 6); }
                } else {
                    for (int it = F.bid * 2 + (F.wave - 6); it < NB * 6 * 64; it += F.G * 2) { const int bh = it % 48, qt = it / 48; sb_item(F, bh / 6, bh % 6, qt); }
                }
            }
        } else if (k == 7 && PM(7)) {
            norm_rows(F, F.out, F.in(11) + l * D, Hb);
        } else if ((k == 1 || k == 5 || k == 6 || k >= 8) && PM(1)) {
            bf16_t* Gt = (bf16_t*)(big + BIG_GT); bf16_t* Mx = (bf16_t*)(big + BIG_MIX);
            const int nsub = (k == 5) ? 2 : 1;
#pragma unroll 1
            for (int sub = 0; sub < nsub; ++sub) {
                pg8::Gemm g; pg8::EpiAll E; E.KVB = ws; E.G16 = Gt; E.Xi = xin; E.Xo = F.out; E.O16 = (bf16_t*)big; E.ldo = D;
                g.M = M; g.N = D; g.K = D; g.lda = D; g.A = Hb; g.a_grp_off = 0; g.align = 1; int reps = 1;
                if (k == 1) { g.Bt = (const bf16_t*)(wt + WT_IN); g.N = NGEMM; E.mode = pg8::EM_PROJ; E.ldo = NPROJ; }
                else if (k == 5) {
                    g.N = 3072; reps = 3;
                    if (sub == 0) { g.Bt = (const bf16_t*)(wt + WT_G); E.mode = pg8::EM_GATE; E.O16 = Gt; E.ldo = 3072; }
                    else { g.A = BR; g.a_grp_off = 384; g.K = 384; g.Bt = (const bf16_t*)(wt + WT_BR); E.mode = pg8::EM_MIXB; E.O16 = Mx; }
                }
                else if (k == 6) { g.A = Mx; g.Bt = (const bf16_t*)(wt + WT_OUT); E.mode = pg8::EM_RES; }
                else if (k == 8) { g.Bt = (const bf16_t*)(wt + WT_UP); g.N = FF; E.mode = pg8::EM_UP; E.ldo = FF; }
                else { g.A = (const bf16_t*)big; g.K = FF; g.lda = FF; g.Bt = (const bf16_t*)(wt + WT_DOWN); E.mode = pg8::EM_RES; E.Xi = F.out; }
                pg8::StaticOrder S; S.init(M, g.N, F.G, F.bid, reps);
                pg8::gemm_phase(F.lds, g, S, E);
            }
        }
#ifdef REPEAT_K
        }
#endif
        if (ph + 1 < args.ph_hi) grid.sync();
    }
}

extern "C" void kernel_launch(void* const* d_in, const int* in_sizes, int n_in, void* d_out, int out_size, void* d_ws, size_t ws_size, hipStream_t stream) {
    static int grid = 0;
    if (grid == 0) {
        if (n_in != 14 || out_size != M * D || ws_size < WS_END) { fprintf(stderr, "kernel_launch: unexpected shapes (n_in %d out %d ws %zu)\n", n_in, out_size, ws_size); grid = -1; return; }
        int dev = 0, cus = 0, per_cu = 0;
        hipGetDevice(&dev); hipDeviceGetAttribute(&cus, hipDeviceAttributeMultiprocessorCount, dev);
        hipFuncSetAttribute((const void*)hybrid_fwd, hipFuncAttributeMaxDynamicSharedMemorySize, LDS_BYTES);
        hipOccupancyMaxActiveBlocksPerMultiprocessor(&per_cu, (const void*)hybrid_fwd, 512, LDS_BYTES);
        (void)hipGetLastError();
        if (per_cu < 1) { fprintf(stderr, "kernel_launch: occupancy query says %d blocks/CU\n", per_cu); per_cu = 1; }
        grid = cus * 1;
        fprintf(stderr, "kernel_launch: grid %d (cus %d, per_cu %d)\n", grid, cus, per_cu);
    }
    if (grid < 0) return;
#ifdef DIAG_MEMSET
    hipMemsetAsync((char*)d_ws + WS_KF_SB, 0, 30 * MiB, stream);
#endif
    Args a{};
    for (int i = 0; i < 14; ++i) a.in[i] = (const float*)d_in[i];
    a.out = (float*)d_out; a.ws = (unsigned char*)d_ws;
#if ONE_LAUNCH
    a.ph_lo = 0; a.ph_hi = N_PHASES;
    void* kargs[] = {&a};
    hipError_t e = hipLaunchCooperativeKernel((const void*)hybrid_fwd, dim3(grid), dim3(512), kargs, LDS_BYTES, stream);
    if (e != hipSuccess) fprintf(stderr, "cooperative launch failed: %s (grid %d)\n", hipGetErrorString(e), grid);
#else
    for (int ph = 0; ph < N_PHASES; ++ph) { a.ph_lo = ph; a.ph_hi = ph + 1; hipLaunchKernelGGL(hybrid_fwd, dim3(grid), dim3(512), LDS_BYTES, stream, a); }
#endif
}
```

```cpp
#include <hip/hip_runtime.h>
#include <hip/hip_cooperative_groups.h>
#include <cstdio>
#include <cstdint>
namespace cg = cooperative_groups;

#ifndef ONE_LAUNCH
#define ONE_LAUNCH 1
#endif

#define LAS __attribute__((address_space(3)))
typedef unsigned short bf16_t;
typedef short bf16x8 __attribute__((ext_vector_type(8)));
typedef short bf16x4 __attribute__((ext_vector_type(4)));
typedef float f32x4 __attribute__((ext_vector_type(4)));
typedef float f32x16 __attribute__((ext_vector_type(16)));
typedef unsigned u32x4 __attribute__((ext_vector_type(4)));
typedef unsigned u32x2 __attribute__((ext_vector_type(2)));

constexpr int D = 1024, NB = 8, T = 2048, DEPTH = 2, M = NB * T, FF = 4096;
constexpr int D_IN = 6856;
constexpr int NGEMM = 3840;
constexpr int G_SV = 0, G_DV = 384, G_SK = 448, NKV = 832, NPROJ = NGEMM - NKV;
constexpr int C_SQ = 0, C_DQ = 384, C_DK = 768, C_IQ = 832, C_IK = 1344, C_HQ = 1408, C_HF = 1920, C_HI = 2432, C_HG = 2688, C_IW = 2944;
constexpr float EPS = 1e-6f;
constexpr float LOG2E = 1.4426950408889634f;

constexpr size_t MiB = 1u << 20;
constexpr size_t WS_WT = 1 * MiB;
constexpr size_t WT_IN = 0, WT_G = WT_IN + (size_t)NGEMM * D * 2, WT_BR = WT_G + (size_t)3072 * D * 2  ,
                 WT_OUT = WT_BR + (size_t)3072 * 384 * 2, WT_UP = WT_OUT + (size_t)D * D * 2, WT_DOWN = WT_UP + (size_t)FF * D * 2,
                 WT_END = WT_DOWN + (size_t)D * FF * 2;
static_assert(WT_END <= 34 * MiB, "weights");
constexpr size_t WS_H = 35 * MiB;
constexpr size_t WS_BR = 67 * MiB;
constexpr size_t WS_BIG = 99 * MiB;
constexpr size_t BIG_GT = 0  , BIG_MIX = 96 * MiB;
constexpr size_t WS_KF_SB = WS_BIG + 96 * MiB, WS_VF_SB = WS_KF_SB + 12 * MiB, WS_KF_DSA = WS_VF_SB + 12 * MiB, WS_VF_DSA = WS_KF_DSA + 2 * MiB, WS_KF_IDX = WS_VF_DSA + 2 * MiB;
static_assert((size_t)M * NPROJ * 2 <= 96 * MiB && WS_KF_IDX + 2 * MiB <= WS_BIG + 128 * MiB, "big");
constexpr size_t WS_MASK = 227 * MiB;
constexpr size_t WS_HST = 231 * MiB;
constexpr size_t HST_STRIDE = 128 * 64 + 128;
constexpr size_t WS_VF_HG = 240 * MiB;
constexpr size_t WS_END = 248 * MiB;
static_assert(WS_HST + 256 * HST_STRIDE * 4 <= WS_END, "ws");

constexpr int LDS_BYTES = 147456;

__device__ __forceinline__ unsigned cvt_pk_bf16(float lo, float hi) { unsigned r; asm volatile("v_cvt_pk_bf16_f32 %0, %1, %2" : "=v"(r) : "v"(lo), "v"(hi)); return r; }
__device__ __forceinline__ float bf2f(unsigned short b) { return __builtin_bit_cast(float, (unsigned)b << 16); }
__device__ __forceinline__ float bflo(unsigned u) { return __builtin_bit_cast(float, u << 16); }
__device__ __forceinline__ float bfhi(unsigned u) { return __builtin_bit_cast(float, u & 0xffff0000u); }
__device__ __forceinline__ float fexp2(float x) { return __builtin_amdgcn_exp2f(x); }
__device__ __forceinline__ float fexp(float x) { return __builtin_amdgcn_exp2f(x * LOG2E); }
__device__ __forceinline__ float flog2(float x) { return __builtin_amdgcn_logf(x); }
__device__ __forceinline__ float frcp(float x) { return __builtin_amdgcn_rcpf(x); }
__device__ __forceinline__ float sigmoidf_(float x) { return frcp(1.f + fexp(-x)); }
__device__ __forceinline__ float wave_sum(float v) {
#pragma unroll
    for (int o = 1; o < 64; o <<= 1) v += __shfl_xor(v, o);
    return v;
}

namespace pg8 {
constexpr int BM = 256, BK = 64, HALF = 128, HTB = HALF * BK * 2, NXCD = 8, WGM = 8;
__host__ __device__ __forceinline__ int lds_byte(int r, int c) { const int st = (r >> 4) * 2 + (c >> 5), rr = r & 15, cc = c & 31, ob = rr * 64 + cc * 2; return st * 1024 + (ob ^ (((ob >> 9) & 1) << 5)); }
__host__ __device__ __forceinline__ void stage_rc(int b, int& R, int& C) { const int st = b / 1024, sb = b % 1024, swz = sb ^ (((sb >> 9) & 1) << 5); R = (st >> 1) * 16 + swz / 64; C = (st & 1) * 32 + (swz % 64) / 2; }
__host__ __device__ __forceinline__ int perm32(int rho) { const int n = rho >> 4, i = rho & 15; return 8 * (i >> 2) + 4 * n + (i & 3); }
struct Unit { int pm, pn; };
struct Gemm { const bf16_t* A; const bf16_t* Bt; int M, N, K, lda, a_grp_off, align; };
struct StaticOrder {
    int nM, nN, nwg, G, c, reps;
    __device__ void init(int M_, int N_, int G_, int c_, int reps_ = 1) { reps = reps_; nM = M_ / BM; nN = N_ / (BM * reps_); nwg = nM * nN; G = G_; c = c_; }
    __device__ bool next(int i, Unit& u) const {
        const int ib = i / reps, br = i - ib * reps;
        const long L = (long)ib * G + c; if (L >= nwg) return false;
        int wgid = (int)L; { const int q = nwg / NXCD, r = nwg % NXCD, xcd = wgid % NXCD, off = wgid / NXCD; wgid = (xcd < r ? xcd * (q + 1) : r * (q + 1) + (xcd - r) * q) + off; }
        const int nig = WGM * nN, gid = wgid / nig, fm = gid * WGM, gsz = (nM - fm) < WGM ? (nM - fm) : WGM;
        u.pm = fm + ((wgid % nig) % gsz); u.pn = br * nN + (wgid % nig) / gsz; return true;
    }
};
template <class Epi>
__device__ __forceinline__ void gemm_phase(LAS unsigned char* lds, const Gemm g, const StaticOrder& S, const Epi& E) {
    int tid_ = threadIdx.x; asm volatile("" : "+v"(tid_));
    const int tid = tid_, wid = __builtin_amdgcn_readfirstlane(tid >> 6), lane = tid & 63, wr = wid >> 2, wc = wid & 3, fr = lane & 15, fq = lane >> 4;
    const int K = g.K, nt = K / BK, lda = g.lda;
    unsigned voffA[2], voffB[2];
#pragma unroll
    for (int i = 0; i < 2; ++i) { int R, C; stage_rc(tid * 16 + i * 8192, R, C); const int Rb = (R & ~31) + perm32(R & 31);
        voffA[i] = (unsigned)(R * lda + C) * 2u; voffB[i] = (unsigned)(Rb * K + C) * 2u; }
    const size_t kstep = (size_t)(BK * 2);
    const size_t hstepA = (size_t)HALF * lda * 2, tstepA = 2 * hstepA;
    const size_t hstepB = (size_t)HALF * K * 2, tstepB = 2 * hstepB;
    const unsigned ldsw = (unsigned)wid * 1024u;
    const int aoff = lds_byte(wr * 64 + fr, fq * 8), boff = lds_byte(wc * 32 + fr, fq * 8);
#define PG8_SA(b, h) (((b) * 2 + (h)) * HTB)
#define PG8_SB(b, h) ((4 + (b) * 2 + (h)) * HTB)
#define PG8_STAGE(bufoff, gbase, voff) do { _Pragma("unroll") for (int _i = 0; _i < 2; ++_i) \
        __builtin_amdgcn_global_load_lds((const unsigned*)((const char*)(gbase) + (voff)[_i]), (LAS unsigned*)(lds + (bufoff) + ldsw + _i * 8192), 16, 0, 0); } while (0)
#define PG8_LDA(dst, b, h) do { _Pragma("unroll") for (int m = 0; m < 4; ++m) _Pragma("unroll") for (int k = 0; k < 2; ++k) dst[m][k] = *(const LAS bf16x8*)(lds + PG8_SA(b, h) + aoff + m * 2048 + k * 1024); } while (0)
#define PG8_LDB(dst, b, h) do { _Pragma("unroll") for (int n = 0; n < 2; ++n) _Pragma("unroll") for (int k = 0; k < 2; ++k) dst[n][k] = *(const LAS bf16x8*)(lds + PG8_SB(b, h) + boff + n * 2048 + k * 1024); } while (0)
#define PG8_MMA(ai, bj, At, Bt) do { __builtin_amdgcn_s_setprio(1); _Pragma("unroll") for (int m = 0; m < 4; ++m) _Pragma("unroll") for (int n = 0; n < 2; ++n) _Pragma("unroll") for (int k = 0; k < 2; ++k) \
        acc[ai][bj][m][n] = __builtin_amdgcn_mfma_f32_16x16x32_bf16(Bt[n][k], At[m][k], acc[ai][bj][m][n], 0, 0, 0); __builtin_amdgcn_s_setprio(0); } while (0)
#define PG8_WAIT_V(n) asm volatile("s_waitcnt vmcnt(" #n ")" ::: "memory")
#define PG8_WAIT_L(n) asm volatile("s_waitcnt lgkmcnt(" #n ")" ::: "memory")
#define PG8_BAR __builtin_amdgcn_s_barrier()
#define PG8_SCHED __builtin_amdgcn_sched_barrier(0)
    Unit cur, nxt; int ui = 0;
    if (!S.next(0, cur)) return;
    f32x4 acc[2][2][4][2];
#pragma unroll
    for (int a = 0; a < 2; ++a)
#pragma unroll
        for (int b = 0; b < 2; ++b)
#pragma unroll
            for (int m = 0; m < 4; ++m)
#pragma unroll
                for (int n = 0; n < 2; ++n) acc[a][b][m][n] = (f32x4){0.f, 0.f, 0.f, 0.f};
    bf16x8 At[4][2], B0[2][2], B1[2][2];
    const size_t agrp = (size_t)g.a_grp_off * 2;
    const char* cA = (const char*)g.A + (size_t)cur.pm * tstepA + (size_t)(cur.pn >> 2) * agrp; const char* cB = (const char*)g.Bt + (size_t)cur.pn * tstepB;
    PG8_STAGE(PG8_SB(0, 0), cB, voffB); PG8_STAGE(PG8_SB(0, 1), cB + hstepB, voffB); PG8_STAGE(PG8_SA(0, 0), cA, voffA); PG8_STAGE(PG8_SA(0, 1), cA + hstepA, voffA);
    if (wr == 1) PG8_BAR;
    PG8_WAIT_V(2); PG8_BAR;
    PG8_STAGE(PG8_SB(1, 0), cB + kstep, voffB); PG8_STAGE(PG8_SA(1, 0), cA + kstep, voffA); PG8_STAGE(PG8_SB(1, 1), cB + hstepB + kstep, voffB);
    PG8_WAIT_V(6); PG8_BAR;
    for (;;) {
        const bool has_next = S.next(ui + 1, nxt);
        const char* nA = has_next ? (const char*)g.A + (size_t)nxt.pm * tstepA + (size_t)(nxt.pn >> 2) * agrp : cA; const char* nB = has_next ? (const char*)g.Bt + (size_t)nxt.pn * tstepB : cB;
        for (int t = 0; t < nt; t += 2) {
            const bool last = (t == nt - 2);
            const char* a1 = cA + (size_t)(t + 1) * kstep;
            const char* a2 = last ? nA : cA + (size_t)(t + 2) * kstep; const char* b2 = last ? nB : cB + (size_t)(t + 2) * kstep;
            const char* a3 = a2 + kstep; const char* b3 = b2 + kstep;
            PG8_LDB(B0, 0, 0); PG8_LDB(B1, 0, 1); PG8_SCHED; PG8_LDA(At, 0, 0); PG8_STAGE(PG8_SA(1, 1), a1 + hstepA, voffA);
            PG8_WAIT_V(8); PG8_WAIT_L(0); PG8_BAR; PG8_MMA(0, 0, At, B0); PG8_MMA(0, 1, At, B1); PG8_BAR; PG8_SCHED;
            PG8_LDA(At, 0, 1); PG8_STAGE(PG8_SB(0, 0), b2, voffB); PG8_STAGE(PG8_SB(0, 1), b2 + hstepB, voffB); PG8_STAGE(PG8_SA(0, 0), a2, voffA);
            PG8_WAIT_V(8); PG8_WAIT_L(0); PG8_BAR; PG8_MMA(1, 0, At, B0); PG8_MMA(1, 1, At, B1); PG8_BAR; PG8_SCHED;
            PG8_LDB(B0, 1, 0); PG8_LDB(B1, 1, 1); PG8_SCHED; PG8_LDA(At, 1, 0); PG8_STAGE(PG8_SA(0, 1), a2 + hstepA, voffA);
            PG8_WAIT_V(8); PG8_WAIT_L(0); PG8_BAR; PG8_MMA(0, 0, At, B0); PG8_MMA(0, 1, At, B1); PG8_BAR; PG8_SCHED;
            PG8_LDA(At, 1, 1); PG8_STAGE(PG8_SB(1, 0), b3, voffB); PG8_STAGE(PG8_SB(1, 1), b3 + hstepB, voffB); PG8_STAGE(PG8_SA(1, 0), a3, voffA);
            PG8_WAIT_V(8); PG8_WAIT_L(0); PG8_BAR; PG8_MMA(1, 0, At, B0); PG8_MMA(1, 1, At, B1); PG8_BAR; PG8_SCHED;
        }
        if (g.align) { if (wr == 0) PG8_BAR; }
        E(acc, cur, wr, wc, fr, fq);
        if (!has_next) break;
#pragma unroll
        for (int a = 0; a < 2; ++a)
#pragma unroll
            for (int b = 0; b < 2; ++b)
#pragma unroll
                for (int m = 0; m < 4; ++m)
#pragma unroll
                    for (int n = 0; n < 2; ++n) acc[a][b][m][n] = (f32x4){0.f, 0.f, 0.f, 0.f};
        cur = nxt; cA = nA; cB = nB; ++ui;
        if (g.align) { if (wr == 1) PG8_BAR; }
    }
    PG8_WAIT_V(0);
    if (!g.align) { if (wr == 0) PG8_BAR; }
    PG8_BAR;
#undef PG8_SA
#undef PG8_SB
#undef PG8_STAGE
#undef PG8_LDA
#undef PG8_LDB
#undef PG8_MMA
#undef PG8_WAIT_V
#undef PG8_WAIT_L
#undef PG8_BAR
#undef PG8_SCHED
}

#define EPI_LOOP_BEGIN \
    _Pragma("unroll") for (int ai = 0; ai < 2; ++ai) _Pragma("unroll") for (int m = 0; m < 4; ++m) { const int row = u.pm * BM + ai * HALF + wr * 64 + m * 16 + fr; \
    _Pragma("unroll") for (int bj = 0; bj < 2; ++bj) { const int col = u.pn * BM + bj * HALF + wc * 32 + 8 * fq; const f32x4 v0 = acc[ai][bj][m][0], v1 = acc[ai][bj][m][1];
#define EPI_LOOP_END } }

enum { EM_PROJ = 0, EM_GATE = 1, EM_MIXB = 2, EM_RES = 5, EM_UP = 6 };
struct EpiAll {
    int mode; bf16_t* O16; int ldo; unsigned char* KVB  ; const bf16_t* G16; const float* Xi; float* Xo;
    __device__ __forceinline__ void operator()(const f32x4 (&acc)[2][2][4][2], const Unit& u, int wr, int wc, int fr, int fq) const {
        asm volatile("" : "+v"(fr), "+v"(fq));
        EPI_LOOP_BEGIN
            if (mode == EM_PROJ) {
                u32x4 w; w.x = cvt_pk_bf16(v0[0], v0[1]); w.y = cvt_pk_bf16(v0[2], v0[3]); w.z = cvt_pk_bf16(v1[0], v1[1]); w.w = cvt_pk_bf16(v1[2], v1[3]);
                const int bb = row >> 11, tt = row & (T - 1), kt = tt >> 5, r = tt & 31;
                if (col < G_SK) {
                    const int isd = col >= G_DV, cc = isd ? col - G_DV : col, hh = cc >> 6, d0 = cc & 63, db = d0 >> 5;
                    const int s2 = r >> 4, k16 = r & 15, jj = 4 * (k16 >> 3) + (k16 & 3), h = (k16 >> 2) & 1;
                    const size_t blk = isd ? (size_t)(((bb * 64 + kt) * 2 + db) * 2 + s2) : (size_t)((((bb * 6 + hh) * 64 + kt) * 2 + db) * 2 + s2);
                    bf16_t* vp = (bf16_t*)(KVB + (isd ? WS_VF_DSA : WS_VF_SB)) + blk * 512 + ((d0 & 31) + 32 * h) * 8 + jj;
                    vp[0] = (bf16_t)(w.x & 0xffff); vp[8] = (bf16_t)(w.x >> 16); vp[16] = (bf16_t)(w.y & 0xffff); vp[24] = (bf16_t)(w.y >> 16);
                    vp[32] = (bf16_t)(w.z & 0xffff); vp[40] = (bf16_t)(w.z >> 16); vp[48] = (bf16_t)(w.w & 0xffff); vp[56] = (bf16_t)(w.w >> 16);
                } else if (col < NKV) {
                    const int cc = col - G_SK, hh = cc >> 6, d0 = cc & 63, s = d0 >> 4, h = (d0 >> 3) & 1;
                    *(u32x4*)((bf16_t*)(KVB + WS_KF_SB) + (size_t)((((bb * 6 + hh) * 64 + kt) * 4 + s)) * 512 + (r + 32 * h) * 8) = w;
                } else if (col >= NKV + C_HI && col < NKV + C_HI + 256) {
                    const int cc = col - (NKV + C_HI), hh = cc >> 6, v0 = cc & 63, s = tt & 63;
                    bf16_t* vp = (bf16_t*)(KVB + WS_VF_HG) + ((size_t)(((((bb * 4 + hh) * 32 + (tt >> 6)) * 4 + (v0 >> 4)) * 2 + (s >> 5))) * 64 + (v0 & 15) + 16 * ((s >> 3) & 3)) * 8 + (s & 7);
                    vp[0] = (bf16_t)(w.x & 0xffff); vp[8] = (bf16_t)(w.x >> 16); vp[16] = (bf16_t)(w.y & 0xffff); vp[24] = (bf16_t)(w.y >> 16);
                    vp[32] = (bf16_t)(w.z & 0xffff); vp[40] = (bf16_t)(w.z >> 16); vp[48] = (bf16_t)(w.w & 0xffff); vp[56] = (bf16_t)(w.w >> 16);
                } else {
                    *(u32x4*)(O16 + (size_t)row * ldo + col - NKV) = w;
                }
            } else if (mode == EM_GATE) {
                u32x4 w; w.x = cvt_pk_bf16(sigmoidf_(v0[0]), sigmoidf_(v0[1])); w.y = cvt_pk_bf16(sigmoidf_(v0[2]), sigmoidf_(v0[3]));
                w.z = cvt_pk_bf16(sigmoidf_(v1[0]), sigmoidf_(v1[1])); w.w = cvt_pk_bf16(sigmoidf_(v1[2]), sigmoidf_(v1[3]));
                *(u32x4*)(O16 + (size_t)row * ldo + col) = w;
            } else if (mode == EM_MIXB) {
                const u32x4 gw = *(const u32x4*)(G16 + (size_t)row * 3072 + col);
                f32x4 r0 = {bflo(gw.x) * v0[0], bfhi(gw.x) * v0[1], bflo(gw.y) * v0[2], bfhi(gw.y) * v0[3]};
                f32x4 r1 = {bflo(gw.z) * v1[0], bfhi(gw.z) * v1[1], bflo(gw.w) * v1[2], bfhi(gw.w) * v1[3]};
                bf16_t* mp = O16 + (size_t)row * D + (col & 1023);
                if (col >= 1024) { const u32x4 pw = *(const u32x4*)mp;
                    r0 += (f32x4){bflo(pw.x), bfhi(pw.x), bflo(pw.y), bfhi(pw.y)}; r1 += (f32x4){bflo(pw.z), bfhi(pw.z), bflo(pw.w), bfhi(pw.w)}; }
                u32x4 w; w.x = cvt_pk_bf16(r0[0], r0[1]); w.y = cvt_pk_bf16(r0[2], r0[3]); w.z = cvt_pk_bf16(r1[0], r1[1]); w.w = cvt_pk_bf16(r1[2], r1[3]);
                *(u32x4*)mp = w;
            } else if (mode == EM_RES) {
                const float* xp = Xi + (size_t)row * D + col; float* op = Xo + (size_t)row * D + col;
                const f32x4 x0 = *(const f32x4*)xp, x1 = *(const f32x4*)(xp + 4);
                *(f32x4*)op = x0 + v0; *(f32x4*)(op + 4) = x1 + v1;
            } else {
                f32x4 a = __builtin_elementwise_max(v0, (f32x4){0.f, 0.f, 0.f, 0.f}), b = __builtin_elementwise_max(v1, (f32x4){0.f, 0.f, 0.f, 0.f}); a = a * a; b = b * b;
                u32x4 w; w.x = cvt_pk_bf16(a[0], a[1]); w.y = cvt_pk_bf16(a[2], a[3]); w.z = cvt_pk_bf16(b[0], b[1]); w.w = cvt_pk_bf16(b[2], b[3]);
                *(u32x4*)(O16 + (size_t)row * ldo + col) = w;
            }
        EPI_LOOP_END
    }
};
}

#define CAS __attribute__((address_space(4)))
struct Ctx {
    LAS unsigned char* lds; int wave, G, bid;
    const CAS unsigned char* ka; float* out; unsigned char* ws;
    __device__ __forceinline__ const float* in(int i) const { return *(const float* const CAS*)(ka + 8 * i); }
};
#define LDS_WAIT() asm volatile("s_waitcnt lgkmcnt(0)" ::: "memory")

struct TrDesc { const float* src; bf16_t* dst; int ldw, ldt; };
__device__ __forceinline__ void tr_load(const TrDesc& d, float (&tv)[32], int lane) {
    const float* wp = d.src + (size_t)(lane >> 5) * d.ldw + (lane & 31);
#pragma unroll
    for (int i = 0; i < 32; ++i) tv[i] = __builtin_nontemporal_load(wp + (size_t)(2 * i) * d.ldw);
}
__device__ __forceinline__ void tr_store(const TrDesc& d, const float (&tv)[32], LAS float* scr, int lane) {
#pragma unroll
    for (int i = 0; i < 32; ++i) scr[(2 * i + (lane >> 5)) * 33 + (lane & 31)] = tv[i];
    LDS_WAIT(); asm volatile("" ::: "memory");
    const int c = lane & 7;
#pragma unroll
    for (int j = 0; j < 4; ++j) { const int n = (lane >> 3) + 8 * j; const LAS float* sp = scr + (8 * c) * 33 + n;
        u32x4 o; o.x = cvt_pk_bf16(sp[0 * 33], sp[1 * 33]); o.y = cvt_pk_bf16(sp[2 * 33], sp[3 * 33]); o.z = cvt_pk_bf16(sp[4 * 33], sp[5 * 33]); o.w = cvt_pk_bf16(sp[6 * 33], sp[7 * 33]);
        *(u32x4*)(d.dst + (size_t)n * d.ldt + 8 * c) = o; }
    LDS_WAIT(); asm volatile("" ::: "memory");
}
__device__ __forceinline__ void rms_row_to_bf16(const float* xrow, const float* gain, bf16_t* orow, int lane) {
    asm volatile("" : "+v"(lane));
    const f32x4* xr = (const f32x4*)xrow + lane; const f32x4* gr = (const f32x4*)gain + lane;
    f32x4 v[4]; float s = 0.f;
#pragma unroll
    for (int j = 0; j < 4; ++j) { v[j] = xr[64 * j]; s += (v[j].x * v[j].x + v[j].y * v[j].y) + (v[j].z * v[j].z + v[j].w * v[j].w); }
    const float rstd = 1.f / sqrtf(wave_sum(s) * (1.f / D) + EPS);
    u32x2* o8 = (u32x2*)orow + lane;
#pragma unroll
    for (int j = 0; j < 4; ++j) { const f32x4 g = gr[64 * j]; u32x2 w; w.x = cvt_pk_bf16(v[j].x * rstd * g.x, v[j].y * rstd * g.y); w.y = cvt_pk_bf16(v[j].z * rstd * g.z, v[j].w * rstd * g.w); o8[64 * j] = w; }
}
__device__ __forceinline__ void norm_rows(const Ctx& F, const float* X, const float* gain, bf16_t* O) {
    const int gw = F.bid * 8 + F.wave, NGW = F.G * 8;
    int lane = (int)threadIdx.x & 63; asm volatile("" : "+v"(lane));
    const f32x4* gr = (const f32x4*)gain + lane;
    for (int m = gw; m < M; m += 2 * NGW) {
        const int m2 = m + NGW; const bool two = m2 < M;
        const f32x4* xa = (const f32x4*)(X + (size_t)m * D) + lane; const f32x4* xb = (const f32x4*)(X + (size_t)(two ? m2 : m) * D) + lane;
        f32x4 va[4], vb[4]; float sa = 0.f, sb = 0.f;
#pragma unroll
        for (int j = 0; j < 4; ++j) { va[j] = xa[64 * j]; vb[j] = xb[64 * j]; }
#pragma unroll
        for (int j = 0; j < 4; ++j) { sa += (va[j].x * va[j].x + va[j].y * va[j].y) + (va[j].z * va[j].z + va[j].w * va[j].w); sb += (vb[j].x * vb[j].x + vb[j].y * vb[j].y) + (vb[j].z * vb[j].z + vb[j].w * vb[j].w); }
#pragma unroll
        for (int o = 1; o < 64; o <<= 1) { sa += __shfl_xor(sa, o); sb += __shfl_xor(sb, o); }
        const float ra = 1.f / sqrtf(sa * (1.f / D) + EPS), rb = 1.f / sqrtf(sb * (1.f / D) + EPS);
        u32x2* oa = (u32x2*)(O + (size_t)m * D) + lane; u32x2* ob = (u32x2*)(O + (size_t)m2 * D) + lane;
#pragma unroll
        for (int j = 0; j < 4; ++j) { const f32x4 g = gr[64 * j];
            u32x2 w; w.x = cvt_pk_bf16(va[j].x * ra * g.x, va[j].y * ra * g.y); w.y = cvt_pk_bf16(va[j].z * ra * g.z, va[j].w * ra * g.w); oa[64 * j] = w;
            if (two) { u32x2 w2; w2.x = cvt_pk_bf16(vb[j].x * rb * g.x, vb[j].y * rb * g.y); w2.y = cvt_pk_bf16(vb[j].z * rb * g.z, vb[j].w * rb * g.w); ob[64 * j] = w2; } }
    }
}
__device__ __forceinline__ void p0_weights(const Ctx& F, int l) {
    LAS float* scr = (LAS float*)(F.lds + F.wave * 16384);
    int tid0 = threadIdx.x; asm volatile("" : "+v"(tid0));
    const int gw = F.bid * 8 + F.wave, NGW = F.G * 8;
    unsigned char* wt = F.ws + WS_WT;
    bf16_t* Wt_in = (bf16_t*)(wt + WT_IN); bf16_t* Wt_g = (bf16_t*)(wt + WT_G); bf16_t* Wt_br = (bf16_t*)(wt + WT_BR);
    bf16_t* Wt_out = (bf16_t*)(wt + WT_OUT); bf16_t* Wt_up = (bf16_t*)(wt + WT_UP); bf16_t* Wt_down = (bf16_t*)(wt + WT_DOWN);
    const float* w_in = F.in(2) + (size_t)l * D * D_IN;
    const float* w_sb = F.in(7) + (size_t)l * 384 * D; const float* w_dsa = F.in(8) + (size_t)l * 384 * D; const float* w_hg = F.in(9) + (size_t)l * 256 * D;
    const float* w_out = F.in(10) + (size_t)l * D * D; const float* w_up = F.in(12) + (size_t)l * D * FF; const float* w_down = F.in(13) + (size_t)l * FF * D;
    constexpr int NI_IN = 16 * (3776 / 32 + 3072 / 32);
    constexpr int NI_TOT = NI_IN + 2 * (6 * 32) + 4 * 32 + 16 * 32 + 16 * 128 + 64 * 32;
#define SEGP(W_, ldw_, c0_, nc_, K_, P_, WT_, r0_) { constexpr int nbk = (nc_) / 32, ni = ((K_) / 64) * nbk; if (r < ni) { const int kb = r / nbk, nb = r - kb * nbk; \
        d.src = (W_) + (size_t)(64 * kb) * (ldw_) + (c0_) + 32 * nb; d.dst = (WT_) + (size_t)((r0_) + 32 * nb) * (P_) + 64 * kb; d.ldw = (ldw_); d.ldt = (P_); break; } r -= ni; }
#define SEG(W_, ldw_, c0_, nc_, K_, WT_, r0_) SEGP(W_, ldw_, c0_, nc_, K_, K_, WT_, r0_)
#define DECODE(it_, d) do { int r = (it_); \
        SEG(w_in, D_IN, 768, 384, 1024, Wt_in, G_SV) SEG(w_in, D_IN, 1600, 64, 1024, Wt_in, G_DV) SEG(w_in, D_IN, 0, 384, 1024, Wt_in, NKV + C_SQ) SEG(w_in, D_IN, 384, 384, 1024, Wt_in, G_SK) \
        SEG(w_in, D_IN, 1152, 384, 1024, Wt_in, NKV + C_DQ) SEG(w_in, D_IN, 1536, 64, 1024, Wt_in, NKV + C_DK) SEG(w_in, D_IN, 1664, 512, 1024, Wt_in, NKV + C_IQ) SEG(w_in, D_IN, 2176, 64, 1024, Wt_in, NKV + C_IK) \
        SEG(w_in, D_IN, 2248, 512, 1024, Wt_in, NKV + C_HQ) SEG(w_in, D_IN, 2760, 512, 1024, Wt_in, NKV + C_HF) SEG(w_in, D_IN, 3272, 256, 1024, Wt_in, NKV + C_HI) SEG(w_in, D_IN, 3528, 256, 1024, Wt_in, NKV + C_HG) \
        SEG(w_in, D_IN, 3784, 3072, 1024, Wt_g, 0) SEG(w_sb, D, 0, 1024, 384, Wt_br, 0) SEG(w_dsa, D, 0, 1024, 384, Wt_br, 1024) SEGP(w_hg, D, 0, 1024, 256, 384, Wt_br, 2048) \
        SEG(w_out, D, 0, 1024, 1024, Wt_out, 0) SEG(w_up, FF, 0, 4096, 1024, Wt_up, 0) SEG(w_down, D, 0, 1024, 4096, Wt_down, 0) } while (0)
    {
        int lane = (int)threadIdx.x & 63; asm volatile("" : "+v"(lane));
        TrDesc dc, dn; float tva[32], tvb[32];
        int it = gw;
        if (it < NI_TOT) { TrDesc d; DECODE(it, d); dc = d; tr_load(dc, tva, lane); }
        while (it < NI_TOT) {
            const int itn = it + NGW; const bool more = itn < NI_TOT;
            if (more) { TrDesc d; DECODE(itn, d); dn = d; tr_load(dn, tvb, lane); }
            tr_store(dc, tva, scr, lane);
            if (more) { dc = dn;
#pragma unroll
                for (int i = 0; i < 32; ++i) tva[i] = tvb[i]; }
            it = itn;
        }
    }
#undef DECODE
#undef SEG
#undef SEGP
    static_assert(NI_IN == 16 * ((384 + 64 + 384 + 384 + 384 + 64 + 512 + 64 + 512 + 512 + 256 + 256 + 3072) / 32), "segments");
    for (int idx = F.bid * 512 + tid0; idx < 1024 * 16; idx += F.G * 512) *(u32x4*)(Wt_br + (size_t)(2048 + (idx >> 4)) * 384 + 256 + (idx & 15) * 8) = (u32x4){0u, 0u, 0u, 0u};
    for (int idx = F.bid * 512 + tid0; idx < 64 * 1024; idx += F.G * 512) { const int rr = idx >> 10, k = idx & 1023;
        Wt_in[(size_t)(NKV + C_IW + rr) * 1024 + k] = rr < 8 ? (bf16_t)(cvt_pk_bf16(w_in[(size_t)k * D_IN + 2240 + rr], 0.f) & 0xffff) : (bf16_t)0; }
}

__device__ __forceinline__ void prep_tokens(const Ctx& F, int l) {
    bf16_t* P = (bf16_t*)(F.ws + WS_BIG);
    int lane_ = ((int)threadIdx.x & 63); asm volatile("" : "+v"(lane_));
    const int gw = F.bid * 8 + F.wave, NGW = F.G * 8, lane = lane_, head = lane >> 2, part = lane & 3;
    const float* gq = F.in(3) + l * 64 + part * 16; const float* gk = F.in(4) + l * 64 + part * 16;
    float g[16];
#pragma unroll
    for (int i = 0; i < 16; ++i) g[i] = head < 6 ? gq[i] : (head == 6 ? gk[i] : 1.f);
    const float inv[8] = {1.0f, 0.19392274474868576f, 0.03760603093086393f, 0.007292664737217109f, 0.001414213562373095f, 0.0002742481756762073f, 5.318295896944988e-05f, 1.031338537721246e-05f};
    for (int m0 = gw; m0 < M; m0 += 2 * NGW) {
        const bool two = m0 + NGW < M;
        bf16_t* pp[2] = {P + (size_t)m0 * NPROJ + C_DQ + lane * 16, P + (size_t)(two ? m0 + NGW : m0) * NPROJ + C_DQ + lane * 16};
        u32x4 ra[2], rb[2];
#pragma unroll
        for (int u = 0; u < 2; ++u) { ra[u] = *(const u32x4*)pp[u]; rb[u] = *(const u32x4*)(pp[u] + 8); }
#pragma unroll
        for (int u = 0; u < 2; ++u) {
            if (u == 1 && !two) break;
            const int m = m0 + u * NGW;
            const u32x4 a = ra[u], b = rb[u];
            float v[16] = {bflo(a.x), bfhi(a.x), bflo(a.y), bfhi(a.y), bflo(a.z), bfhi(a.z), bflo(a.w), bfhi(a.w), bflo(b.x), bfhi(b.x), bflo(b.y), bfhi(b.y), bflo(b.z), bfhi(b.z), bflo(b.w), bfhi(b.w)};
            float ss = 0.f;
#pragma unroll
            for (int i = 0; i < 16; ++i) ss += v[i] * v[i];
            ss += __shfl_xor(ss, 1); ss += __shfl_xor(ss, 2);
            const float rstd = head < 7 ? 1.f / sqrtf(ss * (1.f / 64.f) + EPS) : 1.f;
#pragma unroll
            for (int i = 0; i < 16; ++i) v[i] = v[i] * rstd * g[i];
            if (part == 0) {
                const float pos = (float)(m & (T - 1));
#pragma unroll
                for (int i = 0; i < 8; ++i) { const float ang = pos * inv[i], c = __cosf(ang), sn = __sinf(ang), x1 = v[i], x2 = v[i + 8]; v[i] = x1 * c - x2 * sn; v[i + 8] = x2 * c + x1 * sn; }
            }
            u32x4 oa, ob;
            oa.x = cvt_pk_bf16(v[0], v[1]); oa.y = cvt_pk_bf16(v[2], v[3]); oa.z = cvt_pk_bf16(v[4], v[5]); oa.w = cvt_pk_bf16(v[6], v[7]);
            ob.x = cvt_pk_bf16(v[8], v[9]); ob.y = cvt_pk_bf16(v[10], v[11]); ob.z = cvt_pk_bf16(v[12], v[13]); ob.w = cvt_pk_bf16(v[14], v[15]);
            if (head == 6 || head == 15) {
                const int bb = m >> 11, tt = m & (T - 1);
                bf16_t* kf = (bf16_t*)(F.ws + (head == 6 ? WS_KF_DSA : WS_KF_IDX)) + (size_t)(((bb * 64 + (tt >> 5)) * 4 + part)) * 512 + (tt & 31) * 8;
                *(u32x4*)kf = oa; *(u32x4*)(kf + 256) = ob;
            } else { *(u32x4*)pp[u] = oa; *(u32x4*)(pp[u] + 8) = ob; }
        }
    }
}

__device__ __forceinline__ f32x16 mfma32(bf16x8 a, bf16x8 b, f32x16 c) { return __builtin_amdgcn_mfma_f32_32x32x16_bf16(a, b, c, 0, 0, 0); }
__device__ __forceinline__ bf16x8 ld_frag(const bf16_t* p) { return *(const bf16x8*)p; }
__device__ __forceinline__ bf16x8 ld_vfrag(const bf16_t* p) {
    const u32x2 a = *(const u32x2*)p, b = *(const u32x2*)(p + 8); u32x4 w = {a.x, a.y, b.x, b.y}; return __builtin_bit_cast(bf16x8, w);
}
__device__ __forceinline__ bf16x8 pack_p(const f32x16& p, int s) {
    u32x4 w; w.x = cvt_pk_bf16(p[8 * s + 0], p[8 * s + 1]); w.y = cvt_pk_bf16(p[8 * s + 2], p[8 * s + 3]); w.z = cvt_pk_bf16(p[8 * s + 4], p[8 * s + 5]); w.w = cvt_pk_bf16(p[8 * s + 6], p[8 * s + 7]);
    return __builtin_bit_cast(bf16x8, w);
}
__device__ __forceinline__ void store_ot(bf16_t* orow  , const f32x16& o0, const f32x16& o1, int h, float sc) {
#pragma unroll
    for (int g = 0; g < 4; ++g) {
        u32x2 w0, w1; w0.x = cvt_pk_bf16(o0[4 * g] * sc, o0[4 * g + 1] * sc); w0.y = cvt_pk_bf16(o0[4 * g + 2] * sc, o0[4 * g + 3] * sc);
        w1.x = cvt_pk_bf16(o1[4 * g] * sc, o1[4 * g + 1] * sc); w1.y = cvt_pk_bf16(o1[4 * g + 2] * sc, o1[4 * g + 3] * sc);
        *(u32x2*)(orow + 8 * g + 4 * h) = w0; *(u32x2*)(orow + 32 + 8 * g + 4 * h) = w1;
    }
}

#define LOAD_KV(KF, VA, kp_, vp_) do { _Pragma("unroll") for (int s_ = 0; s_ < 4; ++s_) KF[s_] = ld_frag((kp_) + 512 * s_); \
    _Pragma("unroll") for (int db_ = 0; db_ < 2; ++db_) _Pragma("unroll") for (int s_ = 0; s_ < 2; ++s_) VA[db_][s_] = ld_frag((vp_) + 512 * (2 * db_ + s_)); } while (0)

__device__ __forceinline__ void sb_item(const Ctx& F, int b, int hh, int qt) {
    const bf16_t* P = (const bf16_t*)(F.ws + WS_BIG); bf16_t* BR = (bf16_t*)(F.ws + WS_BR);
    int lane_ = ((int)threadIdx.x & 63); asm volatile("" : "+v"(lane_));
    const int lane = lane_, c = lane & 31, h = lane >> 5, tb = b * T, q0 = 32 * qt, tq = q0 + c;
    bf16x8 qf[4];
#pragma unroll
    for (int s = 0; s < 4; ++s) qf[s] = ld_frag(P + (size_t)(tb + q0 + c) * NPROJ + C_SQ + hh * 64 + 16 * s + 8 * h);
    f32x16 o0, o1;
#pragma unroll
    for (int i = 0; i < 16; ++i) { o0[i] = 0.f; o1[i] = 0.f; }
    float carry = 0.f;
    const bf16_t* kp0 = (const bf16_t*)(F.ws + WS_KF_SB) + (size_t)((b * 6 + hh) * 64) * 2048 + lane * 8;
    const bf16_t* vt0 = (const bf16_t*)(F.ws + WS_VF_SB) + (size_t)((b * 6 + hh) * 64) * 2048 + lane * 8;
    bf16x8 kfn[4], van[2][2];
    LOAD_KV(kfn, van, kp0 + (size_t)qt * 2048, vt0 + (size_t)qt * 2048);
    for (int kt = qt; kt >= 0; --kt) {
        const int key0 = 32 * kt;
        bf16x8 kf[4], va[2][2];
#pragma unroll
        for (int s = 0; s < 4; ++s) kf[s] = kfn[s];
#pragma unroll
        for (int db = 0; db < 2; ++db) { va[db][0] = van[db][0]; va[db][1] = van[db][1]; }
        if (kt > 0) LOAD_KV(kfn, van, kp0 + (size_t)(kt - 1) * 2048, vt0 + (size_t)(kt - 1) * 2048);
        f32x16 st;
#pragma unroll
        for (int i = 0; i < 16; ++i) st[i] = 0.f;
#pragma unroll
        for (int s = 0; s < 4; ++s) st = mfma32(kf[s], qf[s], st);
        float z[16], lm[16];
#pragma unroll
        for (int r = 0; r < 16; ++r) {
            const int key = key0 + (r & 3) + 8 * (r >> 2) + 4 * h;
            z[r] = st[r] * 0.125f;
            const float az = fabsf(z[r]);
            const float sp = fmaxf(z[r], 0.f) + flog2(1.f + fexp(-az)) * 0.6931471805599453f;
            lm[r] = key < tq ? -sp : 0.f;
        }
        float gs[4], pg[4], hi[4];
#pragma unroll
        for (int g = 0; g < 4; ++g) { gs[g] = (lm[4 * g] + lm[4 * g + 1]) + (lm[4 * g + 2] + lm[4 * g + 3]); pg[g] = __shfl_xor(gs[g], 32); }
        hi[3] = 0.f; hi[2] = gs[3] + pg[3]; hi[1] = hi[2] + gs[2] + pg[2]; hi[0] = hi[1] + gs[1] + pg[1];
        const float tot = hi[0] + gs[0] + pg[0];
        f32x16 pa;
#pragma unroll
        for (int g = 0; g < 4; ++g) {
            float run = carry + hi[g] + (h == 0 ? pg[g] : 0.f);
#pragma unroll
            for (int i = 3; i >= 0; --i) {
                const int r = 4 * g + i; const int key = key0 + (r & 3) + 8 * (r >> 2) + 4 * h;
                run += lm[r];
                pa[r] = key < tq ? fexp(z[r] + run) : 0.f;
            }
        }
        carry += tot;
        const bf16x8 pb0 = pack_p(pa, 0), pb1 = pack_p(pa, 1);
        o0 = mfma32(va[0][0], pb0, o0); o0 = mfma32(va[0][1], pb1, o0);
        o1 = mfma32(va[1][0], pb0, o1); o1 = mfma32(va[1][1], pb1, o1);
        if (__all(carry < -104.f)) break;
    }
    store_ot(BR + (size_t)(tb + tq) * D + hh * 64, o0, o1, h, 1.f);
}

__device__ __forceinline__ void dsa_loadq(const Ctx& F, int b, int hh, int qt, bf16x8 (&qf)[4]) {
    const bf16_t* P = (const bf16_t*)(F.ws + WS_BIG);
    int lane_ = ((int)threadIdx.x & 63); asm volatile("" : "+v"(lane_));
    const int c = lane_ & 31, h = lane_ >> 5;
#pragma unroll
    for (int s = 0; s < 4; ++s) qf[s] = ld_frag(P + (size_t)(b * T + 32 * qt + c) * NPROJ + C_DQ + hh * 64 + 16 * s + 8 * h);
}
__device__ __forceinline__ void dsa_item(const Ctx& F, int b, int hh, int qt, const bf16x8 (&qf)[4]) {
    const bf16_t* P = (const bf16_t*)(F.ws + WS_BIG); bf16_t* BR = (bf16_t*)(F.ws + WS_BR);
    const unsigned* MK = (const unsigned*)(F.ws + WS_MASK);
    int lane_ = ((int)threadIdx.x & 63); asm volatile("" : "+v"(lane_));
    const int lane = lane_, c = lane & 31, h = lane >> 5, tb = b * T, q0 = 32 * qt, tq = q0 + c;
    f32x16 o0, o1;
#pragma unroll
    for (int i = 0; i < 16; ++i) { o0[i] = 0.f; o1[i] = 0.f; }
    float mrun = -1e30f, lrun = 0.f;
    const bf16_t* kp0 = (const bf16_t*)(F.ws + WS_KF_DSA) + (size_t)(b * 64) * 2048 + lane * 8;
    const bf16_t* vt0 = (const bf16_t*)(F.ws + WS_VF_DSA) + (size_t)(b * 64) * 2048 + lane * 8;
    const unsigned* mrow = MK + (size_t)(tb + tq) * 64;
    bf16x8 kfn[4], van[2][2]; unsigned mwn = mrow[0];
    LOAD_KV(kfn, van, kp0, vt0);
    constexpr float SC2 = 0.125f * LOG2E;
    for (int kt = 0; kt <= qt; ++kt) {
        bf16x8 kf[4], va[2][2]; const unsigned mw = mwn;
#pragma unroll
        for (int s = 0; s < 4; ++s) kf[s] = kfn[s];
#pragma unroll
        for (int db = 0; db < 2; ++db) { va[db][0] = van[db][0]; va[db][1] = van[db][1]; }
        if (kt < qt) { mwn = mrow[kt + 1]; LOAD_KV(kfn, van, kp0 + (size_t)(kt + 1) * 2048, vt0 + (size_t)(kt + 1) * 2048); }
        if (!__any(mw != 0u)) continue;
        f32x16 st;
#pragma unroll
        for (int i = 0; i < 16; ++i) st[i] = 0.f;
#pragma unroll
        for (int s = 0; s < 4; ++s) st = mfma32(kf[s], qf[s], st);
        float mx = fmaxf(fmaxf(fmaxf(st[0], st[1]), fmaxf(st[2], st[3])), fmaxf(fmaxf(st[4], st[5]), fmaxf(st[6], st[7])));
        mx = fmaxf(mx, fmaxf(fmaxf(fmaxf(st[8], st[9]), fmaxf(st[10], st[11])), fmaxf(fmaxf(st[12], st[13]), fmaxf(st[14], st[15]))));
        mx = fmaxf(mx, __shfl_xor(mx, 32));
        const float mnew = fmaxf(mrun, mx);
        if (__any(mnew > mrun)) {
            const float alpha = fexp2((mrun - mnew) * SC2);
            lrun *= alpha;
#pragma unroll
            for (int i = 0; i < 16; ++i) { o0[i] *= alpha; o1[i] *= alpha; }
            mrun = mnew;
        }
        const float nm = -mrun * SC2; const unsigned mh = mw >> (4 * h);
        float ps = 0.f; f32x16 pa;
#pragma unroll
        for (int r = 0; r < 16; ++r) {
            const unsigned keep = (unsigned)__builtin_amdgcn_sbfe((int)mh, (r & 3) + 8 * (r >> 2), 1);
            pa[r] = __builtin_bit_cast(float, __builtin_bit_cast(unsigned, fexp2(__builtin_fmaf(st[r], SC2, nm))) & keep); ps += pa[r];
        }
        ps += __shfl_xor(ps, 32);
        lrun += ps;
        const bf16x8 pb0 = pack_p(pa, 0), pb1 = pack_p(pa, 1);
        o0 = mfma32(va[0][0], pb0, o0); o0 = mfma32(va[0][1], pb1, o0);
        o1 = mfma32(va[1][0], pb0, o1); o1 = mfma32(va[1][1], pb1, o1);
    }
    store_ot(BR + (size_t)(tb + tq) * D + 384 + hh * 64, o0, o1, h, 1.f / lrun);
}

constexpr int SCP = 2052;
constexpr float IDX_SCALE = 0.044194173824159216f;
__device__ __forceinline__ unsigned mono_key(float f) { const unsigned u = __builtin_bit_cast(unsigned, f); return (u & 0x80000000u) ? ~u : (u | 0x80000000u); }
__device__ __forceinline__ int popc64(unsigned long long m) { return __builtin_popcountll(m); }
__device__ __forceinline__ int cnt_ge8(unsigned v0, unsigned v1, unsigned v2, unsigned v3, unsigned v4, unsigned v5, unsigned v6, unsigned v7, unsigned c) {
    unsigned long long m0, m1, m2, m3, m4, m5, m6, m7;
    asm("v_cmp_le_u32_e64 %0, %8, %9\n\tv_cmp_le_u32_e64 %1, %8, %10\n\tv_cmp_le_u32_e64 %2, %8, %11\n\tv_cmp_le_u32_e64 %3, %8, %12\n\t"
        "v_cmp_le_u32_e64 %4, %8, %13\n\tv_cmp_le_u32_e64 %5, %8, %14\n\tv_cmp_le_u32_e64 %6, %8, %15\n\tv_cmp_le_u32_e64 %7, %8, %16"
        : "=&s"(m0), "=&s"(m1), "=&s"(m2), "=&s"(m3), "=&s"(m4), "=&s"(m5), "=&s"(m6), "=&s"(m7)
        : "s"(c), "v"(v0), "v"(v1), "v"(v2), "v"(v3), "v"(v4), "v"(v5), "v"(v6), "v"(v7));
    return (__builtin_popcountll(m0) + __builtin_popcountll(m1)) + (__builtin_popcountll(m2) + __builtin_popcountll(m3)) + (__builtin_popcountll(m4) + __builtin_popcountll(m5)) + (__builtin_popcountll(m6) + __builtin_popcountll(m7));
}
__device__ __forceinline__ int wave_count6(int c) {
    int tot = 0;
#pragma unroll
    for (int b = 0; b < 6; ++b) tot += popc64(__ballot((c >> b) & 1)) << b;
    return tot;
}
__device__ __forceinline__ unsigned long long sel_mask(const unsigned (&uk)[32], unsigned U, int n, int lane, bool exact) {
    unsigned long long mine = 0ull;
    if (exact && n > 256) {
#pragma unroll
        for (int i = 0; i < 32; ++i) { const unsigned long long mk = __ballot(uk[i] >= U); if (lane == i) mine = mk; }
        return mine;
    }
    if (n <= 256) {
#pragma unroll
        for (int i = 0; i < 4; ++i) { const unsigned long long mk = __ballot(i * 64 + lane < n); if (lane == i) mine = mk; }
        return mine;
    }
    int cgt = 0, ce = 0;
#pragma unroll
    for (int i = 0; i < 32; ++i) { cgt += popc64(__ballot(uk[i] > U)); ce += popc64(__ballot(uk[i] == U)); }
    const int need = 256 - cgt;
    int X = 4096;
    if (ce > need) {
        int lo = 0, hi = 2047;
#pragma unroll 1
        while (lo < hi) {
            const int mid = (lo + hi) >> 1; int cl = 0;
#pragma unroll
            for (int i = 0; i < 32; ++i) cl += popc64(__ballot((uk[i] == U) & (i * 64 + lane <= mid)));
            if (cl >= need) hi = mid; else lo = mid + 1;
        }
        X = lo;
    }
#pragma unroll
    for (int i = 0; i < 32; ++i) {
        const unsigned long long mk = __ballot((uk[i] > U) | ((uk[i] == U) & (i * 64 + lane <= X)));
        if (lane == i) mine = mk;
    }
    return mine;
}
__device__ __forceinline__ void index_items(const Ctx& F, int do_sel = 1) {
    const bf16_t* P = (const bf16_t*)(F.ws + WS_BIG); unsigned long long* MK = (unsigned long long*)(F.ws + WS_MASK);
    LAS float* sc = (LAS float*)F.lds;
    int lane_ = ((int)threadIdx.x & 63); asm volatile("" : "+v"(lane_));
    const int lane = lane_, c = lane & 31, h = lane >> 5, wave = F.wave, qq = c & 15, hsel = c >> 4;
    bf16x8 qi[4][4], qn[4][4]; float wv[4], wn[4];
#define IDX_LOADQ(QI, WV, it_) do { const bf16_t* qrow = P + (size_t)(((it_) & 7) * T + 16 * (127 - ((it_) >> 3)) + qq) * NPROJ; \
        _Pragma("unroll") for (int g = 0; g < 4; ++g) { _Pragma("unroll") for (int s = 0; s < 4; ++s) QI[g][s] = ld_frag(qrow + C_IQ + (2 * g + hsel) * 64 + 16 * s + 8 * h); \
            WV[g] = bf2f(qrow[C_IW + 2 * g + hsel]) * IDX_SCALE; } } while (0)
    if (F.bid < NB * 128) IDX_LOADQ(qi, wv, F.bid);
    for (int it = F.bid; it < NB * 128; it += F.G) {
    const int b = it & 7, qb = 127 - (it >> 3), tb = b * T, q0 = 16 * qb;
    const int ntiles = (q0 + 16 + 31) >> 5;
    {
#define IDX_TILE(KF, key0_) do { float sa[16]; \
            _Pragma("unroll") for (int r = 0; r < 16; ++r) sa[r] = 0.f; \
            _Pragma("unroll") for (int g = 0; g < 4; ++g) { f32x16 st; \
                _Pragma("unroll") for (int i = 0; i < 16; ++i) st[i] = 0.f; \
                _Pragma("unroll") for (int s = 0; s < 4; ++s) st = mfma32(KF[s], qi[g][s], st); \
                _Pragma("unroll") for (int r = 0; r < 16; ++r) sa[r] += wv[g] * fmaxf(st[r], 0.f); } \
            _Pragma("unroll") for (int r = 0; r < 16; ++r) sa[r] += __shfl_xor(sa[r], 16); \
            if (hsel == 0) { _Pragma("unroll") for (int g4 = 0; g4 < 4; ++g4) *(LAS f32x4*)(sc + qq * SCP + (key0_) + 8 * g4 + 4 * h) = (f32x4){sa[4 * g4], sa[4 * g4 + 1], sa[4 * g4 + 2], sa[4 * g4 + 3]}; } } while (0)
        const bf16_t* kbase = (const bf16_t*)(F.ws + WS_KF_IDX) + (size_t)(b * 64) * 2048 + lane * 8;
        for (int kt = wave; kt < ntiles; kt += 16) {
            const int kt2 = kt + 8; const bool two = kt2 < ntiles;
            bf16x8 kfa[4], kfb[4];
#pragma unroll
            for (int s = 0; s < 4; ++s) kfa[s] = ld_frag(kbase + (size_t)kt * 2048 + 512 * s);
            if (two) {
#pragma unroll
                for (int s = 0; s < 4; ++s) kfb[s] = ld_frag(kbase + (size_t)kt2 * 2048 + 512 * s);
            }
            IDX_TILE(kfa, 32 * kt);
            if (two) IDX_TILE(kfb, 32 * kt2);
        }
#undef IDX_TILE
    }
    __syncthreads();
    if (it + F.G < NB * 128) IDX_LOADQ(qn, wn, it + F.G);
    if (do_sel) {
        const int qA = 2 * wave, nA = q0 + qA + 1, nB = nA + 1;
        unsigned ua[32], ub[32];
        {
            float sv[32];
#pragma unroll
            for (int i = 0; i < 32; ++i) sv[i] = sc[qA * SCP + i * 64 + lane];
#pragma unroll
            for (int i = 0; i < 32; ++i) ua[i] = (i * 64 + lane < nA) ? mono_key(sv[i]) : 0u;
#pragma unroll
            for (int i = 0; i < 32; ++i) sv[i] = sc[(qA + 1) * SCP + i * 64 + lane];
#pragma unroll
            for (int i = 0; i < 32; ++i) ub[i] = (i * 64 + lane < nB) ? mono_key(sv[i]) : 0u;
        }
        unsigned UA = 0u, UB = 0u; int cntA = 4096, cntB = 4096;
        if (nB > 256) {
            const int nb8 = (nB + 511) >> 9;
#pragma unroll 1
            for (int bit = 31; bit >= 0; --bit) {
                if (cntA == 256 && cntB == 256) break;
                const unsigned ca = UA | (1u << bit), cb = UB | (1u << bit); int na = 0, nbc = 0;
#pragma unroll
                for (int bk = 0; bk < 4; ++bk) if (bk < nb8) {
                    na += cnt_ge8(ua[8 * bk], ua[8 * bk + 1], ua[8 * bk + 2], ua[8 * bk + 3], ua[8 * bk + 4], ua[8 * bk + 5], ua[8 * bk + 6], ua[8 * bk + 7], ca);
                    nbc += cnt_ge8(ub[8 * bk], ub[8 * bk + 1], ub[8 * bk + 2], ub[8 * bk + 3], ub[8 * bk + 4], ub[8 * bk + 5], ub[8 * bk + 6], ub[8 * bk + 7], cb);
                }
                if (na >= 256) { UA = ca; cntA = na; }
                if (nbc >= 256) { UB = cb; cntB = nbc; }
            }
        }
        const unsigned long long mA = sel_mask(ua, UA, nA, lane, cntA == 256), mB = sel_mask(ub, UB, nB, lane, cntB == 256);
        if (lane < 32) { MK[(size_t)(tb + q0 + qA) * 32 + lane] = mA; MK[(size_t)(tb + q0 + qA + 1) * 32 + lane] = mB; }
    }
    __syncthreads();
    if (it + F.G < NB * 128) {
#pragma unroll
        for (int g = 0; g < 4; ++g) { wv[g] = wn[g];
#pragma unroll
            for (int s2 = 0; s2 < 4; ++s2) qi[g][s2] = qn[g][s2]; }
    }
    }
#undef IDX_LOADQ
}

constexpr int HP = 132, AP = 72, KP = 136, TP = 72, OP = 68;
constexpr int H_Q = 0, H_K = 64 * HP * 4, H_B = 2 * 64 * HP * 4;
constexpr int H_ATT = 3 * 64 * HP * 4;
constexpr int H_K2 = H_ATT + 64 * AP * 2;
constexpr int H_KT = H_K2 + 64 * KP * 2;
constexpr int H_DV = H_KT + 128 * TP * 2;
constexpr int H_END = H_DV + 512;
static_assert(H_END <= LDS_BYTES && 64 * KP * 2 <= 64 * HP * 4 && 64 * OP * 4 <= 64 * HP * 4 && 4 * 128 * 4 <= 64 * AP * 2, "hgrn lds");
__device__ __forceinline__ f32x4 mfma16(bf16x8 a, bf16x8 b, f32x4 c) { return __builtin_amdgcn_mfma_f32_16x16x32_bf16(a, b, c, 0, 0, 0); }
__device__ __forceinline__ bf16x8 pack8(const float* v) { u32x4 w; w.x = cvt_pk_bf16(v[0], v[1]); w.y = cvt_pk_bf16(v[2], v[3]); w.z = cvt_pk_bf16(v[4], v[5]); w.w = cvt_pk_bf16(v[6], v[7]); return __builtin_bit_cast(bf16x8, w); }
__device__ __forceinline__ bf16_t bf1(float a) { return (bf16_t)(cvt_pk_bf16(a, 0.f) & 0xffffu); }

template <int MODE>
__device__ __forceinline__ void hgrn_item(const Ctx& F, int l, int b, int hh, int sc) {
    const bf16_t* P = (const bf16_t*)(F.ws + WS_BIG); bf16_t* BR = (bf16_t*)(F.ws + WS_BR); float* HST = (float*)(F.ws + WS_HST);
    LAS unsigned char* L = F.lds;
    LAS float* qS = (LAS float*)(L + H_Q); LAS float* kS = (LAS float*)(L + H_K); LAS float* bS = (LAS float*)(L + H_B); LAS float* tot = (LAS float*)(L + H_ATT); LAS float* Dv = (LAS float*)(L + H_DV);
    LAS bf16_t* att = (LAS bf16_t*)(L + H_ATT); LAS bf16_t* k2 = (LAS bf16_t*)(L + H_K2); LAS bf16_t* kT = (LAS bf16_t*)(L + H_KT); LAS bf16_t* sT = (LAS bf16_t*)(L + H_B); LAS float* oS = (LAS float*)(L + H_Q);
    int tid_ = threadIdx.x; asm volatile("" : "+v"(tid_));
    const int tid = tid_, lane = tid & 63, w = F.wave, n16 = lane & 15, g4 = lane >> 4, tb = b * T + sc * 256;
    const int item = (b * 4 + hh) * 8 + sc;
    f32x4 S[4]; float Dt[4] = {1.f, 1.f, 1.f, 1.f};
#pragma unroll
    for (int i = 0; i < 4; ++i) S[i] = (f32x4){0.f, 0.f, 0.f, 0.f};
    if (MODE == 1 && sc > 0) {
        const float* hp0 = HST + (size_t)((b * 4 + hh) * 8) * HST_STRIDE;
        float dc[4], dn[4]; f32x4 cs[4], ns[4];
#pragma unroll
        for (int r = 0; r < 4; ++r) { const int kk = 16 * w + 4 * g4 + r; dc[r] = hp0[8192 + kk];
#pragma unroll
            for (int vt = 0; vt < 4; ++vt) cs[vt][r] = hp0[kk * 64 + 16 * vt + n16]; }
        for (int i = 0; i < sc; ++i) {
            if (i + 1 < sc) { const float* hp = hp0 + (size_t)(i + 1) * HST_STRIDE;
#pragma unroll
                for (int r = 0; r < 4; ++r) { const int kk = 16 * w + 4 * g4 + r; dn[r] = hp[8192 + kk];
#pragma unroll
                    for (int vt = 0; vt < 4; ++vt) ns[vt][r] = hp[kk * 64 + 16 * vt + n16]; } }
#pragma unroll
            for (int r = 0; r < 4; ++r)
#pragma unroll
                for (int vt = 0; vt < 4; ++vt) S[vt][r] = dc[r] * S[vt][r] + cs[vt][r];
            if (i + 1 < sc) {
#pragma unroll
                for (int r = 0; r < 4; ++r) dc[r] = dn[r];
#pragma unroll
                for (int vt = 0; vt < 4; ++vt) cs[vt] = ns[vt]; }
        }
    }
    const int lcg = (tid & 15) * 8;
    float lb[8];
#pragma unroll
    for (int e = 0; e < 8; ++e) {
        float v = 0.f;
        if (l == 1) { const float l0 = F.in(5)[hh * 128 + lcg + e], l1 = F.in(5)[512 + hh * 128 + lcg + e]; v = 1.f / (1.f + expf(l0 - l1)); }
        lb[e] = v;
    }
    const bf16_t* vf0 = (const bf16_t*)(F.ws + WS_VF_HG) + (size_t)(((b * 4 + hh) * 32 + sc * 4) * 8) * 512 + lane * 8;
    float onv[8];
#pragma unroll
    for (int e = 0; e < 8; ++e) onv[e] = (MODE == 1) ? F.in(6)[l * 64 + (tid & 7) * 8 + e] : 0.f;
    u32x4 fwn[2], qwn[2];
#pragma unroll
    for (int i = 0; i < 2; ++i) { const bf16_t* src = P + (size_t)(tb + ((tid + 512 * i) >> 4)) * NPROJ + hh * 128 + lcg; fwn[i] = *(const u32x4*)(src + C_HF); if (MODE == 1) qwn[i] = *(const u32x4*)(src + C_HQ); }
#pragma unroll 1
    for (int c = 0; c < 4; ++c) {
        const int tok0 = tb + c * 64;
        u32x4 gwp = {0u, 0u, 0u, 0u};
        if (MODE == 1) gwp = *(const u32x4*)(P + (size_t)(tok0 + (tid >> 3)) * NPROJ + C_HG + hh * 64 + (tid & 7) * 8);
        bf16x8 vf[4][2];
#pragma unroll
        for (int vt = 0; vt < 4; ++vt) { vf[vt][0] = ld_frag(vf0 + (size_t)(c * 8 + vt * 2) * 512); vf[vt][1] = ld_frag(vf0 + (size_t)(c * 8 + vt * 2 + 1) * 512); }
#pragma unroll
        for (int i = 0; i < 2; ++i) {
            const int p = tid + 512 * i, row = p >> 4;
            const u32x4 fw = fwn[i];
            const float fx[8] = {bflo(fw.x), bfhi(fw.x), bflo(fw.y), bfhi(fw.y), bflo(fw.z), bfhi(fw.z), bflo(fw.w), bfhi(fw.w)};
            float kv[8], bv[8];
#pragma unroll
            for (int e = 0; e < 8; ++e) { const float f = lb[e] + (1.f - lb[e]) * sigmoidf_(fx[e]); kv[e] = 1.f - f; bv[e] = flog2(fmaxf(f, 1e-12f)); }
            *(LAS f32x4*)(kS + row * HP + lcg) = (f32x4){kv[0], kv[1], kv[2], kv[3]}; *(LAS f32x4*)(kS + row * HP + lcg + 4) = (f32x4){kv[4], kv[5], kv[6], kv[7]};
            *(LAS f32x4*)(bS + row * HP + lcg) = (f32x4){bv[0], bv[1], bv[2], bv[3]}; *(LAS f32x4*)(bS + row * HP + lcg + 4) = (f32x4){bv[4], bv[5], bv[6], bv[7]};
            if (MODE == 1) {
                const u32x4 qw = qwn[i];
                const float qx[8] = {bflo(qw.x), bfhi(qw.x), bflo(qw.y), bfhi(qw.y), bflo(qw.z), bfhi(qw.z), bflo(qw.w), bfhi(qw.w)};
                float qv[8];
#pragma unroll
                for (int e = 0; e < 8; ++e) qv[e] = qx[e] * sigmoidf_(qx[e]);
                *(LAS f32x4*)(qS + row * HP + lcg) = (f32x4){qv[0], qv[1], qv[2], qv[3]}; *(LAS f32x4*)(qS + row * HP + lcg + 4) = (f32x4){qv[4], qv[5], qv[6], qv[7]};
            }
        }
        if (c < 3) {
#pragma unroll
            for (int i = 0; i < 2; ++i) { const bf16_t* src = P + (size_t)(tok0 + 64 + ((tid + 512 * i) >> 4)) * NPROJ + hh * 128 + lcg; fwn[i] = *(const u32x4*)(src + C_HF); if (MODE == 1) qwn[i] = *(const u32x4*)(src + C_HQ); }
        }
        __syncthreads();
        {
            const int part = tid >> 7, k2i = tid & 127;
            float pv[16]; float run = 0.f;
#pragma unroll
            for (int i = 0; i < 16; ++i) { run += bS[(part * 16 + i) * HP + k2i]; pv[i] = run; }
            tot[part * 128 + k2i] = run;
            __syncthreads();
            float pre = 0.f;
#pragma unroll
            for (int pp = 0; pp < 3; ++pp) if (pp < part) pre += tot[pp * 128 + k2i];
#pragma unroll
            for (int i = 0; i < 16; ++i) bS[(part * 16 + i) * HP + k2i] = pv[i] + pre;
        }
        __syncthreads();
        if (MODE == 1) {
            {
                const int t = tid >> 3, j = tid & 7, G = t >> 3, s = 8 * G + j;
                float a = 0.f;
                if (s <= t) {
#pragma unroll 4
                    for (int k4 = 0; k4 < 128; k4 += 4) {
                        const f32x4 q4 = *(const LAS f32x4*)(qS + t * HP + k4), bt = *(const LAS f32x4*)(bS + t * HP + k4), kx = *(const LAS f32x4*)(kS + s * HP + k4), bs = *(const LAS f32x4*)(bS + s * HP + k4);
                        a += q4.x * kx.x * fexp2(bt.x - bs.x) + q4.y * kx.y * fexp2(bt.y - bs.y) + q4.z * kx.z * fexp2(bt.z - bs.z) + q4.w * kx.w * fexp2(bt.w - bs.w);
                    }
                }
                att[t * AP + s] = bf1(a);
                for (int g2 = G + 1; g2 < 8; ++g2) att[t * AP + 8 * g2 + j] = (bf16_t)0;
            }
#pragma unroll
            for (int i = 0; i < 2; ++i) {
                const int p = tid + 512 * i, row = p >> 4, er = (row | 7);
                float kv[8];
#pragma unroll
                for (int e = 0; e < 8; ++e) kv[e] = kS[row * HP + lcg + e] * fexp2(bS[er * HP + lcg + e] - bS[row * HP + lcg + e]);
                *(LAS bf16x8*)(k2 + row * KP + lcg) = pack8(kv);
            }
            __syncthreads();
            for (int pr = w; pr < 16; pr += 8) {
                int I = 0, G = pr; while (G > 2 * I) { G -= 2 * I + 1; ++I; }
                const int t = 16 * I + n16, er = 8 * G + 7, sB = 8 * G + n16;
                f32x4 acc = {0.f, 0.f, 0.f, 0.f};
#pragma unroll
                for (int ks = 0; ks < 4; ++ks) {
                    const int k0 = 32 * ks + 8 * g4;
                    float qv[8];
#pragma unroll
                    for (int hs = 0; hs < 2; ++hs) {
                        const f32x4 q4 = *(const LAS f32x4*)(qS + t * HP + k0 + 4 * hs), bt = *(const LAS f32x4*)(bS + t * HP + k0 + 4 * hs), be = *(const LAS f32x4*)(bS + er * HP + k0 + 4 * hs);
                        qv[4 * hs] = q4.x * fexp2(fminf(bt.x - be.x, 0.f)); qv[4 * hs + 1] = q4.y * fexp2(fminf(bt.y - be.y, 0.f)); qv[4 * hs + 2] = q4.z * fexp2(fminf(bt.z - be.z, 0.f)); qv[4 * hs + 3] = q4.w * fexp2(fminf(bt.w - be.w, 0.f));
                    }
                    const bf16x8 bfr = *(const LAS bf16x8*)(k2 + (sB < 64 ? sB : 63) * KP + k0);
                    acc = mfma16(pack8(qv), bfr, acc);
                }
                if (n16 < 8) {
#pragma unroll
                    for (int r = 0; r < 4; ++r) { const int tt = 16 * I + 4 * g4 + r; if ((tt >> 3) > G) att[tt * AP + 8 * G + n16] = bf1(acc[r]); }
                }
            }
            __syncthreads();
        }
        if (tid < 128) Dv[tid] = fexp2(bS[63 * HP + tid]);
        if (MODE == 1) {
#pragma unroll
            for (int i = 0; i < 2; ++i) {
                const int p = tid + 512 * i, row = p >> 4;
                float qv[8];
#pragma unroll
                for (int e = 0; e < 8; ++e) qv[e] = qS[row * HP + lcg + e] * fexp2(bS[row * HP + lcg + e]);
                *(LAS bf16x8*)(k2 + row * KP + lcg) = pack8(qv);
            }
        }
#pragma unroll
        for (int i = 0; i < 2; ++i) {
            const int p = tid + 512 * i, kk = p & 127, sg = p >> 7;
            const float b63 = bS[63 * HP + kk];
            float kv[8];
#pragma unroll
            for (int e = 0; e < 8; ++e) kv[e] = kS[(8 * sg + e) * HP + kk] * fexp2(b63 - bS[(8 * sg + e) * HP + kk]);
            *(LAS bf16x8*)(kT + kk * TP + 8 * sg) = pack8(kv);
        }
        __syncthreads();
        if (MODE == 1) {
#pragma unroll
            for (int vt = 0; vt < 4; ++vt) { u32x2 pk; pk.x = cvt_pk_bf16(S[vt][0], S[vt][1]); pk.y = cvt_pk_bf16(S[vt][2], S[vt][3]); *(LAS u32x2*)(sT + (16 * vt + n16) * KP + 16 * w + 4 * g4) = pk; }
            __syncthreads();
            if (w < 4) {
                const int t = 16 * w + n16;
                f32x4 o[4];
#pragma unroll
                for (int vt = 0; vt < 4; ++vt) o[vt] = (f32x4){0.f, 0.f, 0.f, 0.f};
#pragma unroll
                for (int ks = 0; ks < 2; ++ks) { const bf16x8 a = *(const LAS bf16x8*)(att + t * AP + 32 * ks + 8 * g4);
#pragma unroll
                    for (int vt = 0; vt < 4; ++vt) o[vt] = mfma16(a, vf[vt][ks], o[vt]); }
#pragma unroll
                for (int ks = 0; ks < 4; ++ks) { const bf16x8 a = *(const LAS bf16x8*)(k2 + t * KP + 32 * ks + 8 * g4);
#pragma unroll
                    for (int vt = 0; vt < 4; ++vt) o[vt] = mfma16(a, *(const LAS bf16x8*)(sT + (16 * vt + n16) * KP + 32 * ks + 8 * g4), o[vt]); }
#pragma unroll
                for (int vt = 0; vt < 4; ++vt)
#pragma unroll
                    for (int r = 0; r < 4; ++r) oS[(16 * w + 4 * g4 + r) * OP + 16 * vt + n16] = o[vt][r];
            }
            __syncthreads();
            {
                const int t = tid >> 3, v0 = (tid & 7) * 8;
                const f32x4 oa = *(const LAS f32x4*)(oS + t * OP + v0), ob = *(const LAS f32x4*)(oS + t * OP + v0 + 4);
                float ss = (oa.x * oa.x + oa.y * oa.y) + (oa.z * oa.z + oa.w * oa.w) + (ob.x * ob.x + ob.y * ob.y) + (ob.z * ob.z + ob.w * ob.w);
                ss += __shfl_xor(ss, 1); ss += __shfl_xor(ss, 2); ss += __shfl_xor(ss, 4);
                const float rstd = 1.f / sqrtf(ss * (1.f / 64.f) + EPS);
                const u32x4 gw = gwp;
                const float gx[8] = {bflo(gw.x), bfhi(gw.x), bflo(gw.y), bfhi(gw.y), bflo(gw.z), bfhi(gw.z), bflo(gw.w), bfhi(gw.w)};
                const float ov[8] = {oa.x, oa.y, oa.z, oa.w, ob.x, ob.y, ob.z, ob.w};
                float y[8];
#pragma unroll
                for (int e = 0; e < 8; ++e) y[e] = ov[e] * rstd * onv[e] * (gx[e] * sigmoidf_(gx[e]));
                u32x4 wv; wv.x = cvt_pk_bf16(y[0], y[1]); wv.y = cvt_pk_bf16(y[2], y[3]); wv.z = cvt_pk_bf16(y[4], y[5]); wv.w = cvt_pk_bf16(y[6], y[7]);
                *(u32x4*)(BR + (size_t)(tok0 + t) * D + 768 + hh * 64 + v0) = wv;
            }
        }
        {
            bf16x8 ka[2];
#pragma unroll
            for (int ks = 0; ks < 2; ++ks) ka[ks] = *(const LAS bf16x8*)(kT + (16 * w + n16) * TP + 32 * ks + 8 * g4);
#pragma unroll
            for (int r = 0; r < 4; ++r) { const float d = Dv[16 * w + 4 * g4 + r]; Dt[r] *= d;
#pragma unroll
                for (int vt = 0; vt < 4; ++vt) S[vt][r] *= d; }
#pragma unroll
            for (int vt = 0; vt < 4; ++vt) { S[vt] = mfma16(ka[0], vf[vt][0], S[vt]); S[vt] = mfma16(ka[1], vf[vt][1], S[vt]); }
        }
        __syncthreads();
    }
    if (MODE == 0) {
        float* hp = HST + (size_t)item * HST_STRIDE;
#pragma unroll
        for (int r = 0; r < 4; ++r) { const int kk = 16 * w + 4 * g4 + r;
#pragma unroll
            for (int vt = 0; vt < 4; ++vt) hp[kk * 64 + 16 * vt + n16] = S[vt][r];
            if (n16 == 0) hp[8192 + kk] = Dt[r]; }
    }
}

#ifndef PHASE_MASK
#define PHASE_MASK 0xfff
#endif
#define PM(i) ((PHASE_MASK >> (i)) & 1)
#if defined(REPEAT_K) && defined(REP_SKIP_SEL)
#define IDX_DO_SEL (rep == 0)
#else
#define IDX_DO_SEL 1
#endif
constexpr int PH_PER_LAYER = 10, N_PHASES = DEPTH * PH_PER_LAYER;
struct Args { const float* in[14]; float* out; unsigned char* ws; int ph_lo, ph_hi; };
static_assert(offsetof(Args, out) == 112 && offsetof(Args, ws) == 120, "Args layout");

__global__ void __launch_bounds__(512, 2) hybrid_fwd(Args args) {
    extern __shared__ __attribute__((aligned(16))) unsigned char lds_raw[];
    cg::grid_group grid = cg::this_grid();
    Ctx F;
    F.lds = (LAS unsigned char*)lds_raw;
    F.wave = __builtin_amdgcn_readfirstlane((int)threadIdx.x >> 6); F.G = gridDim.x; F.bid = blockIdx.x;
    const int gw = F.bid * 8 + F.wave, NGW = F.G * 8;
    for (int i = threadIdx.x; i < LDS_BYTES / 16; i += 512) ((LAS u32x4*)F.lds)[i] = (u32x4){0u, 0u, 0u, 0u};
    __syncthreads();

    for (int ph = args.ph_lo; ph < args.ph_hi; ++ph) {
        const int l = ph / PH_PER_LAYER, k = ph - l * PH_PER_LAYER;
        {
            const CAS unsigned char* ka = (const CAS unsigned char*)__builtin_amdgcn_kernarg_segment_ptr(); asm volatile("" : "+s"(ka));
            F.ka = ka; F.out = *(float* const CAS*)(ka + 112); F.ws = *(unsigned char* const CAS*)(ka + 120);
        }
        unsigned char* ws = F.ws; unsigned char* wt = ws + WS_WT; unsigned char* big = ws + WS_BIG;
        bf16_t* Hb = (bf16_t*)(ws + WS_H); bf16_t* BR = (bf16_t*)(ws + WS_BR);
        const float* xin = (l == 0) ? F.in(0) : F.out;
#ifdef REPEAT_K
        for (int rep = 0; rep < ((k == REPEAT_K) ? REPEAT_N : 1); ++rep) {
        if (rep) grid.sync();
#endif
        if (k == 0 && PM(0)) {
            p0_weights(F, l);
            norm_rows(F, xin, F.in(1) + l * D, Hb);
        } else if (k == 2 && PM(2)) {
#ifdef REPEAT_K
            if (rep == 0)
#endif
            prep_tokens(F, l);
            for (int it = F.bid; it < 256; it += F.G) hgrn_item<0>(F, l, it >> 5, (it >> 3) & 3, it & 7);
        } else if (k == 3 && PM(3)) {
            if (F.wave >= 4) __builtin_amdgcn_s_setprio(1);
#if defined(REPEAT_K) && defined(REP_ONLY_HGRN)
            if (rep == 0)
#endif
            if (PM(10)) index_items(F, IDX_DO_SEL);
#if defined(REPEAT_K) && defined(REP_ONLY_INDEX)
            if (rep == 0)
#endif
            if (PM(11)) for (int it = F.bid; it < 256; it += F.G) hgrn_item<1>(F, l, it >> 5, (it >> 3) & 3, it & 7);
            __builtin_amdgcn_s_setprio(0);
        } else if (k == 4 && PM(4)) {
            if (F.wave < 6) {
                __builtin_amdgcn_s_setprio(1);
                for (int it = F.bid * 6 + F.wave; it < NB * 6 * 32; it += F.G * 6) { const int bh = it % 48, pi = it / 48; bf16x8 qa[4], qb[4]; dsa_loadq(F, bh / 6, bh % 6, 63 - pi, qa); dsa_loadq(F, bh / 6, bh % 6, pi, qb); dsa_item(F, bh / 6, bh % 6, 63 - pi, qa); dsa_item(F, bh / 6, bh % 6, pi, qb); }
                __builtin_amdgcn_s_setprio(0);
            } else {
                if ((F.G & 7) == 0 && F.G * 12 == NB * 6 * 64) {
                    for (int j = F.wave - 6; j < 12; j += 2) { const int g = (F.bid >> 3) * 12 + j; sb_item(F, F.bid & 7, g % 6, g / 6); }
                } else {
                    for (int it = F.bid * 2 + (F.wave - 6); it < NB * 6 * 64; it += F.G * 2) { const int bh = it % 48, qt = it / 48; sb_item(F, bh / 6, bh % 6, qt); }
                }
            }
        } else if (k == 7 && PM(7)) {
            norm_rows(F, F.out, F.in(11) + l * D, Hb);
        } else if ((k == 1 || k == 5 || k == 6 || k >= 8) && PM(1)) {
            bf16_t* Gt = (bf16_t*)(big + BIG_GT); bf16_t* Mx = (bf16_t*)(big + BIG_MIX);
            const int nsub = (k == 5) ? 2 : 1;
#pragma unroll 1
            for (int sub = 0; sub < nsub; ++sub) {
                pg8::Gemm g; pg8::EpiAll E; E.KVB = ws; E.G16 = Gt; E.Xi = xin; E.Xo = F.out; E.O16 = (bf16_t*)big; E.ldo = D;
                g.M = M; g.N = D; g.K = D; g.lda = D; g.A = Hb; g.a_grp_off = 0; g.align = 1; int reps = 1;
                if (k == 1) { g.Bt = (const bf16_t*)(wt + WT_IN); g.N = NGEMM; E.mode = pg8::EM_PROJ; E.ldo = NPROJ; }
                else if (k == 5) {
                    g.N = 3072; reps = 3;
                    if (sub == 0) { g.Bt = (const bf16_t*)(wt + WT_G); E.mode = pg8::EM_GATE; E.O16 = Gt; E.ldo = 3072; }
                    else { g.A = BR; g.a_grp_off = 384; g.K = 384; g.Bt = (const bf16_t*)(wt + WT_BR); E.mode = pg8::EM_MIXB; E.O16 = Mx; }
                }
                else if (k == 6) { g.A = Mx; g.Bt = (const bf16_t*)(wt + WT_OUT); E.mode = pg8::EM_RES; }
                else if (k == 8) { g.Bt = (const bf16_t*)(wt + WT_UP); g.N = FF; E.mode = pg8::EM_UP; E.ldo = FF; }
                else { g.A = (const bf16_t*)big; g.K = FF; g.lda = FF; g.Bt = (const bf16_t*)(wt + WT_DOWN); E.mode = pg8::EM_RES; E.Xi = F.out; }
                pg8::StaticOrder S; S.init(M, g.N, F.G, F.bid, reps);
                pg8::gemm_phase(F.lds, g, S, E);
            }
        }
#ifdef REPEAT_K
        }
#endif
        if (ph + 1 < args.ph_hi) grid.sync();
    }
}

extern "C" void kernel_launch(void* const* d_in, const int* in_sizes, int n_in, void* d_out, int out_size, void* d_ws, size_t ws_size, hipStream_t stream) {
    static int grid = 0;
    if (grid == 0) {
        if (n_in != 14 || out_size != M * D || ws_size < WS_END) { fprintf(stderr, "kernel_launch: unexpected shapes (n_in %d out %d ws %zu)\n", n_in, out_size, ws_size); grid = -1; return; }
        int dev = 0, cus = 0, per_cu = 0;
        hipGetDevice(&dev); hipDeviceGetAttribute(&cus, hipDeviceAttributeMultiprocessorCount, dev);
        hipFuncSetAttribute((const void*)hybrid_fwd, hipFuncAttributeMaxDynamicSharedMemorySize, LDS_BYTES);
        hipOccupancyMaxActiveBlocksPerMultiprocessor(&per_cu, (const void*)hybrid_fwd, 512, LDS_BYTES);
        (void)hipGetLastError();
        if (per_cu < 1) { fprintf(stderr, "kernel_launch: occupancy query says %d blocks/CU\n", per_cu); per_cu = 1; }
        grid = cus * 1;
        fprintf(stderr, "kernel_launch: grid %d (cus %d, per_cu %d)\n", grid, cus, per_cu);
    }
    if (grid < 0) return;
#ifdef DIAG_MEMSET
    hipMemsetAsync((char*)d_ws + WS_KF_SB, 0, 30 * MiB, stream);
#endif
    Args a{};
    for (int i = 0; i < 14; ++i) a.in[i] = (const float*)d_in[i];
    a.out = (float*)d_out; a.ws = (unsigned char*)d_ws;
#if ONE_LAUNCH
    a.ph_lo = 0; a.ph_hi = N_PHASES;
    void* kargs[] = {&a};
    hipError_t e = hipLaunchCooperativeKernel((const void*)hybrid_fwd, dim3(grid), dim3(512), kargs, LDS_BYTES, stream);
    if (e != hipSuccess) fprintf(stderr, "cooperative launch failed: %s (grid %d)\n", hipGetErrorString(e), grid);
#else
    for (int ph = 0; ph < N_PHASES; ++ph) { a.ph_lo = ph; a.ph_hi = ph + 1; hipLaunchKernelGGL(hybrid_fwd, dim3(grid), dim3(512), LDS_BYTES, stream, a); }
#endif
}
```

```cpp
#include <hip/hip_runtime.h>
#include <hip/hip_cooperative_groups.h>
#include <cstdio>
#include <cstdint>
namespace cg = cooperative_groups;

#ifndef ONE_LAUNCH
#define ONE_LAUNCH 1
#endif

#define LAS __attribute__((address_space(3)))
typedef unsigned short bf16_t;
typedef short bf16x8 __attribute__((ext_vector_type(8)));
typedef short bf16x4 __attribute__((ext_vector_type(4)));
typedef float f32x4 __attribute__((ext_vector_type(4)));
typedef float f32x16 __attribute__((ext_vector_type(16)));
typedef unsigned u32x4 __attribute__((ext_vector_type(4)));
typedef unsigned u32x2 __attribute__((ext_vector_type(2)));

constexpr int D = 1024, NB = 8, T = 2048, DEPTH = 2, M = NB * T, FF = 4096;
constexpr int D_IN = 6856;
constexpr int NGEMM = 3840;
constexpr int G_SV = 0, G_DV = 384, G_SK = 448, NKV = 832, NPROJ = NGEMM - NKV;
constexpr int C_SQ = 0, C_DQ = 384, C_DK = 768, C_IQ = 832, C_IK = 1344, C_HQ = 1408, C_HF = 1920, C_HI = 2432, C_HG = 2688, C_IW = 2944;
constexpr float EPS = 1e-6f;
constexpr float LOG2E = 1.4426950408889634f;

constexpr size_t MiB = 1u << 20;
constexpr size_t WS_WT = 1 * MiB;
constexpr size_t WT_IN = 0, WT_G = WT_IN + (size_t)NGEMM * D * 2, WT_BR = WT_G + (size_t)3072 * D * 2  ,
                 WT_OUT = WT_BR + (size_t)3072 * 384 * 2, WT_UP = WT_OUT + (size_t)D * D * 2, WT_DOWN = WT_UP + (size_t)FF * D * 2,
                 WT_END = WT_DOWN + (size_t)D * FF * 2;
static_assert(WT_END <= 34 * MiB, "weights");
constexpr size_t WS_H = 35 * MiB;
constexpr size_t WS_BR = 67 * MiB;
constexpr size_t WS_BIG = 99 * MiB;
constexpr size_t BIG_GT = 0  , BIG_MIX = 96 * MiB;
constexpr size_t WS_KF_SB = WS_BIG + 96 * MiB, WS_VF_SB = WS_KF_SB + 12 * MiB, WS_KF_DSA = WS_VF_SB + 12 * MiB, WS_VF_DSA = WS_KF_DSA + 2 * MiB, WS_KF_IDX = WS_VF_DSA + 2 * MiB;
static_assert((size_t)M * NPROJ * 2 <= 96 * MiB && WS_KF_IDX + 2 * MiB <= WS_BIG + 128 * MiB, "big");
constexpr size_t WS_MASK = 227 * MiB;
constexpr size_t WS_HST = 231 * MiB;
constexpr size_t HST_STRIDE = 128 * 64 + 128;
constexpr size_t WS_VF_HG = 240 * MiB;
constexpr size_t WS_END = 248 * MiB;
static_assert(WS_HST + 256 * HST_STRIDE * 4 <= WS_END, "ws");

constexpr int LDS_BYTES = 147456;

__device__ __forceinline__ unsigned cvt_pk_bf16(float lo, float hi) { unsigned r; asm volatile("v_cvt_pk_bf16_f32 %0, %1, %2" : "=v"(r) : "v"(lo), "v"(hi)); return r; }
__device__ __forceinline__ float bf2f(unsigned short b) { return __builtin_bit_cast(float, (unsigned)b << 16); }
__device__ __forceinline__ float bflo(unsigned u) { return __builtin_bit_cast(float, u << 16); }
__device__ __forceinline__ float bfhi(unsigned u) { return __builtin_bit_cast(float, u & 0xffff0000u); }
__device__ __forceinline__ float fexp2(float x) { return __builtin_amdgcn_exp2f(x); }
__device__ __forceinline__ float fexp(float x) { return __builtin_amdgcn_exp2f(x * LOG2E); }
__device__ __forceinline__ float flog2(float x) { return __builtin_amdgcn_logf(x); }
__device__ __forceinline__ float frcp(float x) { return __builtin_amdgcn_rcpf(x); }
__device__ __forceinline__ float sigmoidf_(float x) { return frcp(1.f + fexp(-x)); }
__device__ __forceinline__ float wave_sum(float v) {
#pragma unroll
    for (int o = 1; o < 64; o <<= 1) v += __shfl_xor(v, o);
    return v;
}

namespace pg8 {
constexpr int BM = 256, BK = 64, HALF = 128, HTB = HALF * BK * 2, NXCD = 8, WGM = 8;
__host__ __device__ __forceinline__ int lds_byte(int r, int c) { const int st = (r >> 4) * 2 + (c >> 5), rr = r & 15, cc = c & 31, ob = rr * 64 + cc * 2; return st * 1024 + (ob ^ (((ob >> 9) & 1) << 5)); }
__host__ __device__ __forceinline__ void stage_rc(int b, int& R, int& C) { const int st = b / 1024, sb = b % 1024, swz = sb ^ (((sb >> 9) & 1) << 5); R = (st >> 1) * 16 + swz / 64; C = (st & 1) * 32 + (swz % 64) / 2; }
__host__ __device__ __forceinline__ int perm32(int rho) { const int n = rho >> 4, i = rho & 15; return 8 * (i >> 2) + 4 * n + (i & 3); }
struct Unit { int pm, pn; };
struct Gemm { const bf16_t* A; const bf16_t* Bt; int M, N, K, lda, a_grp_off, align; };
struct StaticOrder {
    int nM, nN, nwg, G, c, reps;
    __device__ void init(int M_, int N_, int G_, int c_, int reps_ = 1) { reps = reps_; nM = M_ / BM; nN = N_ / (BM * reps_); nwg = nM * nN; G = G_; c = c_; }
    __device__ bool next(int i, Unit& u) const {
        const int ib = i / reps, br = i - ib * reps;
        const long L = (long)ib * G + c; if (L >= nwg) return false;
        int wgid = (int)L; { const int q = nwg / NXCD, r = nwg % NXCD, xcd = wgid % NXCD, off = wgid / NXCD; wgid = (xcd < r ? xcd * (q + 1) : r * (q + 1) + (xcd - r) * q) + off; }
        const int nig = WGM * nN, gid = wgid / nig, fm = gid * WGM, gsz = (nM - fm) < WGM ? (nM - fm) : WGM;
        u.pm = fm + ((wgid % nig) % gsz); u.pn = br * nN + (wgid % nig) / gsz; return true;
    }
};
template <class Epi>
__device__ __forceinline__ void gemm_phase(LAS unsigned char* lds, const Gemm g, const StaticOrder& S, const Epi& E) {
    int tid_ = threadIdx.x; asm volatile("" : "+v"(tid_));
    const int tid = tid_, wid = __builtin_amdgcn_readfirstlane(tid >> 6), lane = tid & 63, wr = wid >> 2, wc = wid & 3, fr = lane & 15, fq = lane >> 4;
    const int K = g.K, nt = K / BK, lda = g.lda;
    unsigned voffA[2], voffB[2];
#pragma unroll
    for (int i = 0; i < 2; ++i) { int R, C; stage_rc(tid * 16 + i * 8192, R, C); const int Rb = (R & ~31) + perm32(R & 31);
        voffA[i] = (unsigned)(R * lda + C) * 2u; voffB[i] = (unsigned)(Rb * K + C) * 2u; }
    const size_t kstep = (size_t)(BK * 2);
    const size_t hstepA = (size_t)HALF * lda * 2, tstepA = 2 * hstepA;
    const size_t hstepB = (size_t)HALF * K * 2, tstepB = 2 * hstepB;
    const unsigned ldsw = (unsigned)wid * 1024u;
    const int aoff = lds_byte(wr * 64 + fr, fq * 8), boff = lds_byte(wc * 32 + fr, fq * 8);
#define PG8_SA(b, h) (((b) * 2 + (h)) * HTB)
#define PG8_SB(b, h) ((4 + (b) * 2 + (h)) * HTB)
#define PG8_STAGE(bufoff, gbase, voff) do { _Pragma("unroll") for (int _i = 0; _i < 2; ++_i) \
        __builtin_amdgcn_global_load_lds((const unsigned*)((const char*)(gbase) + (voff)[_i]), (LAS unsigned*)(lds + (bufoff) + ldsw + _i * 8192), 16, 0, 0); } while (0)
#define PG8_LDA(dst, b, h) do { _Pragma("unroll") for (int m = 0; m < 4; ++m) _Pragma("unroll") for (int k = 0; k < 2; ++k) dst[m][k] = *(const LAS bf16x8*)(lds + PG8_SA(b, h) + aoff + m * 2048 + k * 1024); } while (0)
#define PG8_LDB(dst, b, h) do { _Pragma("unroll") for (int n = 0; n < 2; ++n) _Pragma("unroll") for (int k = 0; k < 2; ++k) dst[n][k] = *(const LAS bf16x8*)(lds + PG8_SB(b, h) + boff + n * 2048 + k * 1024); } while (0)
#define PG8_MMA(ai, bj, At, Bt) do { __builtin_amdgcn_s_setprio(1); _Pragma("unroll") for (int m = 0; m < 4; ++m) _Pragma("unroll") for (int n = 0; n < 2; ++n) _Pragma("unroll") for (int k = 0; k < 2; ++k) \
        acc[ai][bj][m][n] = __builtin_amdgcn_mfma_f32_16x16x32_bf16(Bt[n][k], At[m][k], acc[ai][bj][m][n], 0, 0, 0); __builtin_amdgcn_s_setprio(0); } while (0)
#define PG8_WAIT_V(n) asm volatile("s_waitcnt vmcnt(" #n ")" ::: "memory")
#define PG8_WAIT_L(n) asm volatile("s_waitcnt lgkmcnt(" #n ")" ::: "memory")
#define PG8_BAR __builtin_amdgcn_s_barrier()
#define PG8_SCHED __builtin_amdgcn_sched_barrier(0)
    Unit cur, nxt; int ui = 0;
    if (!S.next(0, cur)) return;
    f32x4 acc[2][2][4][2];
#pragma unroll
    for (int a = 0; a < 2; ++a)
#pragma unroll
        for (int b = 0; b < 2; ++b)
#pragma unroll
            for (int m = 0; m < 4; ++m)
#pragma unroll
                for (int n = 0; n < 2; ++n) acc[a][b][m][n] = (f32x4){0.f, 0.f, 0.f, 0.f};
    bf16x8 At[4][2], B0[2][2], B1[2][2];
    const size_t agrp = (size_t)g.a_grp_off * 2;
    const char* cA = (const char*)g.A + (size_t)cur.pm * tstepA + (size_t)(cur.pn >> 2) * agrp; const char* cB = (const char*)g.Bt + (size_t)cur.pn * tstepB;
    PG8_STAGE(PG8_SB(0, 0), cB, voffB); PG8_STAGE(PG8_SB(0, 1), cB + hstepB, voffB); PG8_STAGE(PG8_SA(0, 0), cA, voffA); PG8_STAGE(PG8_SA(0, 1), cA + hstepA, voffA);
    if (wr == 1) PG8_BAR;
    PG8_WAIT_V(2); PG8_BAR;
    PG8_STAGE(PG8_SB(1, 0), cB + kstep, voffB); PG8_STAGE(PG8_SA(1, 0), cA + kstep, voffA); PG8_STAGE(PG8_SB(1, 1), cB + hstepB + kstep, voffB);
    PG8_WAIT_V(6); PG8_BAR;
    for (;;) {
        const bool has_next = S.next(ui + 1, nxt);
        const char* nA = has_next ? (const char*)g.A + (size_t)nxt.pm * tstepA + (size_t)(nxt.pn >> 2) * agrp : cA; const char* nB = has_next ? (const char*)g.Bt + (size_t)nxt.pn * tstepB : cB;
        for (int t = 0; t < nt; t += 2) {
            const bool last = (t == nt - 2);
            const char* a1 = cA + (size_t)(t + 1) * kstep;
            const char* a2 = last ? nA : cA + (size_t)(t + 2) * kstep; const char* b2 = last ? nB : cB + (size_t)(t + 2) * kstep;
            const char* a3 = a2 + kstep; const char* b3 = b2 + kstep;
            PG8_LDB(B0, 0, 0); PG8_LDB(B1, 0, 1); PG8_SCHED; PG8_LDA(At, 0, 0); PG8_STAGE(PG8_SA(1, 1), a1 + hstepA, voffA);
            PG8_WAIT_V(8); PG8_WAIT_L(0); PG8_BAR; PG8_MMA(0, 0, At, B0); PG8_MMA(0, 1, At, B1); PG8_BAR; PG8_SCHED;
            PG8_LDA(At, 0, 1); PG8_STAGE(PG8_SB(0, 0), b2, voffB); PG8_STAGE(PG8_SB(0, 1), b2 + hstepB, voffB); PG8_STAGE(PG8_SA(0, 0), a2, voffA);
            PG8_WAIT_V(8); PG8_WAIT_L(0); PG8_BAR; PG8_MMA(1, 0, At, B0); PG8_MMA(1, 1, At, B1); PG8_BAR; PG8_SCHED;
            PG8_LDB(B0, 1, 0); PG8_LDB(B1, 1, 1); PG8_SCHED; PG8_LDA(At, 1, 0); PG8_STAGE(PG8_SA(0, 1), a2 + hstepA, voffA);
            PG8_WAIT_V(8); PG8_WAIT_L(0); PG8_BAR; PG8_MMA(0, 0, At, B0); PG8_MMA(0, 1, At, B1); PG8_BAR; PG8_SCHED;
            PG8_LDA(At, 1, 1); PG8_STAGE(PG8_SB(1, 0), b3, voffB); PG8_STAGE(PG8_SB(1, 1), b3 + hstepB, voffB); PG8_STAGE(PG8_SA(1, 0), a3, voffA);
            PG8_WAIT_V(8); PG8_WAIT_L(0); PG8_BAR; PG8_MMA(1, 0, At, B0); PG8_MMA(1, 1, At, B1); PG8_BAR; PG8_SCHED;
        }
        if (g.align) { if (wr == 0) PG8_BAR; }
        E(acc, cur, wr, wc, fr, fq);
        if (!has_next) break;
#pragma unroll
        for (int a = 0; a < 2; ++a)
#pragma unroll
            for (int b = 0; b < 2; ++b)
#pragma unroll
                for (int m = 0; m < 4; ++m)
#pragma unroll
                    for (int n = 0; n < 2; ++n) acc[a][b][m][n] = (f32x4){0.f, 0.f, 0.f, 0.f};
        cur = nxt; cA = nA; cB = nB; ++ui;
        if (g.align) { if (wr == 1) PG8_BAR; }
    }
    PG8_WAIT_V(0);
    if (!g.align) { if (wr == 0) PG8_BAR; }
    PG8_BAR;
#undef PG8_SA
#undef PG8_SB
#undef PG8_STAGE
#undef PG8_LDA
#undef PG8_LDB
#undef PG8_MMA
#undef PG8_WAIT_V
#undef PG8_WAIT_L
#undef PG8_BAR
#undef PG8_SCHED
}

#define EPI_LOOP_BEGIN \
    _Pragma("unroll") for (int ai = 0; ai < 2; ++ai) _Pragma("unroll") for (int m = 0; m < 4; ++m) { const int row = u.pm * BM + ai * HALF + wr * 64 + m * 16 + fr; \
    _Pragma("unroll") for (int bj = 0; bj < 2; ++bj) { const int col = u.pn * BM + bj * HALF + wc * 32 + 8 * fq; const f32x4 v0 = acc[ai][bj][m][0], v1 = acc[ai][bj][m][1];
#define EPI_LOOP_END } }

enum { EM_PROJ = 0, EM_GATE = 1, EM_MIXB = 2, EM_RES = 5, EM_UP = 6 };
struct EpiAll {
    int mode; bf16_t* O16; int ldo; unsigned char* KVB  ; const bf16_t* G16; const float* Xi; float* Xo;
    __device__ __forceinline__ void operator()(const f32x4 (&acc)[2][2][4][2], const Unit& u, int wr, int wc, int fr, int fq) const {
        asm volatile("" : "+v"(fr), "+v"(fq));
        EPI_LOOP_BEGIN
            if (mode == EM_PROJ) {
                u32x4 w; w.x = cvt_pk_bf16(v0[0], v0[1]); w.y = cvt_pk_bf16(v0[2], v0[3]); w.z = cvt_pk_bf16(v1[0], v1[1]); w.w = cvt_pk_bf16(v1[2], v1[3]);
                const int bb = row >> 11, tt = row & (T - 1), kt = tt >> 5, r = tt & 31;
                if (col < G_SK) {
                    const int isd = col >= G_DV, cc = isd ? col - G_DV : col, hh = cc >> 6, d0 = cc & 63, db = d0 >> 5;
                    const int s2 = r >> 4, k16 = r & 15, jj = 4 * (k16 >> 3) + (k16 & 3), h = (k16 >> 2) & 1;
                    const size_t blk = isd ? (size_t)(((bb * 64 + kt) * 2 + db) * 2 + s2) : (size_t)((((bb * 6 + hh) * 64 + kt) * 2 + db) * 2 + s2);
                    bf16_t* vp = (bf16_t*)(KVB + (isd ? WS_VF_DSA : WS_VF_SB)) + blk * 512 + ((d0 & 31) + 32 * h) * 8 + jj;
                    vp[0] = (bf16_t)(w.x & 0xffff); vp[8] = (bf16_t)(w.x >> 16); vp[16] = (bf16_t)(w.y & 0xffff); vp[24] = (bf16_t)(w.y >> 16);
                    vp[32] = (bf16_t)(w.z & 0xffff); vp[40] = (bf16_t)(w.z >> 16); vp[48] = (bf16_t)(w.w & 0xffff); vp[56] = (bf16_t)(w.w >> 16);
                } else if (col < NKV) {
                    const int cc = col - G_SK, hh = cc >> 6, d0 = cc & 63, s = d0 >> 4, h = (d0 >> 3) & 1;
                    *(u32x4*)((bf16_t*)(KVB + WS_KF_SB) + (size_t)((((bb * 6 + hh) * 64 + kt) * 4 + s)) * 512 + (r + 32 * h) * 8) = w;
                } else if (col >= NKV + C_HI && col < NKV + C_HI + 256) {
                    const int cc = col - (NKV + C_HI), hh = cc >> 6, v0 = cc & 63, s = tt & 63;
                    bf16_t* vp = (bf16_t*)(KVB + WS_VF_HG) + ((size_t)(((((bb * 4 + hh) * 32 + (tt >> 6)) * 4 + (v0 >> 4)) * 2 + (s >> 5))) * 64 + (v0 & 15) + 16 * ((s >> 3) & 3)) * 8 + (s & 7);
                    vp[0] = (bf16_t)(w.x & 0xffff); vp[8] = (bf16_t)(w.x >> 16); vp[16] = (bf16_t)(w.y & 0xffff); vp[24] = (bf16_t)(w.y >> 16);
                    vp[32] = (bf16_t)(w.z & 0xffff); vp[40] = (bf16_t)(w.z >> 16); vp[48] = (bf16_t)(w.w & 0xffff); vp[56] = (bf16_t)(w.w >> 16);
                } else {
                    *(u32x4*)(O16 + (size_t)row * ldo + col - NKV) = w;
                }
            } else if (mode == EM_GATE) {
                u32x4 w; w.x = cvt_pk_bf16(sigmoidf_(v0[0]), sigmoidf_(v0[1])); w.y = cvt_pk_bf16(sigmoidf_(v0[2]), sigmoidf_(v0[3]));
                w.z = cvt_pk_bf16(sigmoidf_(v1[0]), sigmoidf_(v1[1])); w.w = cvt_pk_bf16(sigmoidf_(v1[2]), sigmoidf_(v1[3]));
                *(u32x4*)(O16 + (size_t)row * ldo + col) = w;
            } else if (mode == EM_MIXB) {
                const u32x4 gw = *(const u32x4*)(G16 + (size_t)row * 3072 + col);
                f32x4 r0 = {bflo(gw.x) * v0[0], bfhi(gw.x) * v0[1], bflo(gw.y) * v0[2], bfhi(gw.y) * v0[3]};
                f32x4 r1 = {bflo(gw.z) * v1[0], bfhi(gw.z) * v1[1], bflo(gw.w) * v1[2], bfhi(gw.w) * v1[3]};
                bf16_t* mp = O16 + (size_t)row * D + (col & 1023);
                if (col >= 1024) { const u32x4 pw = *(const u32x4*)mp;
                    r0 += (f32x4){bflo(pw.x), bfhi(pw.x), bflo(pw.y), bfhi(pw.y)}; r1 += (f32x4){bflo(pw.z), bfhi(pw.z), bflo(pw.w), bfhi(pw.w)}; }
                u32x4 w; w.x = cvt_pk_bf16(r0[0], r0[1]); w.y = cvt_pk_bf16(r0[2], r0[3]); w.z = cvt_pk_bf16(r1[0], r1[1]); w.w = cvt_pk_bf16(r1[2], r1[3]);
                *(u32x4*)mp = w;
            } else if (mode == EM_RES) {
                const float* xp = Xi + (size_t)row * D + col; float* op = Xo + (size_t)row * D + col;
                const f32x4 x0 = *(const f32x4*)xp, x1 = *(const f32x4*)(xp + 4);
                *(f32x4*)op = x0 + v0; *(f32x4*)(op + 4) = x1 + v1;
            } else {
                f32x4 a = __builtin_elementwise_max(v0, (f32x4){0.f, 0.f, 0.f, 0.f}), b = __builtin_elementwise_max(v1, (f32x4){0.f, 0.f, 0.f, 0.f}); a = a * a; b = b * b;
                u32x4 w; w.x = cvt_pk_bf16(a[0], a[1]); w.y = cvt_pk_bf16(a[2], a[3]); w.z = cvt_pk_bf16(b[0], b[1]); w.w = cvt_pk_bf16(b[2], b[3]);
                *(u32x4*)(O16 + (size_t)row * ldo + col) = w;
            }
        EPI_LOOP_END
    }
};
}

#define CAS __attribute__((address_space(4)))
struct Ctx {
    LAS unsigned char* lds; int wave, G, bid;
    const CAS unsigned char* ka; float* out; unsigned char* ws;
    __device__ __forceinline__ const float* in(int i) const { return *(const float* const CAS*)(ka + 8 * i); }
};
#define LDS_WAIT() asm volatile("s_waitcnt lgkmcnt(0)" ::: "memory")

struct TrDesc { const float* src; bf16_t* dst; int ldw, ldt; };
__device__ __forceinline__ void tr_load(const TrDesc& d, float (&tv)[32], int lane) {
    const float* wp = d.src + (size_t)(lane >> 5) * d.ldw + (lane & 31);
#pragma unroll
    for (int i = 0; i < 32; ++i) tv[i] = __builtin_nontemporal_load(wp + (size_t)(2 * i) * d.ldw);
}
__device__ __forceinline__ void tr_store(const TrDesc& d, const float (&tv)[32], LAS float* scr, int lane) {
#pragma unroll
    for (int i = 0; i < 32; ++i) scr[(2 * i + (lane >> 5)) * 33 + (lane & 31)] = tv[i];
    LDS_WAIT(); asm volatile("" ::: "memory");
    const int c = lane & 7;
#pragma unroll
    for (int j = 0; j < 4; ++j) { const int n = (lane >> 3) + 8 * j; const LAS float* sp = scr + (8 * c) * 33 + n;
        u32x4 o; o.x = cvt_pk_bf16(sp[0 * 33], sp[1 * 33]); o.y = cvt_pk_bf16(sp[2 * 33], sp[3 * 33]); o.z = cvt_pk_bf16(sp[4 * 33], sp[5 * 33]); o.w = cvt_pk_bf16(sp[6 * 33], sp[7 * 33]);
        *(u32x4*)(d.dst + (size_t)n * d.ldt + 8 * c) = o; }
    LDS_WAIT(); asm volatile("" ::: "memory");
}
__device__ __forceinline__ void rms_row_to_bf16(const float* xrow, const float* gain, bf16_t* orow, int lane) {
    asm volatile("" : "+v"(lane));
    const f32x4* xr = (const f32x4*)xrow + lane; const f32x4* gr = (const f32x4*)gain + lane;
    f32x4 v[4]; float s = 0.f;
#pragma unroll
    for (int j = 0; j < 4; ++j) { v[j] = xr[64 * j]; s += (v[j].x * v[j].x + v[j].y * v[j].y) + (v[j].z * v[j].z + v[j].w * v[j].w); }
    const float rstd = 1.f / sqrtf(wave_sum(s) * (1.f / D) + EPS);
    u32x2* o8 = (u32x2*)orow + lane;
#pragma unroll
    for (int j = 0; j < 4; ++j) { const f32x4 g = gr[64 * j]; u32x2 w; w.x = cvt_pk_bf16(v[j].x * rstd * g.x, v[j].y * rstd * g.y); w.y = cvt_pk_bf16(v[j].z * rstd * g.z, v[j].w * rstd * g.w); o8[64 * j] = w; }
}
__device__ __forceinline__ void norm_rows(const Ctx& F, const float* X, const float* gain, bf16_t* O) {
    const int gw = F.bid * 8 + F.wave, NGW = F.G * 8;
    int lane = (int)threadIdx.x & 63; asm volatile("" : "+v"(lane));
    const f32x4* gr = (const f32x4*)gain + lane;
    for (int m = gw; m < M; m += 2 * NGW) {
        const int m2 = m + NGW; const bool two = m2 < M;
        const f32x4* xa = (const f32x4*)(X + (size_t)m * D) + lane; const f32x4* xb = (const f32x4*)(X + (size_t)(two ? m2 : m) * D) + lane;
        f32x4 va[4], vb[4]; float sa = 0.f, sb = 0.f;
#pragma unroll
        for (int j = 0; j < 4; ++j) { va[j] = xa[64 * j]; vb[j] = xb[64 * j]; }
#pragma unroll
        for (int j = 0; j < 4; ++j) { sa += (va[j].x * va[j].x + va[j].y * va[j].y) + (va[j].z * va[j].z + va[j].w * va[j].w); sb += (vb[j].x * vb[j].x + vb[j].y * vb[j].y) + (vb[j].z * vb[j].z + vb[j].w * vb[j].w); }
#pragma unroll
        for (int o = 1; o < 64; o <<= 1) { sa += __shfl_xor(sa, o); sb += __shfl_xor(sb, o); }
        const float ra = 1.f / sqrtf(sa * (1.f / D) + EPS), rb = 1.f / sqrtf(sb * (1.f / D) + EPS);
        u32x2* oa = (u32x2*)(O + (size_t)m * D) + lane; u32x2* ob = (u32x2*)(O + (size_t)m2 * D) + lane;
#pragma unroll
        for (int j = 0; j < 4; ++j) { const f32x4 g = gr[64 * j];
            u32x2 w; w.x = cvt_pk_bf16(va[j].x * ra * g.x, va[j].y * ra * g.y); w.y = cvt_pk_bf16(va[j].z * ra * g.z, va[j].w * ra * g.w); oa[64 * j] = w;
            if (two) { u32x2 w2; w2.x = cvt_pk_bf16(vb[j].x * rb * g.x, vb[j].y * rb * g.y); w2.y = cvt_pk_bf16(vb[j].z * rb * g.z, vb[j].w * rb * g.w); ob[64 * j] = w2; } }
    }
}
__device__ __forceinline__ void p0_weights(const Ctx& F, int l) {
    LAS float* scr = (LAS float*)(F.lds + F.wave * 16384);
    int tid0 = threadIdx.x; asm volatile("" : "+v"(tid0));
    const int gw = F.bid * 8 + F.wave, NGW = F.G * 8;
    unsigned char* wt = F.ws + WS_WT;
    bf16_t* Wt_in = (bf16_t*)(wt + WT_IN); bf16_t* Wt_g = (bf16_t*)(wt + WT_G); bf16_t* Wt_br = (bf16_t*)(wt + WT_BR);
    bf16_t* Wt_out = (bf16_t*)(wt + WT_OUT); bf16_t* Wt_up = (bf16_t*)(wt + WT_UP); bf16_t* Wt_down = (bf16_t*)(wt + WT_DOWN);
    const float* w_in = F.in(2) + (size_t)l * D * D_IN;
    const float* w_sb = F.in(7) + (size_t)l * 384 * D; const float* w_dsa = F.in(8) + (size_t)l * 384 * D; const float* w_hg = F.in(9) + (size_t)l * 256 * D;
    const float* w_out = F.in(10) + (size_t)l * D * D; const float* w_up = F.in(12) + (size_t)l * D * FF; const float* w_down = F.in(13) + (size_t)l * FF * D;
    constexpr int NI_IN = 16 * (3776 / 32 + 3072 / 32);
    constexpr int NI_TOT = NI_IN + 2 * (6 * 32) + 4 * 32 + 16 * 32 + 16 * 128 + 64 * 32;
#define SEGP(W_, ldw_, c0_, nc_, K_, P_, WT_, r0_) { constexpr int nbk = (nc_) / 32, ni = ((K_) / 64) * nbk; if (r < ni) { const int kb = r / nbk, nb = r - kb * nbk; \
        d.src = (W_) + (size_t)(64 * kb) * (ldw_) + (c0_) + 32 * nb; d.dst = (WT_) + (size_t)((r0_) + 32 * nb) * (P_) + 64 * kb; d.ldw = (ldw_); d.ldt = (P_); break; } r -= ni; }
#define SEG(W_, ldw_, c0_, nc_, K_, WT_, r0_) SEGP(W_, ldw_, c0_, nc_, K_, K_, WT_, r0_)
#define DECODE(it_, d) do { int r = (it_); \
        SEG(w_in, D_IN, 768, 384, 1024, Wt_in, G_SV) SEG(w_in, D_IN, 1600, 64, 1024, Wt_in, G_DV) SEG(w_in, D_IN, 0, 384, 1024, Wt_in, NKV + C_SQ) SEG(w_in, D_IN, 384, 384, 1024, Wt_in, G_SK) \
        SEG(w_in, D_IN, 1152, 384, 1024, Wt_in, NKV + C_DQ) SEG(w_in, D_IN, 1536, 64, 1024, Wt_in, NKV + C_DK) SEG(w_in, D_IN, 1664, 512, 1024, Wt_in, NKV + C_IQ) SEG(w_in, D_IN, 2176, 64, 1024, Wt_in, NKV + C_IK) \
        SEG(w_in, D_IN, 2248, 512, 1024, Wt_in, NKV + C_HQ) SEG(w_in, D_IN, 2760, 512, 1024, Wt_in, NKV + C_HF) SEG(w_in, D_IN, 3272, 256, 1024, Wt_in, NKV + C_HI) SEG(w_in, D_IN, 3528, 256, 1024, Wt_in, NKV + C_HG) \
        SEG(w_in, D_IN, 3784, 3072, 1024, Wt_g, 0) SEG(w_sb, D, 0, 1024, 384, Wt_br, 0) SEG(w_dsa, D, 0, 1024, 384, Wt_br, 1024) SEGP(w_hg, D, 0, 1024, 256, 384, Wt_br, 2048) \
        SEG(w_out, D, 0, 1024, 1024, Wt_out, 0) SEG(w_up, FF, 0, 4096, 1024, Wt_up, 0) SEG(w_down, D, 0, 1024, 4096, Wt_down, 0) } while (0)
    {
        int lane = (int)threadIdx.x & 63; asm volatile("" : "+v"(lane));
        TrDesc dc, dn; float tva[32], tvb[32];
        int it = gw;
        if (it < NI_TOT) { TrDesc d; DECODE(it, d); dc = d; tr_load(dc, tva, lane); }
        while (it < NI_TOT) {
            const int itn = it + NGW; const bool more = itn < NI_TOT;
            if (more) { TrDesc d; DECODE(itn, d); dn = d; tr_load(dn, tvb, lane); }
            tr_store(dc, tva, scr, lane);
            if (more) { dc = dn;
#pragma unroll
                for (int i = 0; i < 32; ++i) tva[i] = tvb[i]; }
            it = itn;
        }
    }
#undef DECODE
#undef SEG
#undef SEGP
    static_assert(NI_IN == 16 * ((384 + 64 + 384 + 384 + 384 + 64 + 512 + 64 + 512 + 512 + 256 + 256 + 3072) / 32), "segments");
    for (int idx = F.bid * 512 + tid0; idx < 1024 * 16; idx += F.G * 512) *(u32x4*)(Wt_br + (size_t)(2048 + (idx >> 4)) * 384 + 256 + (idx & 15) * 8) = (u32x4){0u, 0u, 0u, 0u};
    for (int idx = F.bid * 512 + tid0; idx < 64 * 1024; idx += F.G * 512) { const int rr = idx >> 10, k = idx & 1023;
        Wt_in[(size_t)(NKV + C_IW + rr) * 1024 + k] = rr < 8 ? (bf16_t)(cvt_pk_bf16(w_in[(size_t)k * D_IN + 2240 + rr], 0.f) & 0xffff) : (bf16_t)0; }
}

__device__ __forceinline__ void prep_tokens(const Ctx& F, int l) {
    bf16_t* P = (bf16_t*)(F.ws + WS_BIG);
    int lane_ = ((int)threadIdx.x & 63); asm volatile("" : "+v"(lane_));
    const int gw = F.bid * 8 + F.wave, NGW = F.G * 8, lane = lane_, head = lane >> 2, part = lane & 3;
    const float* gq = F.in(3) + l * 64 + part * 16; const float* gk = F.in(4) + l * 64 + part * 16;
    float g[16];
#pragma unroll
    for (int i = 0; i < 16; ++i) g[i] = head < 6 ? gq[i] : (head == 6 ? gk[i] : 1.f);
    const float inv[8] = {1.0f, 0.19392274474868576f, 0.03760603093086393f, 0.007292664737217109f, 0.001414213562373095f, 0.0002742481756762073f, 5.318295896944988e-05f, 1.031338537721246e-05f};
    for (int m0 = gw; m0 < M; m0 += 2 * NGW) {
        const bool two = m0 + NGW < M;
        bf16_t* pp[2] = {P + (size_t)m0 * NPROJ + C_DQ + lane * 16, P + (size_t)(two ? m0 + NGW : m0) * NPROJ + C_DQ + lane * 16};
        u32x4 ra[2], rb[2];
#pragma unroll
        for (int u = 0; u < 2; ++u) { ra[u] = *(const u32x4*)pp[u]; rb[u] = *(const u32x4*)(pp[u] + 8); }
#pragma unroll
        for (int u = 0; u < 2; ++u) {
            if (u == 1 && !two) break;
            const int m = m0 + u * NGW;
            const u32x4 a = ra[u], b = rb[u];
            float v[16] = {bflo(a.x), bfhi(a.x), bflo(a.y), bfhi(a.y), bflo(a.z), bfhi(a.z), bflo(a.w), bfhi(a.w), bflo(b.x), bfhi(b.x), bflo(b.y), bfhi(b.y), bflo(b.z), bfhi(b.z), bflo(b.w), bfhi(b.w)};
            float ss = 0.f;
#pragma unroll
            for (int i = 0; i < 16; ++i) ss += v[i] * v[i];
            ss += __shfl_xor(ss, 1); ss += __shfl_xor(ss, 2);
            const float rstd = head < 7 ? 1.f / sqrtf(ss * (1.f / 64.f) + EPS) : 1.f;
#pragma unroll
            for (int i = 0; i < 16; ++i) v[i] = v[i] * rstd * g[i];
            if (part == 0) {
                const float pos = (float)(m & (T - 1));
#pragma unroll
                for (int i = 0; i < 8; ++i) { const float ang = pos * inv[i], c = __cosf(ang), sn = __sinf(ang), x1 = v[i], x2 = v[i + 8]; v[i] = x1 * c - x2 * sn; v[i + 8] = x2 * c + x1 * sn; }
            }
            u32x4 oa, ob;
            oa.x = cvt_pk_bf16(v[0], v[1]); oa.y = cvt_pk_bf16(v[2], v[3]); oa.z = cvt_pk_bf16(v[4], v[5]); oa.w = cvt_pk_bf16(v[6], v[7]);
            ob.x = cvt_pk_bf16(v[8], v[9]); ob.y = cvt_pk_bf16(v[10], v[11]); ob.z = cvt_pk_bf16(v[12], v[13]); ob.w = cvt_pk_bf16(v[14], v[15]);
            if (head == 6 || head == 15) {
                const int bb = m >> 11, tt = m & (T - 1);
                bf16_t* kf = (bf16_t*)(F.ws + (head == 6 ? WS_KF_DSA : WS_KF_IDX)) + (size_t)(((bb * 64 + (tt >> 5)) * 4 + part)) * 512 + (tt & 31) * 8;
                *(u32x4*)kf = oa; *(u32x4*)(kf + 256) = ob;
            } else { *(u32x4*)pp[u] = oa; *(u32x4*)(pp[u] + 8) = ob; }
        }
    }
}

__device__ __forceinline__ f32x16 mfma32(bf16x8 a, bf16x8 b, f32x16 c) { return __builtin_amdgcn_mfma_f32_32x32x16_bf16(a, b, c, 0, 0, 0); }
__device__ __forceinline__ bf16x8 ld_frag(const bf16_t* p) { return *(const bf16x8*)p; }
__device__ __forceinline__ bf16x8 ld_vfrag(const bf16_t* p) {
    const u32x2 a = *(const u32x2*)p, b = *(const u32x2*)(p + 8); u32x4 w = {a.x, a.y, b.x, b.y}; return __builtin_bit_cast(bf16x8, w);
}
__device__ __forceinline__ bf16x8 pack_p(const f32x16& p, int s) {
    u32x4 w; w.x = cvt_pk_bf16(p[8 * s + 0], p[8 * s + 1]); w.y = cvt_pk_bf16(p[8 * s + 2], p[8 * s + 3]); w.z = cvt_pk_bf16(p[8 * s + 4], p[8 * s + 5]); w.w = cvt_pk_bf16(p[8 * s + 6], p[8 * s + 7]);
    return __builtin_bit_cast(bf16x8, w);
}
__device__ __forceinline__ void store_ot(bf16_t* orow  , const f32x16& o0, const f32x16& o1, int h, float sc) {
#pragma unroll
    for (int g = 0; g < 4; ++g) {
        u32x2 w0, w1; w0.x = cvt_pk_bf16(o0[4 * g] * sc, o0[4 * g + 1] * sc); w0.y = cvt_pk_bf16(o0[4 * g + 2] * sc, o0[4 * g + 3] * sc);
        w1.x = cvt_pk_bf16(o1[4 * g] * sc, o1[4 * g + 1] * sc); w1.y = cvt_pk_bf16(o1[4 * g + 2] * sc, o1[4 * g + 3] * sc);
        *(u32x2*)(orow + 8 * g + 4 * h) = w0; *(u32x2*)(orow + 32 + 8 * g + 4 * h) = w1;
    }
}

#define LOAD_KV(KF, VA, kp_, vp_) do { _Pragma("unroll") for (int s_ = 0; s_ < 4; ++s_) KF[s_] = ld_frag((kp_) + 512 * s_); \
    _Pragma("unroll") for (int db_ = 0; db_ < 2; ++db_) _Pragma("unroll") for (int s_ = 0; s_ < 2; ++s_) VA[db_][s_] = ld_frag((vp_) + 512 * (2 * db_ + s_)); } while (0)

__device__ __forceinline__ void sb_item(const Ctx& F, int b, int hh, int qt) {
    const bf16_t* P = (const bf16_t*)(F.ws + WS_BIG); bf16_t* BR = (bf16_t*)(F.ws + WS_BR);
    int lane_ = ((int)threadIdx.x & 63); asm volatile("" : "+v"(lane_));
    const int lane = lane_, c = lane & 31, h = lane >> 5, tb = b * T, q0 = 32 * qt, tq = q0 + c;
    bf16x8 qf[4];
#pragma unroll
    for (int s = 0; s < 4; ++s) qf[s] = ld_frag(P + (size_t)(tb + q0 + c) * NPROJ + C_SQ + hh * 64 + 16 * s + 8 * h);
    f32x16 o0, o1;
#pragma unroll
    for (int i = 0; i < 16; ++i) { o0[i] = 0.f; o1[i] = 0.f; }
    float carry = 0.f;
    const bf16_t* kp0 = (const bf16_t*)(F.ws + WS_KF_SB) + (size_t)((b * 6 + hh) * 64) * 2048 + lane * 8;
    const bf16_t* vt0 = (const bf16_t*)(F.ws + WS_VF_SB) + (size_t)((b * 6 + hh) * 64) * 2048 + lane * 8;
    bf16x8 kfn[4], van[2][2];
    LOAD_KV(kfn, van, kp0 + (size_t)qt * 2048, vt0 + (size_t)qt * 2048);
    for (int kt = qt; kt >= 0; --kt) {
        const int key0 = 32 * kt;
        bf16x8 kf[4], va[2][2];
#pragma unroll
        for (int s = 0; s < 4; ++s) kf[s] = kfn[s];
#pragma unroll
        for (int db = 0; db < 2; ++db) { va[db][0] = van[db][0]; va[db][1] = van[db][1]; }
        if (kt > 0) LOAD_KV(kfn, van, kp0 + (size_t)(kt - 1) * 2048, vt0 + (size_t)(kt - 1) * 2048);
        f32x16 st;
#pragma unroll
        for (int i = 0; i < 16; ++i) st[i] = 0.f;
#pragma unroll
        for (int s = 0; s < 4; ++s) st = mfma32(kf[s], qf[s], st);
        float z[16], lm[16];
#pragma unroll
        for (int r = 0; r < 16; ++r) {
            const int key = key0 + (r & 3) + 8 * (r >> 2) + 4 * h;
            z[r] = st[r] * 0.125f;
            const float az = fabsf(z[r]);
            const float sp = fmaxf(z[r], 0.f) + flog2(1.f + fexp(-az)) * 0.6931471805599453f;
            lm[r] = key < tq ? -sp : 0.f;
        }
        float gs[4], pg[4], hi[4];
#pragma unroll
        for (int g = 0; g < 4; ++g) { gs[g] = (lm[4 * g] + lm[4 * g + 1]) + (lm[4 * g + 2] + lm[4 * g + 3]); pg[g] = __shfl_xor(gs[g], 32); }
        hi[3] = 0.f; hi[2] = gs[3] + pg[3]; hi[1] = hi[2] + gs[2] + pg[2]; hi[0] = hi[1] + gs[1] + pg[1];
        const float tot = hi[0] + gs[0] + pg[0];
        f32x16 pa;
#pragma unroll
        for (int g = 0; g < 4; ++g) {
            float run = carry + hi[g] + (h == 0 ? pg[g] : 0.f);
#pragma unroll
            for (int i = 3; i >= 0; --i) {
                const int r = 4 * g + i; const int key = key0 + (r & 3) + 8 * (r >> 2) + 4 * h;
                run += lm[r];
                pa[r] = key < tq ? fexp(z[r] + run) : 0.f;
            }
        }
        carry += tot;
        const bf16x8 pb0 = pack_p(pa, 0), pb1 = pack_p(pa, 1);
        o0 = mfma32(va[0][0], pb0, o0); o0 = mfma32(va[0][1], pb1, o0);
        o1 = mfma32(va[1][0], pb0, o1); o1 = mfma32(va[1][1], pb1, o1);
        if (__all(carry < -104.f)) break;
    }
    store_ot(BR + (size_t)(tb + tq) * D + hh * 64, o0, o1, h, 1.f);
}

__device__ __forceinline__ void dsa_loadq(const Ctx& F, int b, int hh, int qt, bf16x8 (&qf)[4]) {
    const bf16_t* P = (const bf16_t*)(F.ws + WS_BIG);
    int lane_ = ((int)threadIdx.x & 63); asm volatile("" : "+v"(lane_));
    const int c = lane_ & 31, h = lane_ >> 5;
#pragma unroll
    for (int s = 0; s < 4; ++s) qf[s] = ld_frag(P + (size_t)(b * T + 32 * qt + c) * NPROJ + C_DQ + hh * 64 + 16 * s + 8 * h);
}
__device__ __forceinline__ void dsa_item(const Ctx& F, int b, int hh, int qt, const bf16x8 (&qf)[4]) {
    const bf16_t* P = (const bf16_t*)(F.ws + WS_BIG); bf16_t* BR = (bf16_t*)(F.ws + WS_BR);
    const unsigned* MK = (const unsigned*)(F.ws + WS_MASK);
    int lane_ = ((int)threadIdx.x & 63); asm volatile("" : "+v"(lane_));
    const int lane = lane_, c = lane & 31, h = lane >> 5, tb = b * T, q0 = 32 * qt, tq = q0 + c;
    f32x16 o0, o1;
#pragma unroll
    for (int i = 0; i < 16; ++i) { o0[i] = 0.f; o1[i] = 0.f; }
    float mrun = -1e30f, lrun = 0.f;
    const bf16_t* kp0 = (const bf16_t*)(F.ws + WS_KF_DSA) + (size_t)(b * 64) * 2048 + lane * 8;
    const bf16_t* vt0 = (const bf16_t*)(F.ws + WS_VF_DSA) + (size_t)(b * 64) * 2048 + lane * 8;
    const unsigned* mrow = MK + (size_t)(tb + tq) * 64;
    bf16x8 kfn[4], van[2][2]; unsigned mwn = mrow[0];
    LOAD_KV(kfn, van, kp0, vt0);
    constexpr float SC2 = 0.125f * LOG2E;
    for (int kt = 0; kt <= qt; ++kt) {
        bf16x8 kf[4], va[2][2]; const unsigned mw = mwn;
#pragma unroll
        for (int s = 0; s < 4; ++s) kf[s] = kfn[s];
#pragma unroll
        for (int db = 0; db < 2; ++db) { va[db][0] = van[db][0]; va[db][1] = van[db][1]; }
        if (kt < qt) { mwn = mrow[kt + 1]; LOAD_KV(kfn, van, kp0 + (size_t)(kt + 1) * 2048, vt0 + (size_t)(kt + 1) * 2048); }
        if (!__any(mw != 0u)) continue;
        f32x16 st;
#pragma unroll
        for (int i = 0; i < 16; ++i) st[i] = 0.f;
#pragma unroll
        for (int s = 0; s < 4; ++s) st = mfma32(kf[s], qf[s], st);
        float mx = fmaxf(fmaxf(fmaxf(st[0], st[1]), fmaxf(st[2], st[3])), fmaxf(fmaxf(st[4], st[5]), fmaxf(st[6], st[7])));
        mx = fmaxf(mx, fmaxf(fmaxf(fmaxf(st[8], st[9]), fmaxf(st[10], st[11])), fmaxf(fmaxf(st[12], st[13]), fmaxf(st[14], st[15]))));
        mx = fmaxf(mx, __shfl_xor(mx, 32));
        const float mnew = fmaxf(mrun, mx);
        if (__any(mnew > mrun)) {
            const float alpha = fexp2((mrun - mnew) * SC2);
            lrun *= alpha;
#pragma unroll
            for (int i = 0; i < 16; ++i) { o0[i] *= alpha; o1[i] *= alpha; }
            mrun = mnew;
        }
        const float nm = -mrun * SC2; const unsigned mh = mw >> (4 * h);
        float ps = 0.f; f32x16 pa;
#pragma unroll
        for (int r = 0; r < 16; ++r) {
            const unsigned keep = (unsigned)__builtin_amdgcn_sbfe((int)mh, (r & 3) + 8 * (r >> 2), 1);
            pa[r] = __builtin_bit_cast(float, __builtin_bit_cast(unsigned, fexp2(__builtin_fmaf(st[r], SC2, nm))) & keep); ps += pa[r];
        }
        ps += __shfl_xor(ps, 32);
        lrun += ps;
        const bf16x8 pb0 = pack_p(pa, 0), pb1 = pack_p(pa, 1);
        o0 = mfma32(va[0][0], pb0, o0); o0 = mfma32(va[0][1], pb1, o0);
        o1 = mfma32(va[1][0], pb0, o1); o1 = mfma32(va[1][1], pb1, o1);
    }
    store_ot(BR + (size_t)(tb + tq) * D + 384 + hh * 64, o0, o1, h, 1.f / lrun);
}

constexpr int SCP = 2052;
constexpr float IDX_SCALE = 0.044194173824159216f;
__device__ __forceinline__ unsigned mono_key(float f) { const unsigned u = __builtin_bit_cast(unsigned, f); return (u & 0x80000000u) ? ~u : (u | 0x80000000u); }
__device__ __forceinline__ int popc64(unsigned long long m) { return __builtin_popcountll(m); }
__device__ __forceinline__ int cnt_ge8(unsigned v0, unsigned v1, unsigned v2, unsigned v3, unsigned v4, unsigned v5, unsigned v6, unsigned v7, unsigned c) {
    unsigned long long m0, m1, m2, m3, m4, m5, m6, m7;
    asm("v_cmp_le_u32_e64 %0, %8, %9\n\tv_cmp_le_u32_e64 %1, %8, %10\n\tv_cmp_le_u32_e64 %2, %8, %11\n\tv_cmp_le_u32_e64 %3, %8, %12\n\t"
        "v_cmp_le_u32_e64 %4, %8, %13\n\tv_cmp_le_u32_e64 %5, %8, %14\n\tv_cmp_le_u32_e64 %6, %8, %15\n\tv_cmp_le_u32_e64 %7, %8, %16"
        : "=&s"(m0), "=&s"(m1), "=&s"(m2), "=&s"(m3), "=&s"(m4), "=&s"(m5), "=&s"(m6), "=&s"(m7)
        : "s"(c), "v"(v0), "v"(v1), "v"(v2), "v"(v3), "v"(v4), "v"(v5), "v"(v6), "v"(v7));
    return (__builtin_popcountll(m0) + __builtin_popcountll(m1)) + (__builtin_popcountll(m2) + __builtin_popcountll(m3)) + (__builtin_popcountll(m4) + __builtin_popcountll(m5)) + (__builtin_popcountll(m6) + __builtin_popcountll(m7));
}
__device__ __forceinline__ int wave_count6(int c) {
    int tot = 0;
#pragma unroll
    for (int b = 0; b < 6; ++b) tot += popc64(__ballot((c >> b) & 1)) << b;
    return tot;
}
__device__ __forceinline__ unsigned long long sel_mask(const unsigned (&uk)[32], unsigned U, int n, int lane, bool exact) {
    unsigned long long mine = 0ull;
    if (exact && n > 256) {
#pragma unroll
        for (int i = 0; i < 32; ++i) { const unsigned long long mk = __ballot(uk[i] >= U); if (lane == i) mine = mk; }
        return mine;
    }
    if (n <= 256) {
#pragma unroll
        for (int i = 0; i < 4; ++i) { const unsigned long long mk = __ballot(i * 64 + lane < n); if (lane == i) mine = mk; }
        return mine;
    }
    int cgt = 0, ce = 0;
#pragma unroll
    for (int i = 0; i < 32; ++i) { cgt += popc64(__ballot(uk[i] > U)); ce += popc64(__ballot(uk[i] == U)); }
    const int need = 256 - cgt;
    int X = 4096;
    if (ce > need) {
        int lo = 0, hi = 2047;
#pragma unroll 1
        while (lo < hi) {
            const int mid = (lo + hi) >> 1; int cl = 0;
#pragma unroll
            for (int i = 0; i < 32; ++i) cl += popc64(__ballot((uk[i] == U) & (i * 64 + lane <= mid)));
            if (cl >= need) hi = mid; else lo = mid + 1;
        }
        X = lo;
    }
#pragma unroll
    for (int i = 0; i < 32; ++i) {
        const unsigned long long mk = __ballot((uk[i] > U) | ((uk[i] == U) & (i * 64 + lane <= X)));
        if (lane == i) mine = mk;
    }
    return mine;
}
__device__ __forceinline__ void index_items(const Ctx& F, int do_sel = 1) {
    const bf16_t* P = (const bf16_t*)(F.ws + WS_BIG); unsigned long long* MK = (unsigned long long*)(F.ws + WS_MASK);
    LAS float* sc = (LAS float*)F.lds;
    int lane_ = ((int)threadIdx.x & 63); asm volatile("" : "+v"(lane_));
    const int lane = lane_, c = lane & 31, h = lane >> 5, wave = F.wave, qq = c & 15, hsel = c >> 4;
    bf16x8 qi[4][4], qn[4][4]; float wv[4], wn[4];
#define IDX_LOADQ(QI, WV, it_) do { const bf16_t* qrow = P + (size_t)(((it_) & 7) * T + 16 * (127 - ((it_) >> 3)) + qq) * NPROJ; \
        _Pragma("unroll") for (int g = 0; g < 4; ++g) { _Pragma("unroll") for (int s = 0; s < 4; ++s) QI[g][s] = ld_frag(qrow + C_IQ + (2 * g + hsel) * 64 + 16 * s + 8 * h); \
            WV[g] = bf2f(qrow[C_IW + 2 * g + hsel]) * IDX_SCALE; } } while (0)
    if (F.bid < NB * 128) IDX_LOADQ(qi, wv, F.bid);
    for (int it = F.bid; it < NB * 128; it += F.G) {
    const int b = it & 7, qb = 127 - (it >> 3), tb = b * T, q0 = 16 * qb;
    const int ntiles = (q0 + 16 + 31) >> 5;
    {
#define IDX_TILE(KF, key0_) do { float sa[16]; \
            _Pragma("unroll") for (int r = 0; r < 16; ++r) sa[r] = 0.f; \
            _Pragma("unroll") for (int g = 0; g < 4; ++g) { f32x16 st; \
                _Pragma("unroll") for (int i = 0; i < 16; ++i) st[i] = 0.f; \
                _Pragma("unroll") for (int s = 0; s < 4; ++s) st = mfma32(KF[s], qi[g][s], st); \
                _Pragma("unroll") for (int r = 0; r < 16; ++r) sa[r] += wv[g] * fmaxf(st[r], 0.f); } \
            _Pragma("unroll") for (int r = 0; r < 16; ++r) sa[r] += __shfl_xor(sa[r], 16); \
            if (hsel == 0) { _Pragma("unroll") for (int g4 = 0; g4 < 4; ++g4) *(LAS f32x4*)(sc + qq * SCP + (key0_) + 8 * g4 + 4 * h) = (f32x4){sa[4 * g4], sa[4 * g4 + 1], sa[4 * g4 + 2], sa[4 * g4 + 3]}; } } while (0)
        const bf16_t* kbase = (const bf16_t*)(F.ws + WS_KF_IDX) + (size_t)(b * 64) * 2048 + lane * 8;
        for (int kt = wave; kt < ntiles; kt += 16) {
            const int kt2 = kt + 8; const bool two = kt2 < ntiles;
            bf16x8 kfa[4], kfb[4];
#pragma unroll
            for (int s = 0; s < 4; ++s) kfa[s] = ld_frag(kbase + (size_t)kt * 2048 + 512 * s);
            if (two) {
#pragma unroll
                for (int s = 0; s < 4; ++s) kfb[s] = ld_frag(kbase + (size_t)kt2 * 2048 + 512 * s);
            }
            IDX_TILE(kfa, 32 * kt);
            if (two) IDX_TILE(kfb, 32 * kt2);
        }
#undef IDX_TILE
    }
    __syncthreads();
    if (it + F.G < NB * 128) IDX_LOADQ(qn, wn, it + F.G);
    if (do_sel) {
        const int qA = 2 * wave, nA = q0 + qA + 1, nB = nA + 1;
        unsigned ua[32], ub[32];
        {
            float sv[32];
#pragma unroll
            for (int i = 0; i < 32; ++i) sv[i] = sc[qA * SCP + i * 64 + lane];
#pragma unroll
            for (int i = 0; i < 32; ++i) ua[i] = (i * 64 + lane < nA) ? mono_key(sv[i]) : 0u;
#pragma unroll
            for (int i = 0; i < 32; ++i) sv[i] = sc[(qA + 1) * SCP + i * 64 + lane];
#pragma unroll
            for (int i = 0; i < 32; ++i) ub[i] = (i * 64 + lane < nB) ? mono_key(sv[i]) : 0u;
        }
        unsigned UA = 0u, UB = 0u; int cntA = 4096, cntB = 4096;
        if (nB > 256) {
            const int nb8 = (nB + 511) >> 9;
#pragma unroll 1
            for (int bit = 31; bit >= 0; --bit) {
                if (cntA == 256 && cntB == 256) break;
                const unsigned ca = UA | (1u << bit), cb = UB | (1u << bit); int na = 0, nbc = 0;
#pragma unroll
                for (int bk = 0; bk < 4; ++bk) if (bk < nb8) {
                    na += cnt_ge8(ua[8 * bk], ua[8 * bk + 1], ua[8 * bk + 2], ua[8 * bk + 3], ua[8 * bk + 4], ua[8 * bk + 5], ua[8 * bk + 6], ua[8 * bk + 7], ca);
                    nbc += cnt_ge8(ub[8 * bk], ub[8 * bk + 1], ub[8 * bk + 2], ub[8 * bk + 3], ub[8 * bk + 4], ub[8 * bk + 5], ub[8 * bk + 6], ub[8 * bk + 7], cb);
                }
                if (na >= 256) { UA = ca; cntA = na; }
                if (nbc >= 256) { UB = cb; cntB = nbc; }
            }
        }
        const unsigned long long mA = sel_mask(ua, UA, nA, lane, cntA == 256), mB = sel_mask(ub, UB, nB, lane, cntB == 256);
        if (lane < 32) { MK[(size_t)(tb + q0 + qA) * 32 + lane] = mA; MK[(size_t)(tb + q0 + qA + 1) * 32 + lane] = mB; }
    }
    __syncthreads();
    if (it + F.G < NB * 128) {
#pragma unroll
        for (int g = 0; g < 4; ++g) { wv[g] = wn[g];
#pragma unroll
            for (int s2 = 0; s2 < 4; ++s2) qi[g][s2] = qn[g][s2]; }
    }
    }
#undef IDX_LOADQ
}

constexpr int HP = 132, AP = 72, KP = 136, TP = 72, OP = 68;
constexpr int H_Q = 0, H_K = 64 * HP * 4, H_B = 2 * 64 * HP * 4;
constexpr int H_ATT = 3 * 64 * HP * 4;
constexpr int H_K2 = H_ATT + 64 * AP * 2;
constexpr int H_KT = H_K2 + 64 * KP * 2;
constexpr int H_DV = H_KT + 128 * TP * 2;
constexpr int H_END = H_DV + 512;
static_assert(H_END <= LDS_BYTES && 64 * KP * 2 <= 64 * HP * 4 && 64 * OP * 4 <= 64 * HP * 4 && 4 * 128 * 4 <= 64 * AP * 2, "hgrn lds");
__device__ __forceinline__ f32x4 mfma16(bf16x8 a, bf16x8 b, f32x4 c) { return __builtin_amdgcn_mfma_f32_16x16x32_bf16(a, b, c, 0, 0, 0); }
__device__ __forceinline__ bf16x8 pack8(const float* v) { u32x4 w; w.x = cvt_pk_bf16(v[0], v[1]); w.y = cvt_pk_bf16(v[2], v[3]); w.z = cvt_pk_bf16(v[4], v[5]); w.w = cvt_pk_bf16(v[6], v[7]); return __builtin_bit_cast(bf16x8, w); }
__device__ __forceinline__ bf16_t bf1(float a) { return (bf16_t)(cvt_pk_bf16(a, 0.f) & 0xffffu); }

template <int MODE>
__device__ __forceinline__ void hgrn_item(const Ctx& F, int l, int b, int hh, int sc) {
    const bf16_t* P = (const bf16_t*)(F.ws + WS_BIG); bf16_t* BR = (bf16_t*)(F.ws + WS_BR); float* HST = (float*)(F.ws + WS_HST);
    LAS unsigned char* L = F.lds;
    LAS float* qS = (LAS float*)(L + H_Q); LAS float* kS = (LAS float*)(L + H_K); LAS float* bS = (LAS float*)(L + H_B); LAS float* tot = (LAS float*)(L + H_ATT); LAS float* Dv = (LAS float*)(L + H_DV);
    LAS bf16_t* att = (LAS bf16_t*)(L + H_ATT); LAS bf16_t* k2 = (LAS bf16_t*)(L + H_K2); LAS bf16_t* kT = (LAS bf16_t*)(L + H_KT); LAS bf16_t* sT = (LAS bf16_t*)(L + H_B); LAS float* oS = (LAS float*)(L + H_Q);
    int tid_ = threadIdx.x; asm volatile("" : "+v"(tid_));
    const int tid = tid_, lane = tid & 63, w = F.wave, n16 = lane & 15, g4 = lane >> 4, tb = b * T + sc * 256;
    const int item = (b * 4 + hh) * 8 + sc;
    f32x4 S[4]; float Dt[4] = {1.f, 1.f, 1.f, 1.f};
#pragma unroll
    for (int i = 0; i < 4; ++i) S[i] = (f32x4){0.f, 0.f, 0.f, 0.f};
    if (MODE == 1 && sc > 0) {
        const float* hp0 = HST + (size_t)((b * 4 + hh) * 8) * HST_STRIDE;
        float dc[4], dn[4]; f32x4 cs[4], ns[4];
#pragma unroll
        for (int r = 0; r < 4; ++r) { const int kk = 16 * w + 4 * g4 + r; dc[r] = hp0[8192 + kk];
#pragma unroll
            for (int vt = 0; vt < 4; ++vt) cs[vt][r] = hp0[kk * 64 + 16 * vt + n16]; }
        for (int i = 0; i < sc; ++i) {
            if (i + 1 < sc) { const float* hp = hp0 + (size_t)(i + 1) * HST_STRIDE;
#pragma unroll
                for (int r = 0; r < 4; ++r) { const int kk = 16 * w + 4 * g4 + r; dn[r] = hp[8192 + kk];
#pragma unroll
                    for (int vt = 0; vt < 4; ++vt) ns[vt][r] = hp[kk * 64 + 16 * vt + n16]; } }
#pragma unroll
            for (int r = 0; r < 4; ++r)
#pragma unroll
                for (int vt = 0; vt < 4; ++vt) S[vt][r] = dc[r] * S[vt][r] + cs[vt][r];
            if (i + 1 < sc) {
#pragma unroll
                for (int r = 0; r < 4; ++r) dc[r] = dn[r];
#pragma unroll
                for (int vt = 0; vt < 4; ++vt) cs[vt] = ns[vt]; }
        }
    }
    const int lcg = (tid & 15) * 8;
    float lb[8];
#pragma unroll
    for (int e = 0; e < 8; ++e) {
        float v = 0.f;
        if (l == 1) { const float l0 = F.in(5)[hh * 128 + lcg + e], l1 = F.in(5)[512 + hh * 128 + lcg + e]; v = 1.f / (1.f + expf(l0 - l1)); }
        lb[e] = v;
    }
    const bf16_t* vf0 = (const bf16_t*)(F.ws + WS_VF_HG) + (size_t)(((b * 4 + hh) * 32 + sc * 4) * 8) * 512 + lane * 8;
    float onv[8];
#pragma unroll
    for (int e = 0; e < 8; ++e) onv[e] = (MODE == 1) ? F.in(6)[l * 64 + (tid & 7) * 8 + e] : 0.f;
    u32x4 fwn[2], qwn[2];
#pragma unroll
    for (int i = 0; i < 2; ++i) { const bf16_t* src = P + (size_t)(tb + ((tid + 512 * i) >> 4)) * NPROJ + hh * 128 + lcg; fwn[i] = *(const u32x4*)(src + C_HF); if (MODE == 1) qwn[i] = *(const u32x4*)(src + C_HQ); }
#pragma unroll 1
    for (int c = 0; c < 4; ++c) {
        const int tok0 = tb + c * 64;
        u32x4 gwp = {0u, 0u, 0u, 0u};
        if (MODE == 1) gwp = *(const u32x4*)(P + (size_t)(tok0 + (tid >> 3)) * NPROJ + C_HG + hh * 64 + (tid & 7) * 8);
        bf16x8 vf[4][2];
#pragma unroll
        for (int vt = 0; vt < 4; ++vt) { vf[vt][0] = ld_frag(vf0 + (size_t)(c * 8 + vt * 2) * 512); vf[vt][1] = ld_frag(vf0 + (size_t)(c * 8 + vt * 2 + 1) * 512); }
#pragma unroll
        for (int i = 0; i < 2; ++i) {
            const int p = tid + 512 * i, row = p >> 4;
            const u32x4 fw = fwn[i];
            const float fx[8] = {bflo(fw.x), bfhi(fw.x), bflo(fw.y), bfhi(fw.y), bflo(fw.z), bfhi(fw.z), bflo(fw.w), bfhi(fw.w)};
            float kv[8], bv[8];
#pragma unroll
            for (int e = 0; e < 8; ++e) { const float f = lb[e] + (1.f - lb[e]) * sigmoidf_(fx[e]); kv[e] = 1.f - f; bv[e] = flog2(fmaxf(f, 1e-12f)); }
            *(LAS f32x4*)(kS + row * HP + lcg) = (f32x4){kv[0], kv[1], kv[2], kv[3]}; *(LAS f32x4*)(kS + row * HP + lcg + 4) = (f32x4){kv[4], kv[5], kv[6], kv[7]};
            *(LAS f32x4*)(bS + row * HP + lcg) = (f32x4){bv[0], bv[1], bv[2], bv[3]}; *(LAS f32x4*)(bS + row * HP + lcg + 4) = (f32x4){bv[4], bv[5], bv[6], bv[7]};
            if (MODE == 1) {
                const u32x4 qw = qwn[i];
                const float qx[8] = {bflo(qw.x), bfhi(qw.x), bflo(qw.y), bfhi(qw.y), bflo(qw.z), bfhi(qw.z), bflo(qw.w), bfhi(qw.w)};
                float qv[8];
#pragma unroll
                for (int e = 0; e < 8; ++e) qv[e] = qx[e] * sigmoidf_(qx[e]);
                *(LAS f32x4*)(qS + row * HP + lcg) = (f32x4){qv[0], qv[1], qv[2], qv[3]}; *(LAS f32x4*)(qS + row * HP + lcg + 4) = (f32x4){qv[4], qv[5], qv[6], qv[7]};
            }
        }
        if (c < 3) {
#pragma unroll
            for (int i = 0; i < 2; ++i) { const bf16_t* src = P + (size_t)(tok0 + 64 + ((tid + 512 * i) >> 4)) * NPROJ + hh * 128 + lcg; fwn[i] = *(const u32x4*)(src + C_HF); if (MODE == 1) qwn[i] = *(const u32x4*)(src + C_HQ); }
        }
        __syncthreads();
        {
            const int part = tid >> 7, k2i = tid & 127;
            float pv[16]; float run = 0.f;
#pragma unroll
            for (int i = 0; i < 16; ++i) { run += bS[(part * 16 + i) * HP + k2i]; pv[i] = run; }
            tot[part * 128 + k2i] = run;
            __syncthreads();
            float pre = 0.f;
#pragma unroll
            for (int pp = 0; pp < 3; ++pp) if (pp < part) pre += tot[pp * 128 + k2i];
#pragma unroll
            for (int i = 0; i < 16; ++i) bS[(part * 16 + i) * HP + k2i] = pv[i] + pre;
        }
        __syncthreads();
        if (MODE == 1) {
            {
                const int t = tid >> 3, j = tid & 7, G = t >> 3, s = 8 * G + j;
                float a = 0.f;
                if (s <= t) {
#pragma unroll 4
                    for (int k4 = 0; k4 < 128; k4 += 4) {
                        const f32x4 q4 = *(const LAS f32x4*)(qS + t * HP + k4), bt = *(const LAS f32x4*)(bS + t * HP + k4), kx = *(const LAS f32x4*)(kS + s * HP + k4), bs = *(const LAS f32x4*)(bS + s * HP + k4);
                        a += q4.x * kx.x * fexp2(bt.x - bs.x) + q4.y * kx.y * fexp2(bt.y - bs.y) + q4.z * kx.z * fexp2(bt.z - bs.z) + q4.w * kx.w * fexp2(bt.w - bs.w);
                    }
                }
                att[t * AP + s] = bf1(a);
                for (int g2 = G + 1; g2 < 8; ++g2) att[t * AP + 8 * g2 + j] = (bf16_t)0;
            }
#pragma unroll
            for (int i = 0; i < 2; ++i) {
                const int p = tid + 512 * i, row = p >> 4, er = (row | 7);
                float kv[8];
#pragma unroll
                for (int e = 0; e < 8; ++e) kv[e] = kS[row * HP + lcg + e] * fexp2(bS[er * HP + lcg + e] - bS[row * HP + lcg + e]);
                *(LAS bf16x8*)(k2 + row * KP + lcg) = pack8(kv);
            }
            __syncthreads();
            for (int pr = w; pr < 16; pr += 8) {
                int I = 0, G = pr; while (G > 2 * I) { G -= 2 * I + 1; ++I; }
                const int t = 16 * I + n16, er = 8 * G + 7, sB = 8 * G + n16;
                f32x4 acc = {0.f, 0.f, 0.f, 0.f};
#pragma unroll
                for (int ks = 0; ks < 4; ++ks) {
                    const int k0 = 32 * ks + 8 * g4;
                    float qv[8];
#pragma unroll
                    for (int hs = 0; hs < 2; ++hs) {
                        const f32x4 q4 = *(const LAS f32x4*)(qS + t * HP + k0 + 4 * hs), bt = *(const LAS f32x4*)(bS + t * HP + k0 + 4 * hs), be = *(const LAS f32x4*)(bS + er * HP + k0 + 4 * hs);
                        qv[4 * hs] = q4.x * fexp2(fminf(bt.x - be.x, 0.f)); qv[4 * hs + 1] = q4.y * fexp2(fminf(bt.y - be.y, 0.f)); qv[4 * hs + 2] = q4.z * fexp2(fminf(bt.z - be.z, 0.f)); qv[4 * hs + 3] = q4.w * fexp2(fminf(bt.w - be.w, 0.f));
                    }
                    const bf16x8 bfr = *(const LAS bf16x8*)(k2 + (sB < 64 ? sB : 63) * KP + k0);
                    acc = mfma16(pack8(qv), bfr, acc);
                }
                if (n16 < 8) {
#pragma unroll
                    for (int r = 0; r < 4; ++r) { const int tt = 16 * I + 4 * g4 + r; if ((tt >> 3) > G) att[tt * AP + 8 * G + n16] = bf1(acc[r]); }
                }
            }
            __syncthreads();
        }
        if (tid < 128) Dv[tid] = fexp2(bS[63 * HP + tid]);
        if (MODE == 1) {
#pragma unroll
            for (int i = 0; i < 2; ++i) {
                const int p = tid + 512 * i, row = p >> 4;
                float qv[8];
#pragma unroll
                for (int e = 0; e < 8; ++e) qv[e] = qS[row * HP + lcg + e] * fexp2(bS[row * HP + lcg + e]);
                *(LAS bf16x8*)(k2 + row * KP + lcg) = pack8(qv);
            }
        }
#pragma unroll
        for (int i = 0; i < 2; ++i) {
            const int p = tid + 512 * i, kk = p & 127, sg = p >> 7;
            const float b63 = bS[63 * HP + kk];
            float kv[8];
#pragma unroll
            for (int e = 0; e < 8; ++e) kv[e] = kS[(8 * sg + e) * HP + kk] * fexp2(b63 - bS[(8 * sg + e) * HP + kk]);
            *(LAS bf16x8*)(kT + kk * TP + 8 * sg) = pack8(kv);
        }
        __syncthreads();
        if (MODE == 1) {
#pragma unroll
            for (int vt = 0; vt < 4; ++vt) { u32x2 pk; pk.x = cvt_pk_bf16(S[vt][0], S[vt][1]); pk.y = cvt_pk_bf16(S[vt][2], S[vt][3]); *(LAS u32x2*)(sT + (16 * vt + n16) * KP + 16 * w + 4 * g4) = pk; }
            __syncthreads();
            if (w < 4) {
                const int t = 16 * w + n16;
                f32x4 o[4];
#pragma unroll
                for (int vt = 0; vt < 4; ++vt) o[vt] = (f32x4){0.f, 0.f, 0.f, 0.f};
#pragma unroll
                for (int ks = 0; ks < 2; ++ks) { const bf16x8 a = *(const LAS bf16x8*)(att + t * AP + 32 * ks + 8 * g4);
#pragma unroll
                    for (int vt = 0; vt < 4; ++vt) o[vt] = mfma16(a, vf[vt][ks], o[vt]); }
#pragma unroll
                for (int ks = 0; ks < 4; ++ks) { const bf16x8 a = *(const LAS bf16x8*)(k2 + t * KP + 32 * ks + 8 * g4);
#pragma unroll
                    for (int vt = 0; vt < 4; ++vt) o[vt] = mfma16(a, *(const LAS bf16x8*)(sT + (16 * vt + n16) * KP + 32 * ks + 8 * g4), o[vt]); }
#pragma unroll
                for (int vt = 0; vt < 4; ++vt)
#pragma unroll
                    for (int r = 0; r < 4; ++r) oS[(16 * w + 4 * g4 + r) * OP + 16 * vt + n16] = o[vt][r];
            }
            __syncthreads();
            {
                const int t = tid >> 3, v0 = (tid & 7) * 8;
                const f32x4 oa = *(const LAS f32x4*)(oS + t * OP + v0), ob = *(const LAS f32x4*)(oS + t * OP + v0 + 4);
                float ss = (oa.x * oa.x + oa.y * oa.y) + (oa.z * oa.z + oa.w * oa.w) + (ob.x * ob.x + ob.y * ob.y) + (ob.z * ob.z + ob.w * ob.w);
                ss += __shfl_xor(ss, 1); ss += __shfl_xor(ss, 2); ss += __shfl_xor(ss, 4);
                const float rstd = 1.f / sqrtf(ss * (1.f / 64.f) + EPS);
                const u32x4 gw = gwp;
                const float gx[8] = {bflo(gw.x), bfhi(gw.x), bflo(gw.y), bfhi(gw.y), bflo(gw.z), bfhi(gw.z), bflo(gw.w), bfhi(gw.w)};
                const float ov[8] = {oa.x, oa.y, oa.z, oa.w, ob.x, ob.y, ob.z, ob.w};
                float y[8];
#pragma unroll
                for (int e = 0; e < 8; ++e) y[e] = ov[e] * rstd * onv[e] * (gx[e] * sigmoidf_(gx[e]));
                u32x4 wv; wv.x = cvt_pk_bf16(y[0], y[1]); wv.y = cvt_pk_bf16(y[2], y[3]); wv.z = cvt_pk_bf16(y[4], y[5]); wv.w = cvt_pk_bf16(y[6], y[7]);
                *(u32x4*)(BR + (size_t)(tok0 + t) * D + 768 + hh * 64 + v0) = wv;
            }
        }
        {
            bf16x8 ka[2];
#pragma unroll
            for (int ks = 0; ks < 2; ++ks) ka[ks] = *(const LAS bf16x8*)(kT + (16 * w + n16) * TP + 32 * ks + 8 * g4);
#pragma unroll
            for (int r = 0; r < 4; ++r) { const float d = Dv[16 * w + 4 * g4 + r]; Dt[r] *= d;
#pragma unroll
                for (int vt = 0; vt < 4; ++vt) S[vt][r] *= d; }
#pragma unroll
            for (int vt = 0; vt < 4; ++vt) { S[vt] = mfma16(ka[0], vf[vt][0], S[vt]); S[vt] = mfma16(ka[1], vf[vt][1], S[vt]); }
        }
        __syncthreads();
    }
    if (MODE == 0) {
        float* hp = HST + (size_t)item * HST_STRIDE;
#pragma unroll
        for (int r = 0; r < 4; ++r) { const int kk = 16 * w + 4 * g4 + r;
#pragma unroll
            for (int vt = 0; vt < 4; ++vt) hp[kk * 64 + 16 * vt + n16] = S[vt][r];
            if (n16 == 0) hp[8192 + kk] = Dt[r]; }
    }
}

#ifndef PHASE_MASK
#define PHASE_MASK 0xfff
#endif
#define PM(i) ((PHASE_MASK >> (i)) & 1)
#if defined(REPEAT_K) && defined(REP_SKIP_SEL)
#define IDX_DO_SEL (rep == 0)
#else
#define IDX_DO_SEL 1
#endif
constexpr int PH_PER_LAYER = 10, N_PHASES = DEPTH * PH_PER_LAYER;
struct Args { const float* in[14]; float* out; unsigned char* ws; int ph_lo, ph_hi; };
static_assert(offsetof(Args, out) == 112 && offsetof(Args, ws) == 120, "Args layout");

__global__ void __launch_bounds__(512, 2) hybrid_fwd(Args args) {
    extern __shared__ __attribute__((aligned(16))) unsigned char lds_raw[];
    cg::grid_group grid = cg::this_grid();
    Ctx F;
    F.lds = (LAS unsigned char*)lds_raw;
    F.wave = __builtin_amdgcn_readfirstlane((int)threadIdx.x >> 6); F.G = gridDim.x; F.bid = blockIdx.x;
    const int gw = F.bid * 8 + F.wave, NGW = F.G * 8;
    for (int i = threadIdx.x; i < LDS_BYTES / 16; i += 512) ((LAS u32x4*)F.lds)[i] = (u32x4){0u, 0u, 0u, 0u};
    __syncthreads();

    for (int ph = args.ph_lo; ph < args.ph_hi; ++ph) {
        const int l = ph / PH_PER_LAYER, k = ph - l * PH_PER_LAYER;
        {
            const CAS unsigned char* ka = (const CAS unsigned char*)__builtin_amdgcn_kernarg_segment_ptr(); asm volatile("" : "+s"(ka));
            F.ka = ka; F.out = *(float* const CAS*)(ka + 112); F.ws = *(unsigned char* const CAS*)(ka + 120);
        }
        unsigned char* ws = F.ws; unsigned char* wt = ws + WS_WT; unsigned char* big = ws + WS_BIG;
        bf16_t* Hb = (bf16_t*)(ws + WS_H); bf16_t* BR = (bf16_t*)(ws + WS_BR);
        const float* xin = (l == 0) ? F.in(0) : F.out;
#ifdef REPEAT_K
        for (int rep = 0; rep < ((k == REPEAT_K) ? REPEAT_N : 1); ++rep) {
        if (rep) grid.sync();
#endif
        if (k == 0 && PM(0)) {
            p0_weights(F, l);
            norm_rows(F, xin, F.in(1) + l * D, Hb);
        } else if (k == 2 && PM(2)) {
#ifdef REPEAT_K
            if (rep == 0)
#endif
            prep_tokens(F, l);
            for (int it = F.bid; it < 256; it += F.G) hgrn_item<0>(F, l, it >> 5, (it >> 3) & 3, it & 7);
        } else if (k == 3 && PM(3)) {
#if defined(REPEAT_K) && defined(REP_ONLY_HGRN)
            if (rep == 0)
#endif
            if (PM(10)) index_items(F, IDX_DO_SEL);
#if defined(REPEAT_K) && defined(REP_ONLY_INDEX)
            if (rep == 0)
#endif
            if (PM(11)) for (int it = F.bid; it < 256; it += F.G) hgrn_item<1>(F, l, it >> 5, (it >> 3) & 3, it & 7);
        } else if (k == 4 && PM(4)) {
            if (F.wave < 6) {
                __builtin_amdgcn_s_setprio(1);
                for (int it = F.bid * 6 + F.wave; it < NB * 6 * 32; it += F.G * 6) { const int bh = it % 48, pi = it / 48; bf16x8 qa[4], qb[4]; dsa_loadq(F, bh / 6, bh % 6, 63 - pi, qa); dsa_loadq(F, bh / 6, bh % 6, pi, qb); dsa_item(F, bh / 6, bh % 6, 63 - pi, qa); dsa_item(F, bh / 6, bh % 6, pi, qb); }
                __builtin_amdgcn_s_setprio(0);
                if ((F.wave == 2 || F.wave == 3) && (F.G & 7) == 0 && F.G * 12 == NB * 6 * 64) { const int g = (F.bid >> 3) * 12 + 8 + F.wave; sb_item(F, F.bid & 7, g % 6, g / 6); }
            } else {
                if ((F.G & 7) == 0 && F.G * 12 == NB * 6 * 64) {
                    for (int j = F.wave - 6; j < 10; j += 2) { const int g = (F.bid >> 3) * 12 + j; sb_item(F, F.bid & 7, g % 6, g / 6); }
                } else {
                    for (int it = F.bid * 2 + (F.wave - 6); it < NB * 6 * 64; it += F.G * 2) { const int bh = it % 48, qt = it / 48; sb_item(F, bh / 6, bh % 6, qt); }
                }
            }
        } else if (k == 7 && PM(7)) {
            norm_rows(F, F.out, F.in(11) + l * D, Hb);
        } else if ((k == 1 || k == 5 || k == 6 || k >= 8) && PM(1)) {
            bf16_t* Gt = (bf16_t*)(big + BIG_GT); bf16_t* Mx = (bf16_t*)(big + BIG_MIX);
            const int nsub = (k == 5) ? 2 : 1;
#pragma unroll 1
            for (int sub = 0; sub < nsub; ++sub) {
                pg8::Gemm g; pg8::EpiAll E; E.KVB = ws; E.G16 = Gt; E.Xi = xin; E.Xo = F.out; E.O16 = (bf16_t*)big; E.ldo = D;
                g.M = M; g.N = D; g.K = D; g.lda = D; g.A = Hb; g.a_grp_off = 0; g.align = 1; int reps = 1;
                if (k == 1) { g.Bt = (const bf16_t*)(wt + WT_IN); g.N = NGEMM; E.mode = pg8::EM_PROJ; E.ldo = NPROJ; }
                else if (k == 5) {
                    g.N = 3072; reps = 3;
                    if (sub == 0) { g.Bt = (const bf16_t*)(wt + WT_G); E.mode = pg8::EM_GATE; E.O16 = Gt; E.ldo = 3072; }
                    else { g.A = BR; g.a_grp_off = 384; g.K = 384; g.Bt = (const bf16_t*)(wt + WT_BR); E.mode = pg8::EM_MIXB; E.O16 = Mx; }
                }
                else if (k == 6) { g.A = Mx; g.Bt = (const bf16_t*)(wt + WT_OUT); E.mode = pg8::EM_RES; }
                else if (k == 8) { g.Bt = (const bf16_t*)(wt + WT_UP); g.N = FF; E.mode = pg8::EM_UP; E.ldo = FF; }
                else { g.A = (const bf16_t*)big; g.K = FF; g.lda = FF; g.Bt = (const bf16_t*)(wt + WT_DOWN); E.mode = pg8::EM_RES; E.Xi = F.out; }
                pg8::StaticOrder S; S.init(M, g.N, F.G, F.bid, reps);
                pg8::gemm_phase(F.lds, g, S, E);
            }
        }
#ifdef REPEAT_K
        }
#endif
        if (ph + 1 < args.ph_hi) grid.sync();
    }
}

extern "C" void kernel_launch(void* const* d_in, const int* in_sizes, int n_in, void* d_out, int out_size, void* d_ws, size_t ws_size, hipStream_t stream) {
    static int grid = 0;
    if (grid == 0) {
        if (n_in != 14 || out_size != M * D || ws_size < WS_END) { fprintf(stderr, "kernel_launch: unexpected shapes (n_in %d out %d ws %zu)\n", n_in, out_size, ws_size); grid = -1; return; }
        int dev = 0, cus = 0, per_cu = 0;
        hipGetDevice(&dev); hipDeviceGetAttribute(&cus, hipDeviceAttributeMultiprocessorCount, dev);
        hipFuncSetAttribute((const void*)hybrid_fwd, hipFuncAttributeMaxDynamicSharedMemorySize, LDS_BYTES);
        hipOccupancyMaxActiveBlocksPerMultiprocessor(&per_cu, (const void*)hybrid_fwd, 512, LDS_BYTES);
        (void)hipGetLastError();
        if (per_cu < 1) { fprintf(stderr, "kernel_launch: occupancy query says %d blocks/CU\n", per_cu); per_cu = 1; }
        grid = cus * 1;
        fprintf(stderr, "kernel_launch: grid %d (cus %d, per_cu %d)\n", grid, cus, per_cu);
    }
    if (grid < 0) return;
#ifdef DIAG_MEMSET
    hipMemsetAsync((char*)d_ws + WS_KF_SB, 0, 30 * MiB, stream);
#endif
    Args a{};
    for (int i = 0; i < 14; ++i) a.in[i] = (const float*)d_in[i];
    a.out = (float*)d_out; a.ws = (unsigned char*)d_ws;
#if ONE_LAUNCH
    a.ph_lo = 0; a.ph_hi = N_PHASES;
    void* kargs[] = {&a};
    hipError_t e = hipLaunchCooperativeKernel((const void*)hybrid_fwd, dim3(grid), dim3(512), kargs, LDS_BYTES, stream);
    if (e != hipSuccess) fprintf(stderr, "cooperative launch failed: %s (grid %d)\n", hipGetErrorString(e), grid);
#else
    for (int ph = 0; ph < N_PHASES; ++ph) { a.ph_lo = ph; a.ph_hi = ph + 1; hipLaunchKernelGGL(hybrid_fwd, dim3(grid), dim3(512), LDS_BYTES, stream, a); }
#endif
}
```
